# Optimizing an MI355X kernel written in HIP

```python
import math
import jax, jax.numpy as jnp
from jax import lax
import numpy as np

D_MODEL = 2048
BATCH = 4
SEQ = 4096
DEPTH = 1

MIX_WIDTH = D_MODEL
ATTN_WIDTH = MIX_WIDTH // 2
ATTN_HEADS = 8
HEAD_DIM = ATTN_WIDTH // ATTN_HEADS
Q_LORA = D_MODEL // 4
KV_LORA = D_MODEL // 8
IDX_HEADS = 16
IDX_DIM = 64
IDX_TOPK_MAX = 256
CONV_WIDTH = MIX_WIDTH - ATTN_WIDTH
CONV_GROUPS = 8
CONV_GROUP_DIM = CONV_WIDTH // CONV_GROUPS
CONV_K = 3
D_FF = 4 * D_MODEL
N_BUCKETS = 32
MAX_DISTANCE = 128
Q_BLOCK = 128
EPS = 1e-6
IN_COLS = Q_LORA + KV_LORA + IDX_DIM + IDX_HEADS + 3 * CONV_WIDTH

kernel_name = 'hybrid_dsa_shortconv_adaln_layer'


def rms_norm(x, g):
    x32 = x.astype(jnp.float32)
    y = x32 * lax.rsqrt(jnp.mean(x32 * x32, axis=-1, keepdims=True) + EPS)
    return (y * g.astype(jnp.float32)).astype(x.dtype)


def layer_norm(x, g, b):
    x32 = x.astype(jnp.float32)
    mu = jnp.mean(x32, axis=-1, keepdims=True)
    xc = x32 - mu
    y = xc * lax.rsqrt(jnp.mean(xc * xc, axis=-1, keepdims=True) + EPS)
    return (y * g.astype(jnp.float32) + b.astype(jnp.float32)).astype(x.dtype)


def modulate(h, shift, scale):
    return h * (1 + scale[:, None, :]) + shift[:, None, :]


def t5_bucket(n):
    max_exact = N_BUCKETS // 2
    nf = jnp.maximum(n, 1).astype(jnp.float32)
    large = max_exact + (jnp.log(nf / max_exact) / math.log(MAX_DISTANCE / max_exact)
                         * (N_BUCKETS - max_exact)).astype(jnp.int32)
    large = jnp.minimum(large, N_BUCKETS - 1)
    return jnp.where(n < max_exact, n, large)


def causal_short_conv(u, w, b):
    S = u.shape[1]
    up = jnp.pad(u, ((0, 0), (CONV_K - 1, 0), (0, 0)))
    y = b
    for j in range(CONV_K):
        y = y + w[j] * up[:, j:j + S]
    return y


def dsa_attention(cq, ckv, k_idx, w_idx, w_uq, w_uk, q_abs_norm_g, w_iq, rel_bias):
    Bn, S, _ = cq.shape
    topk = min(IDX_TOPK_MAX, S // 4)
    nb = S // Q_BLOCK
    q = (cq @ w_uq).reshape(Bn, S, ATTN_HEADS, HEAD_DIM)
    q_abs = jnp.einsum('bshd,hdc->bshc', q, w_uk)
    q_abs = rms_norm(q_abs, q_abs_norm_g)
    iq = (cq @ w_iq).reshape(Bn, S, IDX_HEADS, IDX_DIM)
    w_idx = w_idx * (IDX_HEADS ** -0.5 * IDX_DIM ** -0.5)

    def to_blocks(a):
        return a.reshape((Bn, nb, Q_BLOCK) + a.shape[2:]).swapaxes(0, 1)

    key_pos = jnp.arange(S, dtype=jnp.int32)
    attn_scale = KV_LORA ** -0.5
    neg = jnp.finfo(jnp.float32).min

    def block(args):
        qa, iqb, wb, blk = args
        q_pos = blk * Q_BLOCK + jnp.arange(Q_BLOCK, dtype=jnp.int32)
        lg = jnp.einsum('bqhd,bsd->bqhs', iqb, k_idx)
        score = jnp.einsum('bqhs,bqh->bqs', jax.nn.relu(lg), wb).astype(jnp.float32)
        causal = key_pos[None, :] <= q_pos[:, None]
        score = jnp.where(causal[None], score, neg)
        _, sel = lax.top_k(score, topk)
        valid = sel <= q_pos[None, :, None]
        kv_sel = jax.vmap(lambda kv, i: kv[i])(ckv, sel)
        logits = jnp.einsum('bqhc,bqkc->bhqk', qa, kv_sel).astype(jnp.float32) * attn_scale
        bucket = t5_bucket(jnp.maximum(q_pos[None, :, None] - sel, 0))
        bias = rel_bias[bucket]
        logits = logits + jnp.moveaxis(bias, -1, 1).astype(jnp.float32)
        logits = jnp.where(valid[:, None], logits, neg)
        p = jax.nn.softmax(logits, axis=-1).astype(kv_sel.dtype)
        return jnp.einsum('bhqk,bqkc->bqhc', p, kv_sel)

    o = lax.map(block, (to_blocks(q_abs), to_blocks(iq), to_blocks(w_idx),
                        jnp.arange(nb, dtype=jnp.int32)))
    return o.swapaxes(0, 1).reshape(Bn, S, ATTN_HEADS, KV_LORA)


def setup_inputs(seed: int = 0) -> dict:
    key = jax.random.key(seed)
    ks = jax.random.split(key, 32)
    f32 = jnp.float32

    def nrm(k, shape, scale):
        return jax.random.normal(k, shape, f32) * scale

    def gain(k, shape):
        return 1.0 + 0.02 * jax.random.normal(k, shape, f32)

    L = DEPTH
    return {
        'x': nrm(ks[0], (BATCH, SEQ, D_MODEL), 1.0),
        'c': nrm(ks[1], (BATCH, D_MODEL), 1.0),
        'w_ada': nrm(ks[2], (L, D_MODEL, 6 * D_MODEL), D_MODEL ** -0.5),
        'b_ada': nrm(ks[3], (L, 6 * D_MODEL), 0.02),
        'norm1_g': gain(ks[4], (L, D_MODEL)),
        'norm2_g': gain(ks[5], (L, D_MODEL)),
        'w_in': nrm(ks[6], (L, D_MODEL, IN_COLS), D_MODEL ** -0.5),
        'cq_norm_g': gain(ks[7], (L, Q_LORA)),
        'w_uq': nrm(ks[8], (L, Q_LORA, ATTN_HEADS * HEAD_DIM), Q_LORA ** -0.5),
        'w_uk': nrm(ks[9], (L, ATTN_HEADS, HEAD_DIM, KV_LORA), HEAD_DIM ** -0.5),
        'kv_norm_g': gain(ks[10], (L, KV_LORA)),
        'q_abs_norm_g': gain(ks[11], (L, KV_LORA)),
        'w_uv': nrm(ks[12], (L, ATTN_HEADS, KV_LORA, HEAD_DIM), KV_LORA ** -0.5),
        'w_iq': nrm(ks[13], (L, Q_LORA, IDX_HEADS * IDX_DIM), Q_LORA ** -0.5),
        'idx_k_norm_g': gain(ks[14], (L, IDX_DIM)),
        'idx_k_norm_b': nrm(ks[15], (L, IDX_DIM), 0.02),
        'rel_bias': nrm(ks[16], (N_BUCKETS, ATTN_HEADS), 0.5),
        'conv_w': nrm(ks[17], (L, CONV_K, CONV_WIDTH), CONV_K ** -0.5),
        'conv_b': nrm(ks[18], (L, CONV_WIDTH), 0.02),
        'attn_out_norm_g': gain(ks[19], (L, ATTN_HEADS, HEAD_DIM)),
        'conv_out_norm_g': gain(ks[20], (L, CONV_GROUPS, CONV_GROUP_DIM)),
        'w_out': nrm(ks[21], (L, MIX_WIDTH, D_MODEL), MIX_WIDTH ** -0.5),
        'w_mlp1': nrm(ks[22], (L, D_MODEL, D_FF), D_MODEL ** -0.5),
        'b_mlp1': nrm(ks[23], (L, D_FF), 0.02),
        'w_mlp2': nrm(ks[24], (L, D_FF, D_MODEL), D_FF ** -0.5),
        'b_mlp2': nrm(ks[25], (L, D_MODEL), 0.02),
    }


def reference(x, c, w_ada, b_ada, norm1_g, norm2_g, w_in, cq_norm_g, w_uq, w_uk,
              kv_norm_g, q_abs_norm_g, w_uv, w_iq, idx_k_norm_g, idx_k_norm_b, rel_bias,
              conv_w, conv_b, attn_out_norm_g, conv_out_norm_g, w_out, w_mlp1, b_mlp1,
              w_mlp2, b_mlp2):
    Bn, S, D = x.shape
    c_act = jax.nn.silu(c)
    o0 = Q_LORA
    o1 = o0 + KV_LORA
    o2 = o1 + IDX_DIM
    o3 = o2 + IDX_HEADS
    o4 = o3 + CONV_WIDTH
    o5 = o4 + CONV_WIDTH
    for l in range(DEPTH):
        mod = c_act @ w_ada[l] + b_ada[l]
        sh1, sc1, g1, sh2, sc2, g2 = jnp.split(mod, 6, axis=-1)

        h = modulate(rms_norm(x, norm1_g[l]), sh1, sc1)
        proj = h @ w_in[l]
        cq = rms_norm(proj[..., :o0], cq_norm_g[l])
        ckv = rms_norm(proj[..., o0:o1], kv_norm_g[l])
        k_idx = layer_norm(proj[..., o1:o2], idx_k_norm_g[l], idx_k_norm_b[l])
        w_idx = proj[..., o2:o3]
        gate_b = proj[..., o3:o4]
        gate_c = proj[..., o4:o5]
        h_conv = proj[..., o5:]

        o_lat = dsa_attention(cq, ckv, k_idx, w_idx, w_uq[l], w_uk[l], q_abs_norm_g[l],
                              w_iq[l], rel_bias)
        y_attn = jnp.einsum('bshc,hcv->bshv', o_lat, w_uv[l])
        y_attn = rms_norm(y_attn, attn_out_norm_g[l])

        y_conv = gate_b * causal_short_conv(gate_c * h_conv, conv_w[l], conv_b[l])
        y_conv = rms_norm(y_conv.reshape(Bn, S, CONV_GROUPS, CONV_GROUP_DIM), conv_out_norm_g[l])

        y_mix = jnp.concatenate([y_attn.reshape(Bn, S, ATTN_WIDTH),
                                 y_conv.reshape(Bn, S, CONV_WIDTH)], axis=-1)
        x = x + g1[:, None, :] * (y_mix @ w_out[l])

        h2 = modulate(rms_norm(x, norm2_g[l]), sh2, sc2)
        a = jnp.square(jax.nn.relu(h2 @ w_mlp1[l] + b_mlp1[l]))
        x = x + g2[:, None, :] * (a @ w_mlp2[l] + b_mlp2[l])
    return x
```

```cpp
#include <hip/hip_runtime.h>
#include <hip/hip_cooperative_groups.h>
#include <cstdio>
#include <cstdint>
namespace cg = cooperative_groups;

#define LAS __attribute__((address_space(3)))
typedef _Float16 h16;
typedef _Float16 h16x8 __attribute__((ext_vector_type(8)));
typedef _Float16 h16x4 __attribute__((ext_vector_type(4)));
typedef _Float16 h16x2 __attribute__((ext_vector_type(2)));
typedef float f32x4 __attribute__((ext_vector_type(4)));
typedef float f32x2 __attribute__((ext_vector_type(2)));
typedef unsigned u32x4 __attribute__((ext_vector_type(4)));
typedef unsigned u32x2 __attribute__((ext_vector_type(2)));

constexpr int D_MODEL = 2048, BATCH = 4, SEQ = 4096, T = BATCH * SEQ;
constexpr int ATTN_HEADS = 8, HEAD_DIM = 128, Q_LORA = 512, KV_LORA = 256, IDX_HEADS = 16, IDX_DIM = 64, TOPK = 256;
constexpr int CONV_WIDTH = 1024, D_FF = 8192, IN_COLS = 3920;
constexpr float EPS = 1e-6f;
constexpr int NTHREADS = 512, NWAVES = 8;
constexpr int N_IN = 4096;
constexpr int N_Q = 3072;

constexpr size_t MiB = (size_t)1 << 20;
constexpr size_t WS_CTL = 0;
constexpr size_t WS_MOD = 64 * 1024;
constexpr size_t WS_BT_IN = 1 * MiB;
constexpr size_t WS_BT_Q = WS_BT_IN + 16 * MiB;
constexpr size_t WS_BT_OUT = WS_BT_Q + 3 * MiB;
constexpr size_t WS_BT_1 = WS_BT_OUT + 8 * MiB;
constexpr size_t WS_BT_2 = WS_BT_1 + 32 * MiB;
constexpr size_t WS_WUVT = WS_BT_2 + 32 * MiB;
constexpr size_t WS_R2 = 93 * MiB;
constexpr size_t WS_R3 = WS_R2 + 64 * MiB;
constexpr size_t WS_PROJA = WS_R3;
constexpr size_t WS_PROJB = WS_R3 + 64 * MiB;
constexpr size_t WS_OLAT = WS_R3 + 64 * MiB;
constexpr size_t WS_QABS = WS_R3 + 160 * MiB;
constexpr size_t WS_IQ = WS_R3 + 224 * MiB;
constexpr size_t WS_R4 = WS_R3 + 256 * MiB;
constexpr size_t WS_CQ = WS_R4;
constexpr size_t WS_CKV = WS_CQ + 16 * MiB;
constexpr size_t WS_KIDX = WS_CKV + 8 * MiB;
constexpr size_t WS_WIDX = WS_KIDX + 2 * MiB;
constexpr size_t WS_SEL = WS_WIDX + 1 * MiB;
constexpr size_t WS_END = WS_SEL + 8 * MiB;

struct Params {
    const float *x, *c, *w_ada, *b_ada, *norm1_g, *norm2_g, *w_in, *cq_norm_g, *w_uq, *w_uk, *kv_norm_g, *q_abs_norm_g, *w_uv, *w_iq,
        *idx_k_norm_g, *idx_k_norm_b, *rel_bias, *conv_w, *conv_b, *attn_out_norm_g, *conv_out_norm_g, *w_out, *w_mlp1, *b_mlp1, *w_mlp2, *b_mlp2;
    float* out;
    unsigned char* ws;
    int ph_lo, ph_hi;
};

__device__ __forceinline__ float wave_sum(float v) {
#pragma unroll
    for (int o = 1; o < 64; o <<= 1) v += __shfl_xor(v, o);
    return v;
}
__device__ __forceinline__ float wave_max(float v) {
#pragma unroll
    for (int o = 1; o < 64; o <<= 1) v = fmaxf(v, __shfl_xor(v, o));
    return v;
}
#define LDS_WAIT() asm volatile("s_waitcnt lgkmcnt(0)" ::: "memory")

namespace pg8 {
constexpr int BM = 256, BK = 64, HALF = 128, HTB = HALF * BK * 2, STAGE_BYTES = 8 * HTB, NXCD = 8, WGM = 8;
__host__ __device__ __forceinline__ int lds_byte(int r, int c) { const int st = (r >> 4) * 2 + (c >> 5), rr = r & 15, cc = c & 31, ob = rr * 64 + cc * 2; return st * 1024 + (ob ^ (((ob >> 9) & 1) << 5)); }
__host__ __device__ __forceinline__ void stage_rc(int b, int& R, int& C) { const int st = b / 1024, sb = b % 1024, swz = sb ^ (((sb >> 9) & 1) << 5); R = (st >> 1) * 16 + swz / 64; C = (st & 1) * 32 + (swz % 64) / 2; }
struct Unit { int pm, pn; };
struct Gemm { const h16* A; const h16* Bt; int M, N, K; };
struct StaticOrder {
    int nM, nN, nwg, G, c;
    __host__ __device__ void init(int M, int N, int G_, int c_) { nM = M / BM; nN = N / BM; nwg = nM * nN; G = G_; c = c_; }
    __host__ __device__ bool next(int i, Unit& u) const {
        const long L = (long)i * G + c; if (L >= nwg) return false;
        int wgid = (int)L; { const int q = nwg / NXCD, r = nwg % NXCD, xcd = wgid % NXCD, off = wgid / NXCD; wgid = (xcd < r ? xcd * (q + 1) : r * (q + 1) + (xcd - r) * q) + off; }
        const int nig = WGM * nN, gid = wgid / nig, fm = gid * WGM, gsz = (nM - fm) < WGM ? (nM - fm) : WGM;
        u.pm = fm + ((wgid % nig) % gsz); u.pn = (wgid % nig) / gsz; return true;
    }
};

template <class Epi>
__device__ __forceinline__ void gemm_phase(LAS unsigned char* lds, const Gemm g, const StaticOrder& S, const Epi& E) {
    const int tid = threadIdx.x, wid = __builtin_amdgcn_readfirstlane(tid >> 6), lane = tid & 63, wr = wid >> 2, wc = wid & 3, fr = lane & 15, fq = lane >> 4;
    const int K = g.K, nt = K / BK;
    unsigned voffA[2], voffB[2];
#pragma unroll
    for (int i = 0; i < 2; ++i) { int R, C; stage_rc(tid * 16 + i * 8192, R, C); voffA[i] = (unsigned)(R * K + C) * 2u; voffB[i] = voffA[i]; }
    const size_t kstep = (size_t)(BK * 2);
    const size_t hstep = (size_t)HALF * K * 2;
    const size_t tstep = 2 * hstep;
    const unsigned ldsw = (unsigned)wid * 1024u;
    const int aoff = lds_byte(wr * 64 + fr, fq * 8), boff = lds_byte(wc * 32 + fr, fq * 8);
#define PG8_SA(b, h) (((b) * 2 + (h)) * HTB)
#define PG8_SB(b, h) ((4 + (b) * 2 + (h)) * HTB)
#define PG8_STAGE(bufoff, gbase, voff) do { _Pragma("unroll") for (int _i = 0; _i < 2; ++_i) \
        __builtin_amdgcn_global_load_lds((const unsigned*)((const char*)(gbase) + (voff)[_i]), (LAS unsigned*)(lds + (bufoff) + ldsw + _i * 8192), 16, 0, 0); } while (0)
#define PG8_LDA(dst, b, h) do { _Pragma("unroll") for (int m = 0; m < 4; ++m) _Pragma("unroll") for (int k = 0; k < 2; ++k) dst[m][k] = *(const LAS h16x8*)(lds + PG8_SA(b, h) + aoff + m * 2048 + k * 1024); } while (0)
#define PG8_LDB(dst, b, h) do { _Pragma("unroll") for (int n = 0; n < 2; ++n) _Pragma("unroll") for (int k = 0; k < 2; ++k) dst[n][k] = *(const LAS h16x8*)(lds + PG8_SB(b, h) + boff + n * 2048 + k * 1024); } while (0)
#define PG8_MMA(ai, bj, At, Bt) do { __builtin_amdgcn_s_setprio(1); _Pragma("unroll") for (int m = 0; m < 4; ++m) _Pragma("unroll") for (int n = 0; n < 2; ++n) _Pragma("unroll") for (int k = 0; k < 2; ++k) \
        acc[ai][bj][m][n] = __builtin_amdgcn_mfma_f32_16x16x32_f16(Bt[n][k], At[m][k], acc[ai][bj][m][n], 0, 0, 0); __builtin_amdgcn_s_setprio(0); } while (0)
#define PG8_WAIT_V(n) asm volatile("s_waitcnt vmcnt(" #n ")" ::: "memory")
#define PG8_WAIT_L(n) asm volatile("s_waitcnt lgkmcnt(" #n ")" ::: "memory")
#define PG8_BAR __builtin_amdgcn_s_barrier()
#define PG8_SCHED __builtin_amdgcn_sched_barrier(0)
    Unit cur, nxt; int ui = 0;
    if (!S.next(0, cur)) return;
    f32x4 acc[2][2][4][2];
#pragma unroll
    for (int a = 0; a < 2; ++a)
#pragma unroll
        for (int b = 0; b < 2; ++b)
#pragma unroll
            for (int m = 0; m < 4; ++m)
#pragma unroll
                for (int n = 0; n < 2; ++n) acc[a][b][m][n] = (f32x4){0.f, 0.f, 0.f, 0.f};
    h16x8 At[4][2], B0[2][2], B1[2][2];
    const char* cA = (const char*)g.A + (size_t)cur.pm * tstep; const char* cB = (const char*)g.Bt + (size_t)cur.pn * tstep;
    PG8_STAGE(PG8_SB(0, 0), cB, voffB); PG8_STAGE(PG8_SA(0, 0), cA, voffA); PG8_STAGE(PG8_SB(0, 1), cB + hstep, voffB); PG8_STAGE(PG8_SA(0, 1), cA + hstep, voffA);
    if (wr == 1) PG8_BAR;
    PG8_WAIT_V(4); PG8_BAR;
    PG8_STAGE(PG8_SB(1, 0), cB + kstep, voffB); PG8_STAGE(PG8_SA(1, 0), cA + kstep, voffA); PG8_STAGE(PG8_SB(1, 1), cB + hstep + kstep, voffB);
    PG8_WAIT_V(6); PG8_BAR;
    for (;;) {
        const bool has_next = S.next(ui + 1, nxt);
        const char* nA = has_next ? (const char*)g.A + (size_t)nxt.pm * tstep : cA; const char* nB = has_next ? (const char*)g.Bt + (size_t)nxt.pn * tstep : cB;
        for (int t = 0; t < nt; t += 2) {
            const bool last = (t == nt - 2);
            const char* a1 = cA + (size_t)(t + 1) * kstep;
            const char* a2 = last ? nA : cA + (size_t)(t + 2) * kstep; const char* b2 = last ? nB : cB + (size_t)(t + 2) * kstep;
            const char* a3 = a2 + kstep; const char* b3 = b2 + kstep;
            PG8_LDB(B0, 0, 0); PG8_SCHED; PG8_LDA(At, 0, 0); PG8_STAGE(PG8_SA(1, 1), a1 + hstep, voffA);
            PG8_WAIT_L(8); PG8_BAR; PG8_WAIT_L(0); PG8_MMA(0, 0, At, B0); PG8_BAR; PG8_SCHED;
            PG8_LDB(B1, 0, 1); PG8_STAGE(PG8_SB(0, 0), b2, voffB);
            PG8_BAR; PG8_WAIT_L(0); PG8_MMA(0, 1, At, B1); PG8_BAR;
            PG8_LDA(At, 0, 1); PG8_STAGE(PG8_SA(0, 0), a2, voffA);
            PG8_BAR; PG8_WAIT_L(0); PG8_MMA(1, 0, At, B0); PG8_BAR; PG8_SCHED;
            PG8_STAGE(PG8_SB(0, 1), b2 + hstep, voffB);
            PG8_WAIT_V(6); PG8_BAR; PG8_MMA(1, 1, At, B1); PG8_BAR;
            PG8_LDB(B0, 1, 0); PG8_SCHED; PG8_LDA(At, 1, 0); PG8_STAGE(PG8_SA(0, 1), a2 + hstep, voffA);
            PG8_WAIT_L(8); PG8_BAR; PG8_WAIT_L(0); PG8_MMA(0, 0, At, B0); PG8_BAR; PG8_SCHED;
            PG8_LDB(B1, 1, 1); PG8_STAGE(PG8_SB(1, 0), b3, voffB);
            PG8_BAR; PG8_WAIT_L(0); PG8_MMA(0, 1, At, B1); PG8_BAR;
            PG8_LDA(At, 1, 1); PG8_STAGE(PG8_SA(1, 0), a3, voffA);
            PG8_BAR; PG8_WAIT_L(0); PG8_MMA(1, 0, At, B0); PG8_BAR; PG8_SCHED;
            PG8_STAGE(PG8_SB(1, 1), b3 + hstep, voffB);
            PG8_WAIT_V(6); PG8_BAR; PG8_MMA(1, 1, At, B1); PG8_BAR;
        }
        {
            const int row0 = cur.pm * BM + wr * 64 + fr, col0 = cur.pn * BM + wc * 32 + 4 * fq;
#pragma unroll
            for (int ai = 0; ai < 2; ++ai)
#pragma unroll
                for (int m = 0; m < 4; ++m)
#pragma unroll
                    for (int bj = 0; bj < 2; ++bj)
#pragma unroll
                        for (int n = 0; n < 2; ++n) E.store4(row0 + ai * HALF + m * 16, col0 + bj * HALF + n * 16, acc[ai][bj][m][n]);
        }
        if (!has_next) break;
#pragma unroll
        for (int a = 0; a < 2; ++a)
#pragma unroll
            for (int b = 0; b < 2; ++b)
#pragma unroll
                for (int m = 0; m < 4; ++m)
#pragma unroll
                    for (int n = 0; n < 2; ++n) acc[a][b][m][n] = (f32x4){0.f, 0.f, 0.f, 0.f};
        cur = nxt; cA = nA; cB = nB; ++ui;
    }
    PG8_WAIT_V(0);
    if (wr == 0) PG8_BAR;
    PG8_BAR;
#undef PG8_SA
#undef PG8_SB
#undef PG8_STAGE
#undef PG8_LDA
#undef PG8_LDB
#undef PG8_MMA
#undef PG8_WAIT_V
#undef PG8_WAIT_L
#undef PG8_BAR
#undef PG8_SCHED
}

template <class Epi>
__device__ __forceinline__ void gemm_naive(LAS unsigned char* lds, const Gemm g, int bid, int nb, const Epi& E) {
    LAS float* As = (LAS float*)lds;
    LAS float* Bs = As + 128 * 33;
    const int tid = threadIdx.x, tx = tid & 15, ty = tid >> 4;
    const int ntm = g.M / 128, ntn = g.N / 64;
    for (int tile = bid; tile < ntm * ntn; tile += nb) {
        const int tm = tile / ntn, tn = tile % ntn;
        float acc[4][4];
#pragma unroll
        for (int i = 0; i < 4; ++i)
#pragma unroll
            for (int j = 0; j < 4; ++j) acc[i][j] = 0.f;
        for (int k0 = 0; k0 < g.K; k0 += 32) {
            __syncthreads();
            for (int e = tid; e < 128 * 32; e += NTHREADS) { const int r = e >> 5, c = e & 31; As[r * 33 + c] = (float)g.A[(size_t)(tm * 128 + r) * g.K + k0 + c]; }
            for (int e = tid; e < 64 * 32; e += NTHREADS) { const int r = e >> 5, c = e & 31; Bs[r * 33 + c] = (float)g.Bt[(size_t)(tn * 64 + r) * g.K + k0 + c]; }
            __syncthreads();
#pragma unroll 8
            for (int kk = 0; kk < 32; ++kk) {
                float a[4], b[4];
#pragma unroll
                for (int i = 0; i < 4; ++i) a[i] = As[(ty * 4 + i) * 33 + kk];
#pragma unroll
                for (int j = 0; j < 4; ++j) b[j] = Bs[(tx * 4 + j) * 33 + kk];
#pragma unroll
                for (int i = 0; i < 4; ++i)
#pragma unroll
                    for (int j = 0; j < 4; ++j) acc[i][j] += a[i] * b[j];
            }
        }
#pragma unroll
        for (int i = 0; i < 4; ++i) E.store4(tm * 128 + ty * 4 + i, tn * 64 + tx * 4, (f32x4){acc[i][0], acc[i][1], acc[i][2], acc[i][3]});
    }
    __syncthreads();
}
}

#ifndef NAIVE_GEMM
#define NAIVE_GEMM 0
#endif
template <class Epi>
__device__ __forceinline__ void run_gemm(LAS unsigned char* lds, const h16* A, const h16* Bt, int M, int N, int K, int bid, int nb, const Epi& E) {
    pg8::Gemm g{A, Bt, M, N, K};
#if NAIVE_GEMM
    pg8::gemm_naive(lds, g, bid, nb, E);
#else
    pg8::StaticOrder S; S.init(M, N, nb, bid);
    pg8::gemm_phase(lds, g, S, E);
#endif
}

__device__ __forceinline__ u32x2 pack_h4(f32x4 v) {
    h16x2 a = {(h16)v[0], (h16)v[1]}, b = {(h16)v[2], (h16)v[3]};
    u32x2 r; r.x = __builtin_bit_cast(unsigned, a); r.y = __builtin_bit_cast(unsigned, b); return r;
}

struct EpiProj {
    float* projA; h16* projB;
    __device__ __forceinline__ void store4(int row, int col, f32x4 v) const {
        if (col < 1024) *(f32x4*)(projA + (size_t)row * 1024 + col) = v;
        else *(u32x2*)(projB + (size_t)row * 3072 + (col - 1024)) = pack_h4(v);
    }
};
struct EpiQ {
    h16* qabs; h16* iq;
    __device__ __forceinline__ void store4(int row, int col, f32x4 v) const {
        if (col < 2048) *(u32x2*)(qabs + (size_t)row * 2048 + col) = pack_h4(v);
        else *(u32x2*)(iq + (size_t)row * 1024 + (col - 2048)) = pack_h4(v);
    }
};
struct EpiOut {
    const float* x; const float* mod; float* out;
    __device__ __forceinline__ void store4(int row, int col, f32x4 v) const {
        const int b = row >> 12;
        const f32x4 g = *(const f32x4*)(mod + b * 12288 + 2 * 2048 + col);
        const f32x4 xr = *(const f32x4*)(x + (size_t)row * 2048 + col);
        *(f32x4*)(out + (size_t)row * 2048 + col) = xr + g * v;
    }
};
struct EpiMlp1 {
    const float* b1; h16* a;
    __device__ __forceinline__ void store4(int row, int col, f32x4 v) const {
        const f32x4 b = *(const f32x4*)(b1 + col);
        f32x4 z = v + b;
#pragma unroll
        for (int j = 0; j < 4; ++j) { const float r = fmaxf(z[j], 0.f); z[j] = r * r; }
        *(u32x2*)(a + (size_t)row * D_FF + col) = pack_h4(z);
    }
};
struct EpiMlp2 {
    const float* b2; const float* mod; float* out;
    __device__ __forceinline__ void store4(int row, int col, f32x4 v) const {
        const int b = row >> 12;
        const f32x4 g = *(const f32x4*)(mod + b * 12288 + 5 * 2048 + col);
        const f32x4 bb = *(const f32x4*)(b2 + col);
        float* o = out + (size_t)row * 2048 + col;
        const f32x4 x1 = *(const f32x4*)o;
        *(f32x4*)o = x1 + g * (v + bb);
    }
};

__device__ __forceinline__ void transpose_item(const float* __restrict__ src, int ld, int k0, int n0, int nvalid, const float* __restrict__ kscale,
                                               h16* __restrict__ dst, int dst_ld, int dst_row0, int dst_k0, LAS float* scr, int lane) {
#pragma unroll 8
    for (int i = 0; i < 32; ++i) {
        const int kk = 2 * i + (lane >> 5), n = lane & 31;
        float v = 0.f;
        if (n < nvalid) v = src[(size_t)(k0 + kk) * ld + n0 + n];
        if (kscale) v *= kscale[k0 + kk];
        scr[kk * 33 + n] = v;
    }
    LDS_WAIT(); asm volatile("" ::: "memory");
    const int c = lane & 7;
#pragma unroll
    for (int j = 0; j < 4; ++j) {
        const int n = (lane >> 3) + 8 * j; const LAS float* s = scr + (8 * c) * 33 + n;
        h16x8 o;
#pragma unroll
        for (int q = 0; q < 8; ++q) o[q] = (h16)s[q * 33];
        *(h16x8*)(dst + (size_t)(dst_row0 + n) * dst_ld + dst_k0 + 8 * c) = o;
    }
    LDS_WAIT(); asm volatile("" ::: "memory");
}

__device__ void phase_prep(const Params& p, LAS unsigned char* lds, int bid, int nb) {
    const int tid = threadIdx.x, lane = tid & 63, wave = tid >> 6;
    unsigned char* ws = p.ws;
    {
        LAS f32x4* cact = (LAS f32x4*)lds;
        LAS float* red = (LAS float*)(lds + 32768);
        for (int i = tid; i < 4 * 2048; i += NTHREADS) { const int b = i >> 11, k = i & 2047; const float v = p.c[b * 2048 + k]; ((LAS float*)cact)[k * 4 + b] = v / (1.f + __expf(-v)); }
        __syncthreads();
        float* mod = (float*)(ws + WS_MOD);
        for (int cgp = bid; cgp < 256; cgp += nb) {
            const int col = cgp * 48 + (lane < 48 ? lane : 47);
            float a0 = 0.f, a1 = 0.f, a2 = 0.f, a3 = 0.f;
            const float* wp = p.w_ada + (size_t)(wave * 256) * 12288 + col;
            for (int kb = 0; kb < 256; kb += 32) {
                float wv[32];
#pragma unroll
                for (int j = 0; j < 32; ++j) wv[j] = wp[(size_t)(kb + j) * 12288];
#pragma unroll
                for (int j = 0; j < 32; ++j) { const f32x4 cv = cact[wave * 256 + kb + j]; a0 += cv[0] * wv[j]; a1 += cv[1] * wv[j]; a2 += cv[2] * wv[j]; a3 += cv[3] * wv[j]; }
            }
            red[(wave * 4 + 0) * 64 + lane] = a0; red[(wave * 4 + 1) * 64 + lane] = a1; red[(wave * 4 + 2) * 64 + lane] = a2; red[(wave * 4 + 3) * 64 + lane] = a3;
            __syncthreads();
            if (tid < 192) {
                const int b = tid / 48, l = tid % 48; float s = 0.f;
#pragma unroll
                for (int w = 0; w < 8; ++w) s += red[(w * 4 + b) * 64 + l];
                const int cc = cgp * 48 + l;
                mod[b * 12288 + cc] = s + p.b_ada[cc];
            }
            __syncthreads();
        }
    }
    LAS float* scr = (LAS float*)(lds + wave * 16384);
    const int gw = bid * NWAVES + wave, NGW = nb * NWAVES;
    constexpr int I_IN = 32 * 128, I_1 = 32 * 256, I_2 = 128 * 64, I_OUT = 32 * 64, I_IQ = 8 * 32, I_UV = 8 * 4 * 4, I_QA = 8 * 8 * 8;
    constexpr int NITEMS = I_IN + I_1 + I_2 + I_OUT + I_IQ + I_UV + I_QA;
    for (int it = gw; it < NITEMS - I_QA; it += NGW) {
        int r = it;
        const float* src; int ld, k0, n0, nvalid = 32, dld, drow0; const float* ksc = nullptr; h16* dst;
        if (r < I_IN) {
            const int kb = r / 128, nbk = r % 128, n0d = nbk * 32;
            if (n0d >= 864 && n0d < 1024) continue;
            src = p.w_in; ld = IN_COLS; k0 = kb * 64; n0 = n0d < 1024 ? n0d : n0d - 176; nvalid = (n0d == 832) ? 16 : 32; dst = (h16*)(ws + WS_BT_IN); dld = 2048; drow0 = n0d;
        } else if ((r -= I_IN) < I_1) { const int kb = r / 256, nbk = r % 256; src = p.w_mlp1; ld = D_FF; k0 = kb * 64; n0 = nbk * 32; dst = (h16*)(ws + WS_BT_1); dld = 2048; drow0 = n0; }
        else if ((r -= I_1) < I_2) { const int kb = r / 64, nbk = r % 64; src = p.w_mlp2; ld = 2048; k0 = kb * 64; n0 = nbk * 32; dst = (h16*)(ws + WS_BT_2); dld = 8192; drow0 = n0; }
        else if ((r -= I_2) < I_OUT) { const int kb = r / 64, nbk = r % 64; src = p.w_out; ld = 2048; k0 = kb * 64; n0 = nbk * 32; dst = (h16*)(ws + WS_BT_OUT); dld = 2048; drow0 = n0; }
        else if ((r -= I_OUT) < I_IQ) { const int kb = r / 32, nbk = r % 32; src = p.w_iq; ld = 1024; k0 = kb * 64; n0 = nbk * 32; ksc = p.cq_norm_g; dst = (h16*)(ws + WS_BT_Q); dld = 512; drow0 = 2048 + n0; }
        else { r -= I_IQ; const int h = r / 16, kb = (r % 16) / 4, nbk = r % 4; src = p.w_uv + (size_t)h * 256 * 128; ld = 128; k0 = kb * 64; n0 = nbk * 32; dst = (h16*)(ws + WS_WUVT) + (size_t)h * 128 * 256; dld = 256; drow0 = n0; }
        transpose_item(src, ld, k0, n0, nvalid, ksc, dst, dld, drow0, k0, scr, lane);
    }
    for (int r = gw; r < I_QA; r += NGW) {
        {
            const int h = r / 64, kb = (r % 64) / 8, cb = r % 8, k0 = kb * 64, c0 = cb * 32;
#pragma unroll 8
            for (int e = lane; e < 128 * 32; e += 64) { const int d = e >> 5, c = e & 31; scr[e] = p.w_uk[((size_t)h * 128 + d) * 256 + c0 + c]; }
            LDS_WAIT(); asm volatile("" ::: "memory");
            float acc[32];
#pragma unroll
            for (int c = 0; c < 32; ++c) acc[c] = 0.f;
            const float* uq = p.w_uq + (size_t)(k0 + lane) * 1024 + h * 128;
#pragma unroll 1
            for (int d0 = 0; d0 < 128; d0 += 4) {
                const f32x4 a = *(const f32x4*)(uq + d0);
#pragma unroll
                for (int dd = 0; dd < 4; ++dd) {
#pragma unroll
                    for (int c4 = 0; c4 < 8; ++c4) { const f32x4 w = *(const LAS f32x4*)(scr + (d0 + dd) * 32 + c4 * 4);
                        acc[c4 * 4 + 0] += a[dd] * w[0]; acc[c4 * 4 + 1] += a[dd] * w[1]; acc[c4 * 4 + 2] += a[dd] * w[2]; acc[c4 * 4 + 3] += a[dd] * w[3]; }
                    asm volatile("" ::: "memory");
                }
            }
            const float gk = p.cq_norm_g[k0 + lane];
            h16* dst = (h16*)(ws + WS_BT_Q);
            h16* dp = dst + (size_t)(h * 256 + c0) * 512 + k0 + lane;
#pragma unroll
            for (int c = 0; c < 32; ++c) { dp[(size_t)c * 512] = (h16)(acc[c] * gk); if ((c & 3) == 3) asm volatile("" ::: "memory"); }
            LDS_WAIT(); asm volatile("" ::: "memory");
        }
    }
    {
        u32x4* z = (u32x4*)((h16*)(ws + WS_BT_IN) + (size_t)848 * 2048);
        const int n16 = 176 * 2048 * 2 / 16;
        for (int i = bid * NTHREADS + tid; i < n16; i += nb * NTHREADS) z[i] = (u32x4){0u, 0u, 0u, 0u};
    }
}

__device__ void phase_normmod(const float* __restrict__ xin, const float* __restrict__ g, const float* __restrict__ mod, int sh_off, int sc_off, h16* __restrict__ hout, int bid, int nb) {
    const int tid = threadIdx.x, lane = tid & 63, wave = tid >> 6;
    for (int t = bid * NWAVES + wave; t < T; t += nb * NWAVES) {
        const int b = t >> 12;
        const f32x4* xr = (const f32x4*)(xin + (size_t)t * 2048) + lane;
        f32x4 v[8]; float ss = 0.f;
#pragma unroll
        for (int j = 0; j < 8; ++j) { v[j] = xr[64 * j]; ss += (v[j][0] * v[j][0] + v[j][1] * v[j][1]) + (v[j][2] * v[j][2] + v[j][3] * v[j][3]); }
        const float rstd = rsqrtf(wave_sum(ss) * (1.f / 2048.f) + EPS);
        const float* mb = mod + b * 12288;
        u32x2* o = (u32x2*)(hout + (size_t)t * 2048) + lane;
#pragma unroll
        for (int j = 0; j < 8; ++j) {
            const int d = (lane + 64 * j) * 4;
            const f32x4 gg = *(const f32x4*)(g + d), sc = *(const f32x4*)(mb + sc_off + d), sh = *(const f32x4*)(mb + sh_off + d);
            f32x4 y = (v[j] * rstd) * gg;
            y = y * (sc + 1.f) + sh;
            o[64 * j] = pack_h4(y);
        }
    }
}

__device__ void phase_rows3(const Params& p, int bid, int nb) {
    const int tid = threadIdx.x, lane = tid & 63, wave = tid >> 6;
    unsigned char* ws = p.ws;
    const float* projA = (const float*)(ws + WS_PROJA); const h16* projB = (const h16*)(ws + WS_PROJB);
    h16* cq = (h16*)(ws + WS_CQ); h16* ckv = (h16*)(ws + WS_CKV); h16* kidx = (h16*)(ws + WS_KIDX); float* widx = (float*)(ws + WS_WIDX);
    h16* ymix = (h16*)(ws + WS_R2);
    for (int t = bid * NWAVES + wave; t < T; t += nb * NWAVES) {
        const float* pa = projA + (size_t)t * 1024;
        {
            const f32x4 a = *(const f32x4*)(pa + lane * 4), b = *(const f32x4*)(pa + 256 + lane * 4);
            float ss = (a[0] * a[0] + a[1] * a[1]) + (a[2] * a[2] + a[3] * a[3]) + (b[0] * b[0] + b[1] * b[1]) + (b[2] * b[2] + b[3] * b[3]);
            const float rstd = rsqrtf(wave_sum(ss) * (1.f / 512.f) + EPS);
            *(u32x2*)(cq + (size_t)t * 512 + lane * 4) = pack_h4(a * rstd);
            *(u32x2*)(cq + (size_t)t * 512 + 256 + lane * 4) = pack_h4(b * rstd);
        }
        {
            const f32x4 a = *(const f32x4*)(pa + 512 + lane * 4);
            const float ss = (a[0] * a[0] + a[1] * a[1]) + (a[2] * a[2] + a[3] * a[3]);
            const float rstd = rsqrtf(wave_sum(ss) * (1.f / 256.f) + EPS);
            const f32x4 g = *(const f32x4*)(p.kv_norm_g + lane * 4);
            *(u32x2*)(ckv + (size_t)t * 256 + lane * 4) = pack_h4(a * rstd * g);
        }
        {
            const float v = pa[768 + lane];
            const float mu = wave_sum(v) * (1.f / 64.f);
            const float xc = v - mu;
            const float var = wave_sum(xc * xc) * (1.f / 64.f);
            const float y = xc * rsqrtf(var + EPS) * p.idx_k_norm_g[lane] + p.idx_k_norm_b[lane];
            kidx[(size_t)t * 64 + lane] = (h16)y;
            if (lane < 16) widx[(size_t)t * 16 + lane] = pa[832 + lane] * (1.f / 32.f);
        }
        {
            const int tl = t & (SEQ - 1);
            const h16* pb = projB + (size_t)t * 3072 + lane * 16;
            float u[3][16], gb[16];
#pragma unroll
            for (int hh = 0; hh < 2; ++hh) {
                const h16x8 b8 = *(const h16x8*)(pb + hh * 8);
#pragma unroll
                for (int q = 0; q < 8; ++q) gb[hh * 8 + q] = (float)b8[q];
#pragma unroll
                for (int j = 0; j < 3; ++j) {
                    const int dt = 2 - j;
                    if (tl - dt >= 0) {
                        const h16x8 c8 = *(const h16x8*)(pb - (size_t)dt * 3072 + 1024 + hh * 8), h8 = *(const h16x8*)(pb - (size_t)dt * 3072 + 2048 + hh * 8);
#pragma unroll
                        for (int q = 0; q < 8; ++q) u[j][hh * 8 + q] = (float)c8[q] * (float)h8[q];
                    } else {
#pragma unroll
                        for (int q = 0; q < 8; ++q) u[j][hh * 8 + q] = 0.f;
                    }
                }
            }
            float y[16], ss = 0.f;
#pragma unroll
            for (int q4 = 0; q4 < 4; ++q4) {
                const int c = lane * 16 + q4 * 4;
                const f32x4 w0 = *(const f32x4*)(p.conv_w + c), w1 = *(const f32x4*)(p.conv_w + 1024 + c), w2 = *(const f32x4*)(p.conv_w + 2048 + c), bb = *(const f32x4*)(p.conv_b + c);
#pragma unroll
                for (int q = 0; q < 4; ++q) {
                    const int i = q4 * 4 + q;
                    float s = bb[q] + w0[q] * u[0][i]; s = s + w1[q] * u[1][i]; s = s + w2[q] * u[2][i];
                    y[i] = gb[i] * s; ss += y[i] * y[i];
                }
            }
            ss += __shfl_xor(ss, 1); ss += __shfl_xor(ss, 2); ss += __shfl_xor(ss, 4);
            const float rstd = rsqrtf(ss * (1.f / 128.f) + EPS);
            h16x8 o0, o1;
#pragma unroll
            for (int q = 0; q < 8; ++q) { o0[q] = (h16)(y[q] * rstd * p.conv_out_norm_g[lane * 16 + q]); o1[q] = (h16)(y[8 + q] * rstd * p.conv_out_norm_g[lane * 16 + 8 + q]); }
            *(h16x8*)(ymix + (size_t)t * 2048 + 1024 + lane * 16) = o0;
            *(h16x8*)(ymix + (size_t)t * 2048 + 1024 + lane * 16 + 8) = o1;
        }
    }
}

__device__ void phase_qnorm(const Params& p, int bid, int nb) {
    const int tid = threadIdx.x, lane = tid & 63, wave = tid >> 6;
    h16* qabs = (h16*)(p.ws + WS_QABS);
    const f32x4 g = *(const f32x4*)(p.q_abs_norm_g + lane * 4);
    for (int t = bid * NWAVES + wave; t < T; t += nb * NWAVES) {
#pragma unroll
        for (int h = 0; h < 8; ++h) {
            h16* q = qabs + (size_t)t * 2048 + h * 256 + lane * 4;
            const h16x4 r = *(const h16x4*)q;
            const f32x4 v = {(float)r[0], (float)r[1], (float)r[2], (float)r[3]};
            const float ss = (v[0] * v[0] + v[1] * v[1]) + (v[2] * v[2] + v[3] * v[3]);
            const float rstd = rsqrtf(wave_sum(ss) * (1.f / 256.f) + EPS);
            *(u32x2*)q = pack_h4(v * rstd * g * 0.0625f);
        }
    }
}

__device__ void phase_index_naive(const Params& p, LAS unsigned char* lds, int bid, int nb) {
    const int tid = threadIdx.x;
    unsigned char* ws = p.ws;
    const h16* iq = (const h16*)(ws + WS_IQ); const h16* kidx = (const h16*)(ws + WS_KIDX); const float* widx = (const float*)(ws + WS_WIDX);
    unsigned short* sel = (unsigned short*)(ws + WS_SEL);
    LAS float* sq = (LAS float*)lds;
    LAS float* sw = sq + 1024;
    LAS float* sc = sw + 16;
    for (int t = bid; t < T; t += nb) {
        const int b = t >> 12, tl = t & (SEQ - 1), n = tl + 1;
        if (n <= TOPK) continue;
        __syncthreads();
        for (int e = tid; e < 1024; e += NTHREADS) sq[e] = (float)iq[(size_t)t * 1024 + e];
        if (tid < 16) sw[tid] = widx[(size_t)t * 16 + tid];
        __syncthreads();
        for (int s = tid; s < n; s += NTHREADS) {
            const h16* kr = kidx + ((size_t)b * SEQ + s) * 64;
            float kv[64];
#pragma unroll
            for (int q8 = 0; q8 < 8; ++q8) { const h16x8 k8 = *(const h16x8*)(kr + q8 * 8);
#pragma unroll
                for (int q = 0; q < 8; ++q) kv[q8 * 8 + q] = (float)k8[q]; }
            float score = 0.f;
            for (int h = 0; h < 16; ++h) {
                float lg = 0.f;
#pragma unroll
                for (int d = 0; d < 64; ++d) lg += sq[h * 64 + d] * kv[d];
                score += sw[h] * fmaxf(lg, 0.f);
            }
            sc[s] = score;
        }
        __syncthreads();
        for (int s = tid; s < n; s += NTHREADS) {
            const float v = sc[s]; int rank = 0;
            for (int s2 = 0; s2 < n; ++s2) { const float w = sc[s2]; rank += (w > v || (w == v && s2 < s)) ? 1 : 0; }
            if (rank < TOPK) sel[(size_t)t * TOPK + rank] = (unsigned short)s;
        }
    }
    __syncthreads();
}

__constant__ unsigned char c_bucket_thr[15] = {19, 21, 24, 27, 31, 35, 40, 46, 52, 59, 67, 77, 87, 99, 113};
__device__ __forceinline__ int t5_bucket(int n) {
    if (n < 16) return n;
    int bkt = 16;
#pragma unroll
    for (int i = 0; i < 15; ++i) bkt += (n >= (int)c_bucket_thr[i]) ? 1 : 0;
    return bkt;
}
__device__ void phase_attn_naive(const Params& p, LAS unsigned char* lds, int bid, int nb) {
    const int tid = threadIdx.x;
    unsigned char* ws = p.ws;
    const h16* qabs = (const h16*)(ws + WS_QABS); const h16* ckv = (const h16*)(ws + WS_CKV);
    const unsigned short* sel = (const unsigned short*)(ws + WS_SEL);
    h16* olat = (h16*)(ws + WS_OLAT);
    LAS float* sq = (LAS float*)lds;
    LAS float* sp = sq + 2048;
    LAS int* sidx = (LAS int*)(sp + 2048);
    LAS float* sred = (LAS float*)(sidx + 256);
    for (int t = bid; t < T; t += nb) {
        const int b = t >> 12, tl = t & (SEQ - 1), cnt = tl + 1 < TOPK ? tl + 1 : TOPK;
        __syncthreads();
        for (int e = tid; e < 2048; e += NTHREADS) sq[e] = (float)qabs[(size_t)t * 2048 + e];
        if (tid < 256) sidx[tid] = (tl + 1 <= TOPK) ? (tid < cnt ? tid : 0) : (int)sel[(size_t)t * TOPK + tid];
        __syncthreads();
        {
            const int j = tid & 255, h0 = (tid >> 8) * 4;
            const int s = sidx[j];
            const h16* kr = ckv + ((size_t)b * SEQ + s) * 256;
            float a[4] = {0.f, 0.f, 0.f, 0.f};
            for (int c8 = 0; c8 < 32; ++c8) {
                const h16x8 k8 = *(const h16x8*)(kr + c8 * 8);
#pragma unroll
                for (int q = 0; q < 8; ++q) { const float kf = (float)k8[q];
#pragma unroll
                    for (int hh = 0; hh < 4; ++hh) a[hh] += sq[(h0 + hh) * 256 + c8 * 8 + q] * kf; }
            }
            const int bkt = t5_bucket(tl - s);
#pragma unroll
            for (int hh = 0; hh < 4; ++hh) sp[(h0 + hh) * 256 + j] = (j < cnt) ? a[hh] + p.rel_bias[bkt * 8 + h0 + hh] : -INFINITY;
        }
        __syncthreads();
        {
            const int w = tid >> 6, lane = tid & 63;
            float v[4]; float m = -INFINITY;
#pragma unroll
            for (int q = 0; q < 4; ++q) { v[q] = sp[w * 256 + lane + 64 * q]; m = fmaxf(m, v[q]); }
            m = wave_max(m);
            float s = 0.f;
#pragma unroll
            for (int q = 0; q < 4; ++q) { v[q] = __expf(v[q] - m); s += v[q]; }
            s = wave_sum(s);
            const float inv = 1.f / s;
#pragma unroll
            for (int q = 0; q < 4; ++q) sp[w * 256 + lane + 64 * q] = v[q] * inv;
        }
        __syncthreads();
        {
            const int c = tid & 255, h0 = (tid >> 8) * 4;
            float a[4] = {0.f, 0.f, 0.f, 0.f};
            for (int j = 0; j < cnt; ++j) {
                const float vf = (float)ckv[((size_t)b * SEQ + sidx[j]) * 256 + c];
#pragma unroll
                for (int hh = 0; hh < 4; ++hh) a[hh] += sp[(h0 + hh) * 256 + j] * vf;
            }
#pragma unroll
            for (int hh = 0; hh < 4; ++hh) olat[(size_t)t * 2048 + (h0 + hh) * 256 + c] = (h16)a[hh];
        }
    }
    __syncthreads();
}

__device__ void phase_uv_naive(const Params& p, LAS unsigned char* lds, int bid, int nb) {
    const int tid = threadIdx.x;
    unsigned char* ws = p.ws;
    const h16* olat = (const h16*)(ws + WS_OLAT);
    h16* ymix = (h16*)(ws + WS_R2);
    LAS float* so = (LAS float*)lds;
    LAS float* sy = so + 2048;
    for (int t = bid; t < T; t += nb) {
        __syncthreads();
        for (int e = tid; e < 2048; e += NTHREADS) so[e] = (float)olat[(size_t)t * 2048 + e];
        __syncthreads();
#pragma unroll
        for (int r = 0; r < 2; ++r) {
            const int o = tid + r * NTHREADS, h = o >> 7, v = o & 127;
            const float* w = p.w_uv + (size_t)h * 256 * 128 + v;
            float a = 0.f;
            for (int c = 0; c < 256; ++c) a += so[h * 256 + c] * w[(size_t)c * 128];
            sy[o] = a;
        }
        __syncthreads();
        {
            const int w = tid >> 6, lane = tid & 63;
            const float a = sy[w * 128 + lane], b2 = sy[w * 128 + 64 + lane];
            const float rstd = rsqrtf(wave_sum(a * a + b2 * b2) * (1.f / 128.f) + EPS);
            ymix[(size_t)t * 2048 + w * 128 + lane] = (h16)(a * rstd * p.attn_out_norm_g[w * 128 + lane]);
            ymix[(size_t)t * 2048 + w * 128 + 64 + lane] = (h16)(b2 * rstd * p.attn_out_norm_g[w * 128 + 64 + lane]);
        }
    }
    __syncthreads();
}

constexpr int LDS_BYTES = 160 * 1024;
constexpr int NPHASES = 13;
__global__ void __launch_bounds__(NTHREADS, 2) fwd_kernel(Params p) {
    extern __shared__ __attribute__((aligned(16))) unsigned char lds_raw[];
    LAS unsigned char* lds = (LAS unsigned char*)lds_raw;
    const int bid = blockIdx.x, nb = gridDim.x;
    unsigned char* ws = p.ws;
    float* mod = (float*)(ws + WS_MOD);
    cg::grid_group grid = cg::this_grid();
#ifndef PHASE_MASK
#define PHASE_MASK 0xFFFF
#endif
#define IN(k) (((PHASE_MASK >> (k)) & 1) && p.ph_lo <= (k) && (k) < p.ph_hi)
#define SEAM(k) do { if (IN(k) && IN((k) + 1)) grid.sync(); } while (0)
    if (IN(0)) { phase_prep(p, lds, bid, nb); } SEAM(0);
    if (IN(1)) { phase_normmod(p.x, p.norm1_g, mod, 0, 2048, (h16*)(ws + WS_R2), bid, nb); } SEAM(1);
    if (IN(2)) { EpiProj E{(float*)(ws + WS_PROJA), (h16*)(ws + WS_PROJB)}; run_gemm(lds, (const h16*)(ws + WS_R2), (const h16*)(ws + WS_BT_IN), T, N_IN, 2048, bid, nb, E); } SEAM(2);
    if (IN(3)) { phase_rows3(p, bid, nb); } SEAM(3);
    if (IN(4)) { EpiQ E{(h16*)(ws + WS_QABS), (h16*)(ws + WS_IQ)}; run_gemm(lds, (const h16*)(ws + WS_CQ), (const h16*)(ws + WS_BT_Q), T, N_Q, 512, bid, nb, E); } SEAM(4);
    if (IN(5)) { phase_qnorm(p, bid, nb); phase_index_naive(p, lds, bid, nb); } SEAM(5);
    if (IN(6)) { phase_attn_naive(p, lds, bid, nb); } SEAM(6);
    if (IN(7)) { phase_uv_naive(p, lds, bid, nb); } SEAM(7);
    if (IN(8)) { EpiOut E{p.x, mod, p.out}; run_gemm(lds, (const h16*)(ws + WS_R2), (const h16*)(ws + WS_BT_OUT), T, 2048, 2048, bid, nb, E); } SEAM(8);
    if (IN(9)) { phase_normmod(p.out, p.norm2_g, mod, 3 * 2048, 4 * 2048, (h16*)(ws + WS_R2), bid, nb); } SEAM(9);
    if (IN(10)) { EpiMlp1 E{p.b_mlp1, (h16*)(ws + WS_R3)}; run_gemm(lds, (const h16*)(ws + WS_R2), (const h16*)(ws + WS_BT_1), T, D_FF, 2048, bid, nb, E); } SEAM(10);
    if (IN(11)) { EpiMlp2 E{p.b_mlp2, mod, p.out}; run_gemm(lds, (const h16*)(ws + WS_R3), (const h16*)(ws + WS_BT_2), T, 2048, D_FF, bid, nb, E); }
}

#ifndef N_LAUNCH_MODE
#define N_LAUNCH_MODE 0
#endif
extern "C" void kernel_launch(void* const* d_in, const int* in_sizes, int n_in, void* d_out, int out_size, void* d_ws, size_t ws_size, hipStream_t stream) {
    static int grid = 0;
    if (grid == 0) {
        if (ws_size < WS_END) { fprintf(stderr, "kernel_launch: workspace too small (%zu < %zu)\n", ws_size, (size_t)WS_END); grid = -1; return; }
        int dev = 0, cus = 0, per_cu = 0;
        hipGetDevice(&dev);
        hipDeviceGetAttribute(&cus, hipDeviceAttributeMultiprocessorCount, dev);
        if (hipFuncSetAttribute((const void*)fwd_kernel, hipFuncAttributeMaxDynamicSharedMemorySize, LDS_BYTES) != hipSuccess) { fprintf(stderr, "kernel_launch: hipFuncSetAttribute failed\n"); grid = -1; return; }
        hipOccupancyMaxActiveBlocksPerMultiprocessor(&per_cu, (const void*)fwd_kernel, NTHREADS, LDS_BYTES);
        if (per_cu < 1) { fprintf(stderr, "kernel_launch: occupancy query says %d\n", per_cu); per_cu = 1; }
        grid = cus;
        if (grid > 256) grid = 256;
    }
    if (grid < 0) return;
    Params p{};
    const float** f = (const float**)&p;
    for (int i = 0; i < 26; ++i) f[i] = (const float*)d_in[i];
    p.out = (float*)d_out; p.ws = (unsigned char*)d_ws;
#if N_LAUNCH_MODE == 1
    p.ph_lo = 0; p.ph_hi = NPHASES;
    void* args[] = {&p};
    hipError_t e = hipLaunchCooperativeKernel((const void*)fwd_kernel, dim3(grid), dim3(NTHREADS), args, LDS_BYTES, stream);
    if (e != hipSuccess) fprintf(stderr, "cooperative launch failed: %s (grid %d)\n", hipGetErrorString(e), grid);
#else
    for (int ph = 0; ph < 12; ++ph) {
        p.ph_lo = ph; p.ph_hi = ph + 1;
        hipLaunchKernelGGL(fwd_kernel, dim3(grid), dim3(NTHREADS), LDS_BYTES, stream, p);
    }
#endif
}
```

```cpp
#include <hip/hip_runtime.h>
#include <cstdio>
#include <cstdint>

#define LAS __attribute__((address_space(3)))
typedef _Float16 h16;
typedef _Float16 h16x8 __attribute__((ext_vector_type(8)));
typedef _Float16 h16x4 __attribute__((ext_vector_type(4)));
typedef _Float16 h16x2 __attribute__((ext_vector_type(2)));
typedef float f32x4 __attribute__((ext_vector_type(4)));
typedef float f32x2 __attribute__((ext_vector_type(2)));
typedef unsigned u32x4 __attribute__((ext_vector_type(4)));
typedef unsigned u32x2 __attribute__((ext_vector_type(2)));
typedef int i32x4 __attribute__((ext_vector_type(4)));

constexpr int D_MODEL = 2048, BATCH = 4, SEQ = 4096, T = BATCH * SEQ;
constexpr int ATTN_HEADS = 8, HEAD_DIM = 128, Q_LORA = 512, KV_LORA = 256, IDX_HEADS = 16, IDX_DIM = 64, TOPK = 256;
constexpr int CONV_WIDTH = 1024, D_FF = 8192, IN_COLS = 3920;
constexpr float EPS = 1e-6f;
constexpr int NTHREADS = 512, NWAVES = 8;
constexpr int N_IN = 4096;
constexpr int N_Q = 3072;

constexpr size_t MiB = (size_t)1 << 20;
constexpr size_t WS_CTL = 0;
constexpr size_t WS_MOD = 64 * 1024;
constexpr size_t WS_BT_IN = 1 * MiB;
constexpr size_t WS_BT_Q = WS_BT_IN + 16 * MiB;
constexpr size_t WS_BT_OUT = WS_BT_Q + 3 * MiB;
constexpr size_t WS_BT_1 = WS_BT_OUT + 8 * MiB;
constexpr size_t WS_BT_2 = WS_BT_1 + 32 * MiB;
constexpr size_t WS_WUVT = WS_BT_2 + 32 * MiB;
constexpr size_t WS_R2 = 93 * MiB;
constexpr size_t WS_R3 = WS_R2 + 64 * MiB;
constexpr size_t WS_PROJA = WS_R3;
constexpr size_t WS_PROJB = WS_R3 + 64 * MiB;
constexpr size_t WS_OLAT = WS_R3 + 64 * MiB;
constexpr size_t WS_QABS = WS_R3 + 160 * MiB;
constexpr size_t WS_IQ = WS_R3 + 224 * MiB;
constexpr size_t WS_R4 = WS_R3 + 256 * MiB;
constexpr size_t WS_CQ = WS_R4;
constexpr size_t WS_CKV = WS_CQ + 16 * MiB;
constexpr size_t WS_KIDX = WS_CKV + 8 * MiB;
constexpr size_t WS_WIDX = WS_KIDX + 2 * MiB;
constexpr size_t WS_SEL = WS_WIDX + 1 * MiB;
constexpr size_t WS_Y6 = WS_SEL + 8 * MiB;
constexpr size_t WS_END = WS_Y6 + 64 * MiB;

struct Params {
    const float *x, *c, *w_ada, *b_ada, *norm1_g, *norm2_g, *w_in, *cq_norm_g, *w_uq, *w_uk, *kv_norm_g, *q_abs_norm_g, *w_uv, *w_iq,
        *idx_k_norm_g, *idx_k_norm_b, *rel_bias, *conv_w, *conv_b, *attn_out_norm_g, *conv_out_norm_g, *w_out, *w_mlp1, *b_mlp1, *w_mlp2, *b_mlp2;
    float* out;
    unsigned char* ws;
    int ph_lo, ph_hi;
};

__device__ __forceinline__ float wave_sum(float v) {
#pragma unroll
    for (int o = 1; o < 64; o <<= 1) v += __shfl_xor(v, o);
    return v;
}
__device__ __forceinline__ float wave_max(float v) {
#pragma unroll
    for (int o = 1; o < 64; o <<= 1) v = fmaxf(v, __shfl_xor(v, o));
    return v;
}
#define LDS_WAIT() asm volatile("s_waitcnt lgkmcnt(0)" ::: "memory")

namespace pg8 {
constexpr int BM = 256, BK = 64, HALF = 128, HTB = HALF * BK * 2, STAGE_BYTES = 8 * HTB, NXCD = 8;
__host__ __device__ __forceinline__ int lds_byte(int r, int c) { const int st = (r >> 4) * 2 + (c >> 5), rr = r & 15, cc = c & 31, ob = rr * 64 + cc * 2; return st * 1024 + (ob ^ (((ob >> 9) & 1) << 5)); }
__host__ __device__ __forceinline__ int perm32(int rho) { const int n = rho >> 4, i = rho & 15; return 8 * (i >> 2) + 4 * n + (i & 3); }
__host__ __device__ __forceinline__ void stage_rc(int b, int& R, int& C) { const int st = b / 1024, sb = b % 1024, swz = sb ^ (((sb >> 9) & 1) << 5); R = (st >> 1) * 16 + swz / 64; C = (st & 1) * 32 + (swz % 64) / 2; }
struct Unit { int pm, pn; };
struct Gemm { const h16* A; const h16* Bt; int M, N, K; };
struct StaticOrder {
    int nM, nN, nwg, G, c, WGM;
    __host__ __device__ void init(int M, int N, int G_, int c_, int wgm) { nM = M / BM; nN = N / BM; nwg = nM * nN; G = G_; c = c_; WGM = wgm; }
    __host__ __device__ bool next(int i, Unit& u) const {
        const long L = (long)i * G + c; if (L >= nwg) return false;
        int wgid = (int)L; { const int q = nwg / NXCD, r = nwg % NXCD, xcd = wgid % NXCD, off = wgid / NXCD; wgid = (xcd < r ? xcd * (q + 1) : r * (q + 1) + (xcd - r) * q) + off; }
        const int nig = WGM * nN, gid = wgid / nig, fm = gid * WGM, gsz = (nM - fm) < WGM ? (nM - fm) : WGM;
        u.pm = fm + ((wgid % nig) % gsz); u.pn = (wgid % nig) / gsz; return true;
    }
};

#ifndef PG8_SP2
#define PG8_SP2 true
#endif
#ifndef PG8_ALIGN
#define PG8_ALIGN true
#endif
template <class Epi, bool ALIGN_EPI = PG8_ALIGN, bool SP2 = PG8_SP2>
__device__ __forceinline__ void gemm_phase(LAS unsigned char* lds, const Gemm g, const StaticOrder& S, const Epi& E) {
    const int tid = threadIdx.x, wid = __builtin_amdgcn_readfirstlane(tid >> 6), lane = tid & 63, wr = wid >> 2, wc = wid & 3, fr = lane & 15, fq = lane >> 4;
    const int K = g.K, nt = K / BK;
    unsigned voffA[2], voffB[2];
#pragma unroll
    for (int i = 0; i < 2; ++i) { int R, C; stage_rc(tid * 16 + i * 8192, R, C); const int Rb = Epi::PERM ? ((R & ~31) + perm32(R & 31)) : R; voffA[i] = (unsigned)(R * K + C) * 2u; voffB[i] = (unsigned)(Rb * K + C) * 2u; }
    const size_t kstep = (size_t)(BK * 2);
    const size_t hstep = (size_t)HALF * K * 2;
    const size_t tstep = 2 * hstep;
    const unsigned ldsw = (unsigned)wid * 1024u;
    const int aoff = lds_byte(wr * 64 + fr, fq * 8), boff = lds_byte(wc * 32 + fr, fq * 8);
#define PG8_SA(b, h) (((b) * 2 + (h)) * HTB)
#define PG8_SB(b, h) ((4 + (b) * 2 + (h)) * HTB)
#define PG8_STAGE(bufoff, gbase, voff) do { _Pragma("unroll") for (int _i = 0; _i < 2; ++_i) \
        __builtin_amdgcn_global_load_lds((const unsigned*)((const char*)(gbase) + (voff)[_i]), (LAS unsigned*)(lds + (bufoff) + ldsw + _i * 8192), 16, 0, 0); } while (0)
#define PG8_LDA(dst, b, h) do { _Pragma("unroll") for (int m = 0; m < 4; ++m) _Pragma("unroll") for (int k = 0; k < 2; ++k) dst[m][k] = *(const LAS h16x8*)(lds + PG8_SA(b, h) + aoff + m * 2048 + k * 1024); } while (0)
#define PG8_LDB(dst, b, h) do { _Pragma("unroll") for (int n = 0; n < 2; ++n) _Pragma("unroll") for (int k = 0; k < 2; ++k) dst[n][k] = *(const LAS h16x8*)(lds + PG8_SB(b, h) + boff + n * 2048 + k * 1024); } while (0)
#define PG8_MMA(ai, bj, At, Bt) do { __builtin_amdgcn_s_setprio(1); _Pragma("unroll") for (int m = 0; m < 4; ++m) _Pragma("unroll") for (int n = 0; n < 2; ++n) _Pragma("unroll") for (int k = 0; k < 2; ++k) \
        acc[ai][bj][m][n] = __builtin_amdgcn_mfma_f32_16x16x32_f16(Bt[n][k], At[m][k], acc[ai][bj][m][n], 0, 0, 0); __builtin_amdgcn_s_setprio(0); } while (0)
#define PG8_WAIT_V(n) asm volatile("s_waitcnt vmcnt(" #n ")" ::: "memory")
#define PG8_WAIT_L(n) asm volatile("s_waitcnt lgkmcnt(" #n ")" ::: "memory")
#define PG8_BAR __builtin_amdgcn_s_barrier()
#define PG8_SCHED __builtin_amdgcn_sched_barrier(0)
    Unit cur, nxt; int ui = 0;
    if (!S.next(0, cur)) return;
    f32x4 acc[2][2][4][2];
#pragma unroll
    for (int a = 0; a < 2; ++a)
#pragma unroll
        for (int b = 0; b < 2; ++b)
#pragma unroll
            for (int m = 0; m < 4; ++m)
#pragma unroll
                for (int n = 0; n < 2; ++n) acc[a][b][m][n] = (f32x4){0.f, 0.f, 0.f, 0.f};
    h16x8 At[4][2], B0[2][2], B1[2][2];
    const char* cA = (const char*)g.A + (size_t)cur.pm * tstep; const char* cB = (const char*)g.Bt + (size_t)cur.pn * tstep;
    if constexpr (SP2) {
        PG8_STAGE(PG8_SB(0, 0), cB, voffB); PG8_STAGE(PG8_SB(0, 1), cB + hstep, voffB); PG8_STAGE(PG8_SA(0, 0), cA, voffA); PG8_STAGE(PG8_SA(0, 1), cA + hstep, voffA);
        if (wr == 1) PG8_BAR;
        PG8_WAIT_V(2); PG8_BAR;
        PG8_STAGE(PG8_SB(1, 0), cB + kstep, voffB); PG8_STAGE(PG8_SA(1, 0), cA + kstep, voffA); PG8_STAGE(PG8_SB(1, 1), cB + hstep + kstep, voffB);
        PG8_WAIT_V(6); PG8_BAR;
    } else {
        PG8_STAGE(PG8_SB(0, 0), cB, voffB); PG8_STAGE(PG8_SA(0, 0), cA, voffA); PG8_STAGE(PG8_SB(0, 1), cB + hstep, voffB); PG8_STAGE(PG8_SA(0, 1), cA + hstep, voffA);
        if (wr == 1) PG8_BAR;
        PG8_WAIT_V(4); PG8_BAR;
        PG8_STAGE(PG8_SB(1, 0), cB + kstep, voffB); PG8_STAGE(PG8_SA(1, 0), cA + kstep, voffA); PG8_STAGE(PG8_SB(1, 1), cB + hstep + kstep, voffB);
        PG8_WAIT_V(6); PG8_BAR;
    }
    for (;;) {
        const bool has_next = S.next(ui + 1, nxt);
        const char* nA = has_next ? (const char*)g.A + (size_t)nxt.pm * tstep : cA; const char* nB = has_next ? (const char*)g.Bt + (size_t)nxt.pn * tstep : cB;
        for (int t = 0; t < nt; t += 2) {
            const bool last = (t == nt - 2);
            const char* a1 = cA + (size_t)(t + 1) * kstep;
            const char* a2 = last ? nA : cA + (size_t)(t + 2) * kstep; const char* b2 = last ? nB : cB + (size_t)(t + 2) * kstep;
            const char* a3 = a2 + kstep; const char* b3 = b2 + kstep;
            if constexpr (SP2) {
            PG8_LDB(B0, 0, 0); PG8_LDB(B1, 0, 1); PG8_SCHED; PG8_LDA(At, 0, 0); PG8_STAGE(PG8_SA(1, 1), a1 + hstep, voffA);
            PG8_WAIT_V(8); PG8_WAIT_L(0); PG8_BAR; PG8_MMA(0, 0, At, B0); PG8_MMA(0, 1, At, B1); PG8_BAR; PG8_SCHED;
            PG8_LDA(At, 0, 1); PG8_STAGE(PG8_SB(0, 0), b2, voffB); PG8_STAGE(PG8_SB(0, 1), b2 + hstep, voffB); PG8_STAGE(PG8_SA(0, 0), a2, voffA);
            PG8_WAIT_V(8); PG8_WAIT_L(0); PG8_BAR; PG8_MMA(1, 0, At, B0); PG8_MMA(1, 1, At, B1); PG8_BAR; PG8_SCHED;
            PG8_LDB(B0, 1, 0); PG8_LDB(B1, 1, 1); PG8_SCHED; PG8_LDA(At, 1, 0); PG8_STAGE(PG8_SA(0, 1), a2 + hstep, voffA);
            PG8_WAIT_V(8); PG8_WAIT_L(0); PG8_BAR; PG8_MMA(0, 0, At, B0); PG8_MMA(0, 1, At, B1); PG8_BAR; PG8_SCHED;
            PG8_LDA(At, 1, 1); PG8_STAGE(PG8_SB(1, 0), b3, voffB); PG8_STAGE(PG8_SB(1, 1), b3 + hstep, voffB); PG8_STAGE(PG8_SA(1, 0), a3, voffA);
            PG8_WAIT_V(8); PG8_WAIT_L(0); PG8_BAR; PG8_MMA(1, 0, At, B0); PG8_MMA(1, 1, At, B1); PG8_BAR; PG8_SCHED;
            } else {
            PG8_LDB(B0, 0, 0); PG8_SCHED; PG8_LDA(At, 0, 0); PG8_STAGE(PG8_SA(1, 1), a1 + hstep, voffA);
            PG8_WAIT_L(8); PG8_BAR; PG8_WAIT_L(0); PG8_MMA(0, 0, At, B0); PG8_BAR; PG8_SCHED;
            PG8_LDB(B1, 0, 1); PG8_STAGE(PG8_SB(0, 0), b2, voffB);
            PG8_BAR; PG8_WAIT_L(0); PG8_MMA(0, 1, At, B1); PG8_BAR;
            PG8_LDA(At, 0, 1); PG8_STAGE(PG8_SA(0, 0), a2, voffA);
            PG8_BAR; PG8_WAIT_L(0); PG8_MMA(1, 0, At, B0); PG8_BAR; PG8_SCHED;
            PG8_STAGE(PG8_SB(0, 1), b2 + hstep, voffB);
            PG8_WAIT_V(6); PG8_BAR; PG8_MMA(1, 1, At, B1); PG8_BAR;
            PG8_LDB(B0, 1, 0); PG8_SCHED; PG8_LDA(At, 1, 0); PG8_STAGE(PG8_SA(0, 1), a2 + hstep, voffA);
            PG8_WAIT_L(8); PG8_BAR; PG8_WAIT_L(0); PG8_MMA(0, 0, At, B0); PG8_BAR; PG8_SCHED;
            PG8_LDB(B1, 1, 1); PG8_STAGE(PG8_SB(1, 0), b3, voffB);
            PG8_BAR; PG8_WAIT_L(0); PG8_MMA(0, 1, At, B1); PG8_BAR;
            PG8_LDA(At, 1, 1); PG8_STAGE(PG8_SA(1, 0), a3, voffA);
            PG8_BAR; PG8_WAIT_L(0); PG8_MMA(1, 0, At, B0); PG8_BAR; PG8_SCHED;
            PG8_STAGE(PG8_SB(1, 1), b3 + hstep, voffB);
            PG8_WAIT_V(6); PG8_BAR; PG8_MMA(1, 1, At, B1); PG8_BAR;
            }
        }
        if constexpr (ALIGN_EPI) { if (wr == 0) PG8_BAR; }
        if constexpr (Epi::CUSTOM) { E.run(acc, cur, wr, wc, fr, fq, lds); }
        else if constexpr (Epi::PERM) {
            const int row0 = cur.pm * BM + wr * 64 + fr, col0 = cur.pn * BM + wc * 32 + 8 * fq;
            E.begin_unit(cur.pn, col0);
#pragma unroll
            for (int ai = 0; ai < 2; ++ai)
#pragma unroll
                for (int m = 0; m < 4; ++m)
#pragma unroll
                    for (int bj = 0; bj < 2; ++bj) E.store8(row0 + ai * HALF + m * 16, col0 + bj * HALF, acc[ai][bj][m][0], acc[ai][bj][m][1]);
        } else {
            const int row0 = cur.pm * BM + wr * 64 + fr, col0 = cur.pn * BM + wc * 32 + 4 * fq;
#pragma unroll
            for (int ai = 0; ai < 2; ++ai)
#pragma unroll
                for (int m = 0; m < 4; ++m)
#pragma unroll
                    for (int bj = 0; bj < 2; ++bj)
#pragma unroll
                        for (int n = 0; n < 2; ++n) E.store4(row0 + ai * HALF + m * 16, col0 + bj * HALF + n * 16, acc[ai][bj][m][n]);
        }
        if (!has_next) break;
#pragma unroll
        for (int a = 0; a < 2; ++a)
#pragma unroll
            for (int b = 0; b < 2; ++b)
#pragma unroll
                for (int m = 0; m < 4; ++m)
#pragma unroll
                    for (int n = 0; n < 2; ++n) acc[a][b][m][n] = (f32x4){0.f, 0.f, 0.f, 0.f};
        cur = nxt; cA = nA; cB = nB; ++ui;
        if constexpr (ALIGN_EPI) { if (wr == 1) PG8_BAR; }
    }
    PG8_WAIT_V(0);
    if constexpr (!ALIGN_EPI) { if (wr == 0) PG8_BAR; }
    PG8_BAR;
#undef PG8_SA
#undef PG8_SB
#undef PG8_STAGE
#undef PG8_LDA
#undef PG8_LDB
#undef PG8_MMA
#undef PG8_WAIT_V
#undef PG8_WAIT_L
#undef PG8_BAR
#undef PG8_SCHED
}

}

template <class Epi>
__device__ __forceinline__ void run_gemm(LAS unsigned char* lds, const h16* A, const h16* Bt, int M, int N, int K, int bid, int nb, const Epi& E, int wgm) {
    pg8::Gemm g{A, Bt, M, N, K};
    pg8::StaticOrder S; S.init(M, N, nb, bid, wgm);
    pg8::gemm_phase(lds, g, S, E);
}

__device__ __forceinline__ u32x2 pack_h4(f32x4 v) {
    h16x2 a = {(h16)v[0], (h16)v[1]}, b = {(h16)v[2], (h16)v[3]};
    u32x2 r; r.x = __builtin_bit_cast(unsigned, a); r.y = __builtin_bit_cast(unsigned, b); return r;
}

__device__ __forceinline__ u32x4 pack_h8(f32x4 a, f32x4 b) { const u32x2 x = pack_h4(a), y = pack_h4(b); return (u32x4){x.x, x.y, y.x, y.y}; }
struct EpiProj {
    static constexpr bool PERM = true, CUSTOM = true;
    h16* cq; float* ssq; h16* ckv; h16* kidx; float* widx; h16* projB; const float* gkv; const float* gk; const float* bk;
    __device__ __forceinline__ void run(const f32x4 (&acc)[2][2][4][2], const pg8::Unit& u, int wr, int wc, int fr, int fq, LAS unsigned char* lds) const {
        const int row0 = u.pm * 256 + wr * 64 + fr, cin = wc * 32 + 8 * fq;
        if (u.pn >= 4) {
            h16* base = projB + (size_t)row0 * 3072 + (u.pn - 4) * 256 + cin;
#pragma unroll
            for (int ai = 0; ai < 2; ++ai)
#pragma unroll
                for (int m = 0; m < 4; ++m)
#pragma unroll
                    for (int bj = 0; bj < 2; ++bj) *(u32x4*)(base + (size_t)(ai * 128 + m * 16) * 3072 + bj * 128) = pack_h8(acc[ai][bj][m][0], acc[ai][bj][m][1]);
            return;
        }
        LAS float* P = (LAS float*)(lds + 131072);
        if (u.pn == 3) {
            if (wc < 2) {
#pragma unroll
                for (int ai = 0; ai < 2; ++ai)
#pragma unroll
                    for (int m = 0; m < 4; ++m) {
                        const f32x4 a = acc[ai][0][m][0], b = acc[ai][0][m][1];
                        float sm = (a[0] + a[1]) + (a[2] + a[3]) + (b[0] + b[1]) + (b[2] + b[3]);
                        float sq = (a[0] * a[0] + a[1] * a[1]) + (a[2] * a[2] + a[3] * a[3]) + (b[0] * b[0] + b[1] * b[1]) + (b[2] * b[2] + b[3] * b[3]);
                        sm += __shfl_xor(sm, 16); sm += __shfl_xor(sm, 32); sq += __shfl_xor(sq, 16); sq += __shfl_xor(sq, 32);
                        if (fq == 0) *(LAS f32x2*)(P + ((ai * 128 + wr * 64 + m * 16 + fr) * 2 + wc) * 2) = (f32x2){sm, sq};
                    }
            }
            asm volatile("s_waitcnt lgkmcnt(0)" ::: "memory"); __builtin_amdgcn_s_barrier(); asm volatile("" ::: "memory");
            if (wc < 2) {
                const f32x4 g0 = *(const f32x4*)(gk + cin), g1 = *(const f32x4*)(gk + cin + 4), b0 = *(const f32x4*)(bk + cin), b1 = *(const f32x4*)(bk + cin + 4);
#pragma unroll
                for (int ai = 0; ai < 2; ++ai)
#pragma unroll
                    for (int m = 0; m < 4; ++m) {
                        const f32x4 pp = *(const LAS f32x4*)(P + (ai * 128 + wr * 64 + m * 16 + fr) * 4);
                        const float mean = (pp[0] + pp[2]) * (1.f / 64.f);
                        const f32x4 xa = acc[ai][0][m][0] - mean, xb = acc[ai][0][m][1] - mean;
                        const float var = fmaxf((pp[1] + pp[3]) * (1.f / 64.f) - mean * mean, 0.f);
                        const float rstd = rsqrtf(var + EPS);
                        *(u32x4*)(kidx + (size_t)(row0 + ai * 128 + m * 16) * 64 + cin) = pack_h8(xa * rstd * g0 + b0, xb * rstd * g1 + b1);
                    }
            } else if (wc == 2 && fq < 2) {
#pragma unroll
                for (int ai = 0; ai < 2; ++ai)
#pragma unroll
                    for (int m = 0; m < 4; ++m) {
                        float* o = widx + (size_t)(row0 + ai * 128 + m * 16) * 16 + 8 * fq;
                        *(f32x4*)o = acc[ai][0][m][0] * (1.f / 32.f); *(f32x4*)(o + 4) = acc[ai][0][m][1] * (1.f / 32.f);
                    }
            }
            return;
        }
#pragma unroll
        for (int ai = 0; ai < 2; ++ai)
#pragma unroll
            for (int m = 0; m < 4; ++m) {
                float ss = 0.f;
#pragma unroll
                for (int bj = 0; bj < 2; ++bj)
#pragma unroll
                    for (int n = 0; n < 2; ++n) { const f32x4 v = acc[ai][bj][m][n]; ss += (v[0] * v[0] + v[1] * v[1]) + (v[2] * v[2] + v[3] * v[3]); }
                ss += __shfl_xor(ss, 16); ss += __shfl_xor(ss, 32);
                if (fq == 0) P[(ai * 128 + wr * 64 + m * 16 + fr) * 4 + wc] = ss;
            }
        asm volatile("s_waitcnt lgkmcnt(0)" ::: "memory"); __builtin_amdgcn_s_barrier(); asm volatile("" ::: "memory");
        if (u.pn < 2) {
            h16* base = cq + (size_t)row0 * 512 + u.pn * 256 + cin;
#pragma unroll
            for (int ai = 0; ai < 2; ++ai)
#pragma unroll
                for (int m = 0; m < 4; ++m) {
#pragma unroll
                    for (int bj = 0; bj < 2; ++bj) *(u32x4*)(base + (size_t)(ai * 128 + m * 16) * 512 + bj * 128) = pack_h8(acc[ai][bj][m][0], acc[ai][bj][m][1]);
                    if (wc == 0 && fq == 0) { const f32x4 pp = *(const LAS f32x4*)(P + (ai * 128 + wr * 64 + m * 16 + fr) * 4); ssq[(size_t)(row0 + ai * 128 + m * 16) * 2 + u.pn] = (pp[0] + pp[1]) + (pp[2] + pp[3]); }
                }
        } else {
            h16* base = ckv + (size_t)row0 * 256 + cin;
            f32x4 g[2][2];
#pragma unroll
            for (int bj = 0; bj < 2; ++bj)
#pragma unroll
                for (int n = 0; n < 2; ++n) g[bj][n] = *(const f32x4*)(gkv + cin + bj * 128 + 4 * n);
#pragma unroll
            for (int ai = 0; ai < 2; ++ai)
#pragma unroll
                for (int m = 0; m < 4; ++m) {
                    const f32x4 pp = *(const LAS f32x4*)(P + (ai * 128 + wr * 64 + m * 16 + fr) * 4);
                    const float rstd = rsqrtf(((pp[0] + pp[1]) + (pp[2] + pp[3])) * (1.f / 256.f) + EPS);
#pragma unroll
                    for (int bj = 0; bj < 2; ++bj) *(u32x4*)(base + (size_t)(ai * 128 + m * 16) * 256 + bj * 128) = pack_h8(acc[ai][bj][m][0] * rstd * g[bj][0], acc[ai][bj][m][1] * rstd * g[bj][1]);
                }
        }
    }
};
struct EpiQ {
    static constexpr bool PERM = true, CUSTOM = true;
    h16* qabs; h16* iq; const float* gq; const float* ssq;
    __device__ __forceinline__ void run(const f32x4 (&acc)[2][2][4][2], const pg8::Unit& u, int wr, int wc, int fr, int fq, LAS unsigned char* lds) const {
        const int row0 = u.pm * 256 + wr * 64 + fr, cin = wc * 32 + 8 * fq;
        float rr[2][4];
#pragma unroll
        for (int ai = 0; ai < 2; ++ai)
#pragma unroll
            for (int m = 0; m < 4; ++m) { const f32x2 s2 = *(const f32x2*)(ssq + (size_t)(row0 + ai * 128 + m * 16) * 2); rr[ai][m] = rsqrtf((s2[0] + s2[1]) * (1.f / 512.f) + EPS); }
        if (u.pn >= 8) {
            h16* base = iq + (size_t)row0 * 1024 + (u.pn - 8) * 256 + cin;
#pragma unroll
            for (int ai = 0; ai < 2; ++ai)
#pragma unroll
                for (int m = 0; m < 4; ++m)
#pragma unroll
                    for (int bj = 0; bj < 2; ++bj) *(u32x4*)(base + (size_t)(ai * 128 + m * 16) * 1024 + bj * 128) = pack_h8(acc[ai][bj][m][0] * rr[ai][m], acc[ai][bj][m][1] * rr[ai][m]);
            return;
        }
        LAS float* P = (LAS float*)(lds + 131072);
#pragma unroll
        for (int ai = 0; ai < 2; ++ai)
#pragma unroll
            for (int m = 0; m < 4; ++m) {
                float ss = 0.f;
#pragma unroll
                for (int bj = 0; bj < 2; ++bj)
#pragma unroll
                    for (int n = 0; n < 2; ++n) { const f32x4 v = acc[ai][bj][m][n]; ss += (v[0] * v[0] + v[1] * v[1]) + (v[2] * v[2] + v[3] * v[3]); }
                ss += __shfl_xor(ss, 16); ss += __shfl_xor(ss, 32);
                if (fq == 0) P[(ai * 128 + wr * 64 + m * 16 + fr) * 4 + wc] = ss * (rr[ai][m] * rr[ai][m]);
            }
        asm volatile("s_waitcnt lgkmcnt(0)" ::: "memory"); __builtin_amdgcn_s_barrier(); asm volatile("" ::: "memory");
        h16* base = qabs + (size_t)row0 * 2048 + u.pn * 256 + cin;
        f32x4 g[2][2];
#pragma unroll
        for (int bj = 0; bj < 2; ++bj)
#pragma unroll
            for (int n = 0; n < 2; ++n) g[bj][n] = *(const f32x4*)(gq + cin + bj * 128 + 4 * n) * 0.0625f;
#pragma unroll
        for (int ai = 0; ai < 2; ++ai)
#pragma unroll
            for (int m = 0; m < 4; ++m) {
                const f32x4 pp = *(const LAS f32x4*)(P + (ai * 128 + wr * 64 + m * 16 + fr) * 4);
                const float rstd = rsqrtf(((pp[0] + pp[1]) + (pp[2] + pp[3])) * (1.f / 256.f) + EPS) * rr[ai][m];
#pragma unroll
                for (int bj = 0; bj < 2; ++bj) *(u32x4*)(base + (size_t)(ai * 128 + m * 16) * 2048 + bj * 128) = pack_h8(acc[ai][bj][m][0] * rstd * g[bj][0], acc[ai][bj][m][1] * rstd * g[bj][1]);
            }
    }
};
struct EpiF16 {
    static constexpr bool PERM = true, CUSTOM = false;
    h16* o; const float* bias; mutable f32x4 bz[2][2]; mutable int cbase;
    __device__ __forceinline__ void begin_unit(int, int col0) const {
        cbase = col0;
#pragma unroll
        for (int bj = 0; bj < 2; ++bj)
#pragma unroll
            for (int n = 0; n < 2; ++n) bz[bj][n] = bias ? *(const f32x4*)(bias + col0 + bj * 128 + 4 * n) : (f32x4){0.f, 0.f, 0.f, 0.f};
    }
    __device__ __forceinline__ void store8(int row, int col, f32x4 v0, f32x4 v1) const {
        const int bj = (col - cbase) >> 7;
        *(u32x4*)(o + (size_t)row * 2048 + col) = pack_h8(v0 + (bj ? bz[1][0] : bz[0][0]), v1 + (bj ? bz[1][1] : bz[0][1]));
    }
};
struct EpiMlp1 {
    static constexpr bool PERM = true, CUSTOM = false;
    LAS const h16* b1l; h16* a; mutable f32x4 bz[2][2]; mutable int cbase;
    __device__ __forceinline__ void begin_unit(int, int col0) const {
        cbase = col0;
#pragma unroll
        for (int bj = 0; bj < 2; ++bj)
#pragma unroll
            for (int n = 0; n < 2; ++n) { const h16x4 hb = *(LAS const h16x4*)(b1l + col0 + bj * 128 + 4 * n); bz[bj][n] = (f32x4){(float)hb[0], (float)hb[1], (float)hb[2], (float)hb[3]}; }
    }
    __device__ __forceinline__ f32x4 actb(f32x4 v, f32x4 b) const {
        f32x4 z = v + b;
#pragma unroll
        for (int j = 0; j < 4; ++j) { const float r = fmaxf(z[j], 0.f); z[j] = r * r; }
        return z;
    }
    __device__ __forceinline__ void store8(int row, int col, f32x4 v0, f32x4 v1) const {
        const int bj = (col - cbase) >> 7;
        *(u32x4*)(a + (size_t)row * D_FF + col) = pack_h8(actb(v0, bj ? bz[1][0] : bz[0][0]), actb(v1, bj ? bz[1][1] : bz[0][1]));
    }
};
template <bool SCALE>
__device__ __forceinline__ void transpose_item(const float* __restrict__ src, int ld, int k0, int n0, int nvalid, const float* __restrict__ kscale,
                                               h16* __restrict__ dst, int dst_ld, int dst_row0, int dst_k0, LAS float* scr, int lane) {
    const int n = lane & 31, nn = n < nvalid ? n : nvalid - 1;
    const float msk = n < nvalid ? 1.f : 0.f;
    const float* sp = src + (size_t)(k0 + (lane >> 5)) * ld + n0 + nn;
    float v[32];
#pragma unroll
    for (int i = 0; i < 32; ++i) v[i] = sp[(size_t)(2 * i) * ld];
    if (SCALE) {
        float sc[32];
#pragma unroll
        for (int i = 0; i < 32; ++i) sc[i] = kscale[k0 + 2 * i + (lane >> 5)];
#pragma unroll
        for (int i = 0; i < 32; ++i) v[i] *= sc[i];
    }
#pragma unroll
    for (int i = 0; i < 32; ++i) scr[(2 * i + (lane >> 5)) * 33 + n] = v[i] * msk;
    LDS_WAIT(); asm volatile("" ::: "memory");
    const int c = lane & 7;
#pragma unroll
    for (int j = 0; j < 4; ++j) {
        const int nr = (lane >> 3) + 8 * j; const LAS float* s = scr + (8 * c) * 33 + nr;
        h16x8 o;
#pragma unroll
        for (int q = 0; q < 8; ++q) o[q] = (h16)s[q * 33];
        *(h16x8*)(dst + (size_t)(dst_row0 + nr) * dst_ld + dst_k0 + 8 * c) = o;
    }
    LDS_WAIT(); asm volatile("" ::: "memory");
}

__device__ __forceinline__ void phase_prep(const Params& p, LAS unsigned char* lds, int bid, int nb) {
    const int tid = threadIdx.x, lane = tid & 63, wave = tid >> 6;
    unsigned char* ws = p.ws;
    __syncthreads();
    {
        LAS f32x4* cact = (LAS f32x4*)lds;
        LAS float* red = (LAS float*)(lds + 32768);
        for (int i = tid; i < 4 * 2048; i += NTHREADS) { const int b = i >> 11, k = i & 2047; const float v = p.c[b * 2048 + k]; ((LAS float*)cact)[k * 4 + b] = v / (1.f + __expf(-v)); }
        __syncthreads();
        float* mod = (float*)(ws + WS_MOD);
        for (int cgp = bid; cgp < 192; cgp += nb) {
            const int col = cgp * 64 + lane;
            float a0 = 0.f, a1 = 0.f, a2 = 0.f, a3 = 0.f;
            const float* wp = p.w_ada + (size_t)(wave * 256) * 12288 + col;
            for (int kb = 0; kb < 256; kb += 32) {
                float wv[32];
#pragma unroll
                for (int j = 0; j < 32; ++j) wv[j] = wp[(size_t)(kb + j) * 12288];
#pragma unroll
                for (int j = 0; j < 32; ++j) { const f32x4 cv = cact[wave * 256 + kb + j]; a0 += cv[0] * wv[j]; a1 += cv[1] * wv[j]; a2 += cv[2] * wv[j]; a3 += cv[3] * wv[j]; }
            }
            red[(wave * 4 + 0) * 64 + lane] = a0; red[(wave * 4 + 1) * 64 + lane] = a1; red[(wave * 4 + 2) * 64 + lane] = a2; red[(wave * 4 + 3) * 64 + lane] = a3;
            __syncthreads();
            if (tid < 256) {
                const int b = tid >> 6, l = tid & 63; float s = 0.f;
#pragma unroll
                for (int w = 0; w < 8; ++w) s += red[(w * 4 + b) * 64 + l];
                const int cc = cgp * 64 + l;
                mod[b * 12288 + cc] = s + p.b_ada[cc];
            }
            __syncthreads();
        }
    }
    LAS float* scr = (LAS float*)(lds + wave * 16384);
    const int gw = bid * NWAVES + wave, NGW = nb * NWAVES;
    constexpr int I_IN = 32 * 128, I_1 = 32 * 256, I_2 = 128 * 64, I_OUT = 32 * 64, I_IQ = 8 * 32, I_UV = 8 * 4 * 4, I_QA = 8 * 8 * 8;
    constexpr int NITEMS = I_IN + I_1 + I_2 + I_OUT + I_IQ + I_UV + I_QA;
    const bool bal = (nb == 256);
    const int nextra = bal ? 6 : 0, base_it = bal ? 3072 : 0;
    const int nstr = (NITEMS - I_QA - base_it - gw + NGW - 1) / NGW;
    for (int kk = 0; kk < nextra + nstr; ++kk) {
        int it;
        if (kk < nextra) { if (bid < 192) continue; it = ((bid - 192) * NWAVES + wave) + 512 * kk; }
        else it = base_it + gw + (kk - nextra) * NGW;
        int r = it;
        const float* src; int ld, k0, n0, nvalid = 32, dld, drow0; const float* ksc = nullptr; h16* dst;
        if (r < I_IN) {
            const int kb = r / 128, nbk = r % 128, n0d = nbk * 32;
            if (n0d >= 864 && n0d < 1024) continue;
            src = p.w_in; ld = IN_COLS; k0 = kb * 64; n0 = n0d < 1024 ? n0d : n0d - 176; nvalid = (n0d == 832) ? 16 : 32; dst = (h16*)(ws + WS_BT_IN); dld = 2048; drow0 = n0d;
        } else if ((r -= I_IN) < I_1) { const int kb = r / 256, nbk = r % 256; src = p.w_mlp1; ld = D_FF; k0 = kb * 64; n0 = nbk * 32; dst = (h16*)(ws + WS_BT_1); dld = 2048; drow0 = n0; }
        else if ((r -= I_1) < I_2) { const int kb = r / 64, nbk = r % 64; src = p.w_mlp2; ld = 2048; k0 = kb * 64; n0 = nbk * 32; dst = (h16*)(ws + WS_BT_2); dld = 8192; drow0 = n0; }
        else if ((r -= I_2) < I_OUT) { const int kb = r / 64, nbk = r % 64; src = p.w_out; ld = 2048; k0 = kb * 64; n0 = nbk * 32; dst = (h16*)(ws + WS_BT_OUT); dld = 2048; drow0 = n0; }
        else if ((r -= I_OUT) < I_IQ) { const int kb = r / 32, nbk = r % 32; src = p.w_iq; ld = 1024; k0 = kb * 64; n0 = nbk * 32; ksc = p.cq_norm_g; dst = (h16*)(ws + WS_BT_Q); dld = 512; drow0 = 2048 + n0; }
        else { r -= I_IQ; const int h = r / 16, kb = (r % 16) / 4, nbk = r % 4; src = p.w_uv + (size_t)h * 256 * 128; ld = 128; k0 = kb * 64; n0 = nbk * 32; dst = (h16*)(ws + WS_WUVT) + (size_t)h * 128 * 256; dld = 256; drow0 = n0; }
        if (ksc) transpose_item<true>(src, ld, k0, n0, nvalid, ksc, dst, dld, drow0, k0, scr, lane);
        else transpose_item<false>(src, ld, k0, n0, nvalid, ksc, dst, dld, drow0, k0, scr, lane);
    }
    for (int r = gw; r < I_QA; r += NGW) {
        {
            const int h = r / 64, kb = (r % 64) / 8, cb = r % 8, k0 = kb * 64, c0 = cb * 32;
#pragma unroll 8
            for (int e = lane; e < 128 * 32; e += 64) { const int d = e >> 5, c = e & 31; scr[e] = p.w_uk[((size_t)h * 128 + d) * 256 + c0 + c]; }
            LDS_WAIT(); asm volatile("" ::: "memory");
            float acc[32];
#pragma unroll
            for (int c = 0; c < 32; ++c) acc[c] = 0.f;
            const float* uq = p.w_uq + (size_t)(k0 + lane) * 1024 + h * 128;
#pragma unroll 1
            for (int d0 = 0; d0 < 128; d0 += 4) {
                const f32x4 a = *(const f32x4*)(uq + d0);
#pragma unroll
                for (int dd = 0; dd < 4; ++dd) {
#pragma unroll
                    for (int c4 = 0; c4 < 8; ++c4) { const f32x4 w = *(const LAS f32x4*)(scr + (d0 + dd) * 32 + c4 * 4);
                        acc[c4 * 4 + 0] += a[dd] * w[0]; acc[c4 * 4 + 1] += a[dd] * w[1]; acc[c4 * 4 + 2] += a[dd] * w[2]; acc[c4 * 4 + 3] += a[dd] * w[3]; }
                    asm volatile("" ::: "memory");
                }
            }
            const float gk = p.cq_norm_g[k0 + lane];
            h16* dst = (h16*)(ws + WS_BT_Q);
            h16* dp = dst + (size_t)(h * 256 + c0) * 512 + k0 + lane;
#pragma unroll
            for (int c = 0; c < 32; ++c) { dp[(size_t)c * 512] = (h16)(acc[c] * gk); if ((c & 3) == 3) asm volatile("" ::: "memory"); }
            LDS_WAIT(); asm volatile("" ::: "memory");
        }
    }
    {
        u32x4* z = (u32x4*)((h16*)(ws + WS_BT_IN) + (size_t)848 * 2048);
        const int n16 = 176 * 2048 * 2 / 16;
        for (int i = bid * NTHREADS + tid; i < n16; i += nb * NTHREADS) z[i] = (u32x4){0u, 0u, 0u, 0u};
    }
}

__device__ __forceinline__ void phase_normmod(const float* __restrict__ xin, const float* __restrict__ g, const float* __restrict__ mod, int sh_off, int sc_off, h16* __restrict__ hout, int bid, int nb) {
    const int tid = threadIdx.x, lane = tid & 63, wave = tid >> 6;
    for (int t = bid * NWAVES + wave; t < T; t += nb * NWAVES) {
        const int b = t >> 12;
        const f32x4* xr = (const f32x4*)(xin + (size_t)t * 2048) + lane;
        f32x4 v[8]; float ss = 0.f;
#pragma unroll
        for (int j = 0; j < 8; ++j) { v[j] = xr[64 * j]; ss += (v[j][0] * v[j][0] + v[j][1] * v[j][1]) + (v[j][2] * v[j][2] + v[j][3] * v[j][3]); }
        const float rstd = rsqrtf(wave_sum(ss) * (1.f / 2048.f) + EPS);
        const float* mb = mod + b * 12288;
        u32x2* o = (u32x2*)(hout + (size_t)t * 2048) + lane;
#pragma unroll
        for (int j = 0; j < 8; ++j) {
            const int d = (lane + 64 * j) * 4;
            const f32x4 gg = *(const f32x4*)(g + d), sc = *(const f32x4*)(mb + sc_off + d), sh = *(const f32x4*)(mb + sh_off + d);
            f32x4 y = (v[j] * rstd) * gg;
            y = y * (sc + 1.f) + sh;
            o[64 * j] = pack_h4(y);
        }
    }
}

__device__ __forceinline__ void phase_normmod2(const Params& p, int bid, int nb) {
    const int tid = threadIdx.x, lane = tid & 63, wave = tid >> 6;
    const float* mod = (const float*)(p.ws + WS_MOD); const h16* y6 = (const h16*)(p.ws + WS_Y6); h16* hout = (h16*)(p.ws + WS_R2);
    for (int t = bid * NWAVES + wave; t < T; t += nb * NWAVES) {
        const int b = t >> 12; const float* mb = mod + b * 12288;
        const f32x4* xr = (const f32x4*)(p.x + (size_t)t * 2048) + lane;
        const u32x2* yr = (const u32x2*)(y6 + (size_t)t * 2048) + lane;
        f32x4 v[8]; float ss = 0.f;
#pragma unroll
        for (int j = 0; j < 8; ++j) {
            const int d = (lane + 64 * j) * 4;
            const f32x4 xv = xr[64 * j]; const h16x4 yh = __builtin_bit_cast(h16x4, yr[64 * j]); const f32x4 g1 = *(const f32x4*)(mb + 2 * 2048 + d);
            const f32x4 yv = {(float)yh[0], (float)yh[1], (float)yh[2], (float)yh[3]};
            v[j] = xv + g1 * yv;
            ss += (v[j][0] * v[j][0] + v[j][1] * v[j][1]) + (v[j][2] * v[j][2] + v[j][3] * v[j][3]);
        }
        const float rstd = rsqrtf(wave_sum(ss) * (1.f / 2048.f) + EPS);
        u32x2* o = (u32x2*)(hout + (size_t)t * 2048) + lane;
#pragma unroll
        for (int j = 0; j < 8; ++j) {
            const int d = (lane + 64 * j) * 4;
            const f32x4 gg = *(const f32x4*)(p.norm2_g + d), sc = *(const f32x4*)(mb + 4 * 2048 + d), sh = *(const f32x4*)(mb + 3 * 2048 + d);
            f32x4 y = (v[j] * rstd) * gg;
            y = y * (sc + 1.f) + sh;
            o[64 * j] = pack_h4(y);
        }
    }
}
__device__ __forceinline__ void phase_final(const Params& p, int bid, int nb) {
    const int tid = threadIdx.x, lane = tid & 63, wave = tid >> 6;
    const float* mod = (const float*)(p.ws + WS_MOD); const h16* y6 = (const h16*)(p.ws + WS_Y6); const h16* m16 = (const h16*)(p.ws + WS_R2);
    for (int t = bid * NWAVES + wave; t < T; t += nb * NWAVES) {
        const int b = t >> 12; const float* mb = mod + b * 12288;
        const f32x4* xr = (const f32x4*)(p.x + (size_t)t * 2048) + lane;
        const u32x2* yr = (const u32x2*)(y6 + (size_t)t * 2048) + lane;
        const u32x2* mr = (const u32x2*)(m16 + (size_t)t * 2048) + lane;
        f32x4* orow = (f32x4*)(p.out + (size_t)t * 2048) + lane;
#pragma unroll
        for (int j = 0; j < 8; ++j) {
            const int d = (lane + 64 * j) * 4;
            const f32x4 xv = xr[64 * j]; const h16x4 yh = __builtin_bit_cast(h16x4, yr[64 * j]), mh = __builtin_bit_cast(h16x4, mr[64 * j]);
            const f32x4 g1 = *(const f32x4*)(mb + 2 * 2048 + d), g2 = *(const f32x4*)(mb + 5 * 2048 + d);
            const f32x4 yv = {(float)yh[0], (float)yh[1], (float)yh[2], (float)yh[3]}, mv = {(float)mh[0], (float)mh[1], (float)mh[2], (float)mh[3]};
            orow[64 * j] = (xv + g1 * yv) + g2 * mv;
        }
    }
}

__device__ __forceinline__ void phase_rows3(const Params& p, int bid, int nb) {
    const int tid = threadIdx.x, lane = tid & 63, wave = tid >> 6;
    unsigned char* ws = p.ws;
    const h16* projB = (const h16*)(ws + WS_PROJB);
    h16* ymix = (h16*)(ws + WS_R2);
    f32x4 w0[4], w1[4], w2[4], bb[4], gn[4];
#pragma unroll
    for (int q4 = 0; q4 < 4; ++q4) {
        const int c = lane * 16 + q4 * 4;
        w0[q4] = *(const f32x4*)(p.conv_w + c); w1[q4] = *(const f32x4*)(p.conv_w + 1024 + c); w2[q4] = *(const f32x4*)(p.conv_w + 2048 + c);
        bb[q4] = *(const f32x4*)(p.conv_b + c); gn[q4] = *(const f32x4*)(p.conv_out_norm_g + c);
    }
    for (int t = bid * NWAVES + wave; t < T; t += nb * NWAVES) {
        const int tl = t & (SEQ - 1);
        const h16* pb = projB + (size_t)t * 3072 + lane * 16;
        const int d1 = tl >= 1 ? 1 : 0, d2 = tl >= 2 ? 2 : 0;
        const float m1 = tl >= 1 ? 1.f : 0.f, m2 = tl >= 2 ? 1.f : 0.f;
        h16x8 gbv[2], cv[3][2], hv[3][2];
#pragma unroll
        for (int hh = 0; hh < 2; ++hh) {
            gbv[hh] = *(const h16x8*)(pb + hh * 8);
            cv[2][hh] = *(const h16x8*)(pb + 1024 + hh * 8); hv[2][hh] = *(const h16x8*)(pb + 2048 + hh * 8);
            cv[1][hh] = *(const h16x8*)(pb - (size_t)d1 * 3072 + 1024 + hh * 8); hv[1][hh] = *(const h16x8*)(pb - (size_t)d1 * 3072 + 2048 + hh * 8);
            cv[0][hh] = *(const h16x8*)(pb - (size_t)d2 * 3072 + 1024 + hh * 8); hv[0][hh] = *(const h16x8*)(pb - (size_t)d2 * 3072 + 2048 + hh * 8);
        }
        float y[16], ss = 0.f;
#pragma unroll
        for (int i = 0; i < 16; ++i) {
            const int hh = i >> 3, q = i & 7, q4 = i >> 2, qq = i & 3;
            const float u0 = (float)cv[0][hh][q] * (float)hv[0][hh][q] * m2, u1 = (float)cv[1][hh][q] * (float)hv[1][hh][q] * m1, u2 = (float)cv[2][hh][q] * (float)hv[2][hh][q];
            float sacc = bb[q4][qq] + w0[q4][qq] * u0; sacc = sacc + w1[q4][qq] * u1; sacc = sacc + w2[q4][qq] * u2;
            y[i] = (float)gbv[hh][q] * sacc; ss += y[i] * y[i];
        }
        ss += __shfl_xor(ss, 1); ss += __shfl_xor(ss, 2); ss += __shfl_xor(ss, 4);
        const float rstd = rsqrtf(ss * (1.f / 128.f) + EPS);
        h16x8 o0, o1;
#pragma unroll
        for (int q = 0; q < 8; ++q) { o0[q] = (h16)(y[q] * rstd * gn[q >> 2][q & 3]); o1[q] = (h16)(y[8 + q] * rstd * gn[2 + (q >> 2)][q & 3]); }
        *(h16x8*)(ymix + (size_t)t * 2048 + 1024 + lane * 16) = o0;
        *(h16x8*)(ymix + (size_t)t * 2048 + 1024 + lane * 16 + 8) = o1;
    }
}

__constant__ unsigned char c_bucket_thr[15] = {19, 21, 24, 27, 31, 35, 40, 46, 52, 59, 67, 77, 87, 99, 113};
__device__ __forceinline__ int t5_bucket(int n) {
    if (n < 16) return n;
    int bkt = 16;
#pragma unroll
    for (int i = 0; i < 15; ++i) bkt += (n >= (int)c_bucket_thr[i]) ? 1 : 0;
    return bkt;
}
typedef float f32x16 __attribute__((ext_vector_type(16)));
__device__ __forceinline__ float next_up(float x) {
    const unsigned u = __float_as_uint(x);
    if ((u << 1) == 0u) return __uint_as_float(1u);
    return __uint_as_float((u >> 31) ? u - 1u : u + 1u);
}
__device__ __forceinline__ int wave_sum_dpp(int x) {
    x += __builtin_amdgcn_update_dpp(0, x, 0xB1, 0xf, 0xf, false);
    x += __builtin_amdgcn_update_dpp(0, x, 0x4E, 0xf, 0xf, false);
    x += __builtin_amdgcn_update_dpp(0, x, 0x124, 0xf, 0xf, false);
    x += __builtin_amdgcn_update_dpp(0, x, 0x128, 0xf, 0xf, false);
    return (__builtin_amdgcn_readlane(x, 0) + __builtin_amdgcn_readlane(x, 16)) + (__builtin_amdgcn_readlane(x, 32) + __builtin_amdgcn_readlane(x, 48));
}
__device__ __forceinline__ float dpp_f(float v, const int ctrl_sel) {
    const int i = __float_as_int(v);
    int r;
    if (ctrl_sel == 0) r = __builtin_amdgcn_update_dpp(i, i, 0xB1, 0xf, 0xf, false);
    else if (ctrl_sel == 1) r = __builtin_amdgcn_update_dpp(i, i, 0x4E, 0xf, 0xf, false);
    else if (ctrl_sel == 2) r = __builtin_amdgcn_update_dpp(i, i, 0x124, 0xf, 0xf, false);
    else r = __builtin_amdgcn_update_dpp(i, i, 0x128, 0xf, 0xf, false);
    return __int_as_float(r);
}
__device__ __forceinline__ float wave_min_dpp(float v) {
    v = fminf(v, dpp_f(v, 0)); v = fminf(v, dpp_f(v, 1)); v = fminf(v, dpp_f(v, 2)); v = fminf(v, dpp_f(v, 3));
    const float a = __int_as_float(__builtin_amdgcn_readlane(__float_as_int(v), 0)), b = __int_as_float(__builtin_amdgcn_readlane(__float_as_int(v), 16));
    const float c = __int_as_float(__builtin_amdgcn_readlane(__float_as_int(v), 32)), d = __int_as_float(__builtin_amdgcn_readlane(__float_as_int(v), 48));
    return fminf(fminf(a, b), fminf(c, d));
}
__device__ __forceinline__ float wave_max_dpp(float v) {
    v = fmaxf(v, dpp_f(v, 0)); v = fmaxf(v, dpp_f(v, 1)); v = fmaxf(v, dpp_f(v, 2)); v = fmaxf(v, dpp_f(v, 3));
    const float a = __int_as_float(__builtin_amdgcn_readlane(__float_as_int(v), 0)), b = __int_as_float(__builtin_amdgcn_readlane(__float_as_int(v), 16));
    const float c = __int_as_float(__builtin_amdgcn_readlane(__float_as_int(v), 32)), d = __int_as_float(__builtin_amdgcn_readlane(__float_as_int(v), 48));
    return fmaxf(fmaxf(a, b), fmaxf(c, d));
}
typedef short s16x2 __attribute__((ext_vector_type(2)));
__device__ __forceinline__ h16x2 relu_pk(h16x2 x) { const s16x2 z = {0, 0}; return __builtin_bit_cast(h16x2, __builtin_elementwise_max(__builtin_bit_cast(s16x2, x), z)); }
__device__ __forceinline__ float relu_asm(float x) { const int i = __builtin_bit_cast(int, x); return __builtin_bit_cast(float, i > 0 ? i : 0); }
constexpr int IDX_CHUNK = 512;
__device__ __forceinline__ void phase_index(const Params& p, LAS unsigned char* lds, int bid, int nb) {
    const int tid = threadIdx.x, lane = tid & 63, wave = __builtin_amdgcn_readfirstlane(tid >> 6), k16 = lane & 15, g = lane >> 4;
    unsigned char* ws = p.ws;
    const h16* iq = (const h16*)(ws + WS_IQ); const h16* kidx = (const h16*)(ws + WS_KIDX); const float* widx = (const float*)(ws + WS_WIDX);
    unsigned short* sel = (unsigned short*)(ws + WS_SEL);
    LAS float* SC = (LAS float*)lds;
    const int nitems = (nb == 256) ? 8 : (2048 + nb - 1) / nb;
    for (int ii = 0; ii < nitems; ++ii) {
        int b, i;
        if (nb == 256) { b = (bid & 7) >> 1; const int idx = ((bid >> 3) << 1) | (bid & 1); const int pr = ii >> 1; i = (ii & 1) ? (128 * pr + idx) : (128 * pr + 127 - idx); }
        else { const int item = bid + ii * nb; if (item >= 2048) break; b = item >> 9; i = item & 511; }
        if (i < 32) continue;
        const int t0 = i * 8;
        const int nchunk = (t0 + 7) / IDX_CHUNK + 1;
        const int tq = t0 + wave;
        const size_t tg = (size_t)b * SEQ + tq;
        const h16* kb = kidx + (size_t)b * SEQ * 64;
        {
            h16x8 Af[8][2], A2[8][2];
#pragma unroll
            for (int q = 0; q < 8; ++q) {
                const size_t tgq = (size_t)b * SEQ + t0 + q;
                const h16* ap = iq + tgq * 1024 + k16 * 64 + g * 8;
                Af[q][0] = *(const h16x8*)ap; Af[q][1] = *(const h16x8*)(ap + 32);
                const f32x4 wv = *(const f32x4*)(widx + tgq * 16 + 4 * g);
                h16x4 whi, wlo;
#pragma unroll
                for (int r = 0; r < 4; ++r) { whi[r] = (h16)wv[r]; wlo[r] = (h16)(wv[r] - (float)whi[r]); }
#pragma unroll
                for (int pp = 0; pp < 2; ++pp)
#pragma unroll
                    for (int r = 0; r < 4; ++r) {
                        A2[q][pp][r] = (k16 == 8 * pp) ? whi[r] : ((k16 == 8 * pp + 1) ? wlo[r] : (h16)0.f);
                        A2[q][pp][4 + r] = (k16 == 8 * pp + 4) ? whi[r] : ((k16 == 8 * pp + 5) ? wlo[r] : (h16)0.f);
                    }
            }
            const h16* bp = kb + (size_t)(wave * 64 + k16) * 64 + g * 8;
            h16x8 Bc[8];
#pragma unroll
            for (int x = 0; x < 4; ++x)
#pragma unroll
                for (int ks = 0; ks < 2; ++ks) Bc[2 * x + ks] = *(const h16x8*)(bp + (size_t)(x * 16) * 64 + ks * 32);
            __syncthreads();
#pragma unroll 1
            for (int c = 0; c < nchunk; ++c) {
                const int cn1 = (c + 1 < nchunk) ? c + 1 : c;
                h16x8 Bn[8];
#pragma unroll
                for (int x = 0; x < 4; ++x)
#pragma unroll
                    for (int ks = 0; ks < 2; ++ks) Bn[2 * x + ks] = *(const h16x8*)(bp + (size_t)(cn1 * IDX_CHUNK + x * 16) * 64 + ks * 32);
                if (c * IDX_CHUNK + wave * 64 <= t0 + 7) {
#pragma unroll
                    for (int q = 0; q < 8; ++q) {
                        f32x4 acc[4];
#pragma unroll
                        for (int x = 0; x < 4; ++x) acc[x] = __builtin_amdgcn_mfma_f32_16x16x32_f16(Af[q][0], Bc[2 * x], (f32x4){0.f, 0.f, 0.f, 0.f}, 0, 0, 0);
#pragma unroll
                        for (int x = 0; x < 4; ++x) acc[x] = __builtin_amdgcn_mfma_f32_16x16x32_f16(Af[q][1], Bc[2 * x + 1], acc[x], 0, 0, 0);
                        f32x4 D2 = {0.f, 0.f, 0.f, 0.f};
#pragma unroll
                        for (int pp = 0; pp < 2; ++pp) {
                            h16x2 qv[4];
#pragma unroll
                            for (int e = 0; e < 2; ++e) {
                                const f32x2 r01 = {acc[2 * pp + e][0], acc[2 * pp + e][1]}, r23 = {acc[2 * pp + e][2], acc[2 * pp + e][3]};
                                qv[2 * e] = relu_pk(__builtin_convertvector(r01, h16x2)); qv[2 * e + 1] = relu_pk(__builtin_convertvector(r23, h16x2));
                            }
                            h16x8 B2; B2[0] = qv[0][0]; B2[1] = qv[0][1]; B2[2] = qv[1][0]; B2[3] = qv[1][1]; B2[4] = qv[2][0]; B2[5] = qv[2][1]; B2[6] = qv[3][0]; B2[7] = qv[3][1];
                            D2 = __builtin_amdgcn_mfma_f32_16x16x32_f16(A2[q][pp], B2, D2, 0, 0, 0);
                        }
                        SC[q * SEQ + c * IDX_CHUNK + wave * 64 + lane] = D2[0] + D2[1];
                    }
                }
#pragma unroll
                for (int q = 0; q < 8; ++q) Bc[q] = Bn[q];
            }
        }
        asm volatile("s_waitcnt lgkmcnt(0)" ::: "memory");
        __syncthreads();
        float sc[64];
        {
            const LAS float* sq = SC + wave * SEQ + lane;
#pragma unroll
            for (int j = 0; j < 64; ++j) sc[j] = -INFINITY;
#pragma unroll
            for (int q4 = 0; q4 < 4; ++q4) if (q4 * 1024 <= tq) {
#pragma unroll
                for (int j = 16 * q4; j < 16 * q4 + 16; ++j) { const float v = sq[64 * j]; sc[j] = (64 * j + lane <= tq) ? v : -INFINITY; }
            }
        }
        const int nq = (tq >> 10) + 1;
        float vmin = INFINITY, vmax = -INFINITY;
#pragma unroll
        for (int q = 0; q < 4; ++q) if (q < nq) {
#pragma unroll
            for (int j = 16 * q; j < 16 * q + 16; ++j) { const float v = sc[j]; vmax = fmaxf(vmax, v); vmin = fminf(vmin, (v == -INFINITY) ? INFINITY : v); }
        }
        float lo = wave_min_dpp(vmin), hi = next_up(wave_max_dpp(vmax));
        int clo = tq + 1, chi = 0;
        float Tsel = lo; bool exact = false;
        for (int it = 0; it < 200; ++it) {
            float mid = 0.5f * lo + 0.5f * hi;
            if (!(it & 1)) { const float frac = ((float)(clo - TOPK) - 0.5f) / (float)(clo - chi); const float sm = lo + (hi - lo) * frac; if (sm > lo && sm < hi) mid = sm; }
            if (!(mid > lo && mid < hi)) { Tsel = lo; break; }
            int cn = 0;
#pragma unroll
            for (int q = 0; q < 4; ++q) if (q < nq) {
#pragma unroll
                for (int j = 16 * q; j < 16 * q + 16; ++j) cn += (sc[j] >= mid) ? 1 : 0;
            }
            cn = wave_sum_dpp(cn);
            if (cn == TOPK) { Tsel = mid; exact = true; break; }
            if (cn > TOPK) { lo = mid; clo = cn; } else { hi = mid; chi = cn; }
            Tsel = lo;
        }
        unsigned short* so = sel + tg * TOPK;
        if (exact) {
            int outb = 0;
#pragma unroll
            for (int q = 0; q < 4; ++q) if (q < nq) {
#pragma unroll
                for (int j = 16 * q; j < 16 * q + 16; ++j) {
                    const bool take = sc[j] >= Tsel;
                    const unsigned long long bt = __ballot(take);
                    const int tr = __builtin_amdgcn_mbcnt_hi((unsigned)(bt >> 32), __builtin_amdgcn_mbcnt_lo((unsigned)bt, 0u));
                    if (take) so[outb + tr] = (unsigned short)(j * 64 + lane);
                    outb += __popcll(bt);
                }
            }
        } else {
            int ngt = 0;
#pragma unroll
            for (int j = 0; j < 64; ++j) ngt += (sc[j] > Tsel) ? 1 : 0;
            ngt = wave_sum_dpp(ngt);
            const int quota = TOPK - ngt;
            int outb = 0, eqb = 0;
#pragma unroll
            for (int j = 0; j < 64; ++j) {
                const float v = sc[j];
                const bool gt = v > Tsel, eq = v == Tsel;
                const unsigned long long beq = __ballot(eq);
                const int eqr = __builtin_amdgcn_mbcnt_hi((unsigned)(beq >> 32), __builtin_amdgcn_mbcnt_lo((unsigned)beq, 0u));
                const bool take = gt || (eq && (eqb + eqr) < quota);
                const unsigned long long bt = __ballot(take);
                const int tr = __builtin_amdgcn_mbcnt_hi((unsigned)(bt >> 32), __builtin_amdgcn_mbcnt_lo((unsigned)bt, 0u));
                if (take) so[outb + tr] = (unsigned short)(j * 64 + lane);
                outb += __popcll(bt); eqb += __popcll(beq);
            }
        }
    }
    __syncthreads();
}

typedef short s16x4v __attribute__((__vector_size__(4 * sizeof(short))));
__device__ __forceinline__ h16x4 lds_tr_read(const LAS unsigned char* p) {
    return __builtin_bit_cast(h16x4, __builtin_amdgcn_ds_read_tr16_b64_v4i16((LAS s16x4v*)p));
}
__device__ __forceinline__ void phase_attn(const Params& p, LAS unsigned char* lds, int bid, int nb) {
    const int tid = threadIdx.x, lane = tid & 63, wave = __builtin_amdgcn_readfirstlane(tid >> 6), g = lane >> 4, hd = lane & 15;
    unsigned char* ws = p.ws;
    const h16* qabs = (const h16*)(ws + WS_QABS); const h16* ckv = (const h16*)(ws + WS_CKV);
    const unsigned short* sel = (const unsigned short*)(ws + WS_SEL);
    h16* olat = (h16*)(ws + WS_OLAT);
    LAS unsigned char* kv = lds + wave * 16384;
    LAS int* sidx = (LAS int*)(lds + 131072 + wave * 1024);
    LAS float* biasT = (LAS float*)(lds + 131072 + 8192);
    LAS unsigned char* bktT = lds + 131072 + 8192 + 1024;
    __syncthreads();
    if (tid < 256) biasT[tid] = p.rel_bias[tid];
    if (tid < 128) bktT[tid] = (unsigned char)t5_bucket(tid);
    __syncthreads();
    int tstart, tstride, tcount;
    if (nb == 256) { const int b = (bid & 7) >> 1, wq = ((((bid >> 3) << 1) | (bid & 1)) << 3) + wave; tstart = b * SEQ + wq; tstride = 512; tcount = 8; }
    else { tstart = bid * NWAVES + wave; tstride = nb * NWAVES; tcount = (T - tstart + tstride - 1) / tstride; }
    const int rowA = hd;
    const int fswA = ((rowA & 3) << 1) | (((rowA >> 2) & 1) << 3);
    const int q4 = hd >> 2, p4 = hd & 3;
    const int rowT = 4 * g + q4;
    const int fswT = ((rowT & 3) << 1) | (((rowT >> 2) & 1) << 3);
    const LAS unsigned char* trbase = kv + rowT * 512 + 8 * (p4 & 1);
    for (int qi = 0; qi < tcount; ++qi) {
        const int tg = tstart + qi * tstride;
        const int b = tg >> 12, tl = tg & (SEQ - 1);
        const int cnt = tl + 1 < TOPK ? tl + 1 : TOPK, nch = (cnt + 31) >> 5;
        {
            int i0, i1, i2, i3;
            if (tl + 1 > TOPK) { const u32x2 s4 = *(const u32x2*)(sel + (size_t)tg * TOPK + lane * 4); i0 = s4.x & 0xffff; i1 = s4.x >> 16; i2 = s4.y & 0xffff; i3 = s4.y >> 16; }
            else { const int j = lane * 4; i0 = j < cnt ? j : 0; i1 = j + 1 < cnt ? j + 1 : 0; i2 = j + 2 < cnt ? j + 2 : 0; i3 = j + 3 < cnt ? j + 3 : 0; }
            *(LAS i32x4*)(sidx + lane * 4) = (i32x4){i0, i1, i2, i3};
        }
        h16x8 Qf[8];
#pragma unroll
        for (int ks = 0; ks < 8; ++ks) {
            h16x8 z;
#pragma unroll
            for (int e = 0; e < 8; ++e) z[e] = (h16)0.f;
            Qf[ks] = (hd < 8) ? *(const h16x8*)(qabs + (size_t)tg * 2048 + hd * 256 + ks * 32 + g * 8) : z;
        }
        f32x4 O[16];
#pragma unroll
        for (int ct = 0; ct < 16; ++ct) O[ct] = (f32x4){0.f, 0.f, 0.f, 0.f};
        float m = -INFINITY, l = 0.f;
        const unsigned char* ckvb = (const unsigned char*)(ckv + (size_t)b * SEQ * 256);
        LDS_WAIT();
        for (int c = 0; c < nch; ++c) {
            asm volatile("" ::: "memory");
#pragma unroll
            for (int i = 0; i < 16; ++i) {
                const int row = 2 * i + (lane >> 5);
                const int idx = sidx[32 * c + row];
                const int fsw = ((row & 3) << 1) | (((row >> 2) & 1) << 3);
                const unsigned char* src = ckvb + (size_t)idx * 512 + ((((lane & 31) ^ fsw)) << 4);
                __builtin_amdgcn_global_load_lds((const unsigned*)src, (LAS unsigned*)(kv + i * 1024), 16, 0, 0);
            }
            const i32x4 ia = *(const LAS i32x4*)(sidx + 32 * c + 4 * g), ib = *(const LAS i32x4*)(sidx + 32 * c + 16 + 4 * g);
            const int h7 = hd & 7;
            const int kk8[8] = {ia.x, ia.y, ia.z, ia.w, ib.x, ib.y, ib.z, ib.w};
            float bias8[8];
#pragma unroll
            for (int r = 0; r < 8; ++r) {
                const int slot = 32 * c + (r < 4 ? 4 * g + r : 16 + 4 * g + (r - 4));
                int dist = tl - kk8[r]; dist = dist < 0 ? 0 : (dist > 127 ? 127 : dist);
                bias8[r] = (slot < cnt) ? biasT[(int)bktT[dist] * 8 + h7] : -INFINITY;
            }
            asm volatile("s_waitcnt vmcnt(0)" ::: "memory");
            __builtin_amdgcn_sched_barrier(0);
            f32x4 S0 = {0.f, 0.f, 0.f, 0.f}, S1 = {0.f, 0.f, 0.f, 0.f};
#pragma unroll
            for (int ks = 0; ks < 8; ++ks) {
                const h16x8 A0 = *(const LAS h16x8*)(kv + rowA * 512 + (((4 * ks + g) ^ fswA) << 4));
                const h16x8 A1 = *(const LAS h16x8*)(kv + (rowA + 16) * 512 + (((4 * ks + g) ^ fswA) << 4));
                S0 = __builtin_amdgcn_mfma_f32_16x16x32_f16(A0, Qf[ks], S0, 0, 0, 0);
                S1 = __builtin_amdgcn_mfma_f32_16x16x32_f16(A1, Qf[ks], S1, 0, 0, 0);
            }
            float sv[8]; float cmax = -INFINITY;
#pragma unroll
            for (int r = 0; r < 8; ++r) { sv[r] = ((r < 4) ? S0[r] : S1[r - 4]) + bias8[r]; cmax = fmaxf(cmax, sv[r]); }
            if (__any(cmax > m + 8.f)) {
                cmax = fmaxf(cmax, __shfl_xor(cmax, 16)); cmax = fmaxf(cmax, __shfl_xor(cmax, 32));
                const float mnew = fmaxf(m, cmax);
                const float alpha = __expf(m - mnew);
                l *= alpha; m = mnew;
#pragma unroll
                for (int ct = 0; ct < 16; ++ct) O[ct] *= alpha;
            }
            h16x8 Pf;
#pragma unroll
            for (int r = 0; r < 8; ++r) { const float pv = __expf(sv[r] - m); l += pv; Pf[r] = (h16)pv; }
#pragma unroll
            for (int ct = 0; ct < 16; ++ct) {
                const int choff = ((((2 * (ct & 7)) ^ fswT) + (p4 >> 1)) << 4) + (ct >> 3) * 256;
                const h16x4 a0 = lds_tr_read(trbase + choff);
                const h16x4 a1 = lds_tr_read(trbase + 16 * 512 + choff);
                h16x8 Av; Av[0] = a0[0]; Av[1] = a0[1]; Av[2] = a0[2]; Av[3] = a0[3]; Av[4] = a1[0]; Av[5] = a1[1]; Av[6] = a1[2]; Av[7] = a1[3];
                O[ct] = __builtin_amdgcn_mfma_f32_16x16x32_f16(Av, Pf, O[ct], 0, 0, 0);
            }
            asm volatile("" ::: "memory");
        }
        l += __shfl_xor(l, 16); l += __shfl_xor(l, 32);
        if (hd < 8) {
            const float inv = 1.f / l;
            h16* op = olat + (size_t)tg * 2048 + hd * 256 + 4 * g;
#pragma unroll
            for (int ct = 0; ct < 16; ++ct) *(u32x2*)(op + 16 * ct) = pack_h4(O[ct] * inv);
        }
    }
    __syncthreads();
}

__device__ __forceinline__ void phase_uv(const Params& p, LAS unsigned char* lds, int bid, int nb) {
    const int tid = threadIdx.x, lane = tid & 63, wave = tid >> 6, r31 = lane & 31, hh = lane >> 5;
    unsigned char* ws = p.ws;
    const h16* olat = (const h16*)(ws + WS_OLAT); const h16* wuvT = (const h16*)(ws + WS_WUVT);
    h16* ymix = (h16*)(ws + WS_R2);
    for (int u = bid; u < 256; u += nb) {
        const int h = u & 7, rb = u >> 3;
        __syncthreads();
        for (int e = tid; e < 128 * 32; e += NTHREADS) { const int v = e >> 5, ch = e & 31; *(LAS u32x4*)(lds + v * 528 + ch * 16) = *(const u32x4*)(wuvT + ((size_t)h * 128 + v) * 256 + ch * 8); }
        __syncthreads();
        for (int tile = wave; tile < 16; tile += NWAVES) {
            const int row0 = rb * 512 + tile * 32;
            f32x16 acc[4];
#pragma unroll
            for (int vt = 0; vt < 4; ++vt)
#pragma unroll
                for (int r = 0; r < 16; ++r) acc[vt][r] = 0.f;
            const h16* bp = olat + (size_t)(row0 + r31) * 2048 + h * 256 + hh * 8;
#pragma unroll 4
            for (int ks = 0; ks < 16; ++ks) {
                const h16x8 Bf = *(const h16x8*)(bp + ks * 16);
#pragma unroll
                for (int vt = 0; vt < 4; ++vt) {
                    const h16x8 Af = *(const LAS h16x8*)(lds + (vt * 32 + r31) * 528 + ks * 32 + hh * 16);
                    acc[vt] = __builtin_amdgcn_mfma_f32_32x32x16_f16(Af, Bf, acc[vt], 0, 0, 0);
                }
            }
            float ss = 0.f;
#pragma unroll
            for (int vt = 0; vt < 4; ++vt)
#pragma unroll
                for (int r = 0; r < 16; ++r) ss += acc[vt][r] * acc[vt][r];
            ss += __shfl_xor(ss, 32);
            const float rstd = rsqrtf(ss * (1.f / 128.f) + EPS);
            h16* yp = ymix + (size_t)(row0 + r31) * 2048 + h * 128 + 4 * hh;
            const float* gp = p.attn_out_norm_g + h * 128 + 4 * hh;
#pragma unroll
            for (int vt = 0; vt < 4; ++vt)
#pragma unroll
                for (int rq = 0; rq < 4; ++rq) {
                    const f32x4 gg = *(const f32x4*)(gp + vt * 32 + 8 * rq);
                    const f32x4 y = {acc[vt][4 * rq + 0] * rstd * gg[0], acc[vt][4 * rq + 1] * rstd * gg[1], acc[vt][4 * rq + 2] * rstd * gg[2], acc[vt][4 * rq + 3] * rstd * gg[3]};
                    *(u32x2*)(yp + vt * 32 + 8 * rq) = pack_h4(y);
                }
        }
    }
    __syncthreads();
}

#define XB_TMO      128
#define XB_XCNT(j)  (256  + 64 * (j))
#define XB_XSUB(j)  (1280 + 64 * (j))
#define XB_XGEN(j)  (2304 + 64 * (j))
#define XB_TOP      3328
#define XB_TOPGEN   3392
#define XCD_BAR_WORDS 3456
#define XB_SPIN_CAP (1u << 22)
__device__ __forceinline__ unsigned xb_ld(unsigned* p)              { return __hip_atomic_load(p, __ATOMIC_RELAXED, __HIP_MEMORY_SCOPE_AGENT); }
__device__ __forceinline__ unsigned xb_add(unsigned* p, unsigned v) { return __hip_atomic_fetch_add(p, v, __ATOMIC_RELAXED, __HIP_MEMORY_SCOPE_AGENT); }
__device__ __forceinline__ unsigned xb_xcc_id() { return (unsigned)__builtin_amdgcn_s_getreg((3 << 11) | 20) & 0xFu; }
#define XB_SPIN(cond, bar) do { unsigned _sp = 0; while (cond) { __builtin_amdgcn_s_sleep(1); \
    if ((++_sp & 255u) == 0u) { if (xb_ld(&(bar)[XB_TMO])) break; if (_sp > XB_SPIN_CAP) { atomicAdd(&(bar)[XB_TMO], 1u); break; } } } } while (0)
struct XcdBarrier { unsigned* bar; unsigned x; volatile LAS unsigned* st; };
__device__ __forceinline__ XcdBarrier xcd_barrier_post(unsigned* bar, volatile LAS unsigned* st) {
    XcdBarrier b; b.bar = bar; b.x = xb_xcc_id(); b.st = st;
    if (threadIdx.x == 0) (void)xb_add(&bar[XB_XCNT(b.x)], 1u);
    return b;
}
__device__ __forceinline__ void xcd_barrier_complete(unsigned* bar, unsigned x, unsigned& nloc, unsigned& nx) {
    const unsigned G = gridDim.x * gridDim.y * gridDim.z;
    unsigned sum, cnt, mine, sp = 0u;
    for (;;) {
        sum = 0u; cnt = 0u; mine = 0u;
#pragma unroll
        for (unsigned j = 0; j < 16; ++j) { const unsigned c = xb_ld(&bar[XB_XCNT(j)]); sum += c; cnt += (c > 0u) ? 1u : 0u; mine = (j == x) ? c : mine; }
        if (sum == G) break;
        __builtin_amdgcn_s_sleep(1);
        if ((++sp & 255u) == 0u) { if (xb_ld(&bar[XB_TMO])) break; if (sp > XB_SPIN_CAP) { atomicAdd(&bar[XB_TMO], 1u); break; } }
    }
    nloc = mine > 0u ? mine : 1u; nx = cnt > 0u ? cnt : 1u;
}
__device__ __forceinline__ void xcd_barrier(const XcdBarrier& b) {
    asm volatile("s_waitcnt vmcnt(0)" ::: "memory");
    __syncthreads();
    if (threadIdx.x == 0) {
        unsigned* bar = b.bar;
        __builtin_amdgcn_s_waitcnt(0);
        unsigned nloc = b.st[0], nx = b.st[1];
        if (nloc == 0u) { xcd_barrier_complete(bar, b.x, nloc, nx); b.st[0] = nloc; b.st[1] = nx; }
        const unsigned old = xb_add(&bar[XB_XSUB(b.x)], 1u);
        const unsigned gen = old / nloc;
        if (old + 1u == (gen + 1u) * nloc) {
            __builtin_amdgcn_fence(__ATOMIC_RELEASE, "agent");
            asm volatile("s_waitcnt vmcnt(0)" ::: "memory");
            const unsigned og = xb_add(&bar[XB_TOP], 1u);
            const unsigned tg = og / nx;
            if (og + 1u == (tg + 1u) * nx) xb_add(&bar[XB_TOPGEN], 1u);
            else XB_SPIN(xb_ld(&bar[XB_TOPGEN]) == tg, bar);
            __builtin_amdgcn_fence(__ATOMIC_ACQUIRE, "agent");
            xb_add(&bar[XB_XGEN(b.x)], 1u);
            asm volatile("s_waitcnt vmcnt(0)" ::: "memory");
        } else {
            XB_SPIN(xb_ld(&bar[XB_XGEN(b.x)]) == gen, bar);
            __builtin_amdgcn_fence(__ATOMIC_ACQUIRE, "agent");
            asm volatile("s_waitcnt vmcnt(0)" ::: "memory");
        }
    }
    __syncthreads();
}

constexpr int LDS_BYTES = 160 * 1024;
constexpr int WGM_G1 = 2, WGM_G2 = 2, WGM_G6 = 2, WGM_G7 = 8, WGM_G8 = 2;
constexpr int NPHASES = 13;
__global__ void __launch_bounds__(NTHREADS, 2) fwd_kernel(Params p) {
    extern __shared__ __attribute__((aligned(16))) unsigned char lds_raw[];
    LAS unsigned char* lds = (LAS unsigned char*)lds_raw;
    const int bid = blockIdx.x, nb = gridDim.x;
    unsigned char* ws = p.ws;
    float* mod = (float*)(ws + WS_MOD);
    volatile LAS unsigned* bst = (volatile LAS unsigned*)(lds + LDS_BYTES - 64);
    if (threadIdx.x < 2) bst[threadIdx.x] = 0u;
    __syncthreads();
    XcdBarrier xbar = xcd_barrier_post((unsigned*)(ws + WS_CTL), bst);
#define IN(k) (p.ph_lo <= (k) && (k) < p.ph_hi)
#define SEAM(k) do { if (IN(k) && IN((k) + 1)) xcd_barrier(xbar); } while (0)
    if (IN(0)) { phase_prep(p, lds, bid, nb); } SEAM(0);
    if (IN(1)) { phase_normmod(p.x, p.norm1_g, mod, 0, 2048, (h16*)(ws + WS_R2), bid, nb); } SEAM(1);
    if (IN(2)) { EpiProj E{(h16*)(ws + WS_CQ), (float*)(ws + WS_PROJA), (h16*)(ws + WS_CKV), (h16*)(ws + WS_KIDX), (float*)(ws + WS_WIDX), (h16*)(ws + WS_PROJB), p.kv_norm_g, p.idx_k_norm_g, p.idx_k_norm_b};
                 run_gemm(lds, (const h16*)(ws + WS_R2), (const h16*)(ws + WS_BT_IN), T, N_IN, 2048, bid, nb, E, WGM_G1); } SEAM(2);
    if (IN(3)) { phase_rows3(p, bid, nb); } SEAM(3);
    if (IN(4)) { EpiQ E{(h16*)(ws + WS_QABS), (h16*)(ws + WS_IQ), p.q_abs_norm_g, (const float*)(ws + WS_PROJA)}; run_gemm(lds, (const h16*)(ws + WS_CQ), (const h16*)(ws + WS_BT_Q), T, N_Q, 512, bid, nb, E, WGM_G2); } SEAM(4);
    if (IN(5)) { phase_index(p, lds, bid, nb); } SEAM(5);
    if (IN(6)) { phase_attn(p, lds, bid, nb); } SEAM(6);
    if (IN(7)) { phase_uv(p, lds, bid, nb); } SEAM(7);
    if (IN(8)) { EpiF16 E{(h16*)(ws + WS_Y6), nullptr}; run_gemm(lds, (const h16*)(ws + WS_R2), (const h16*)(ws + WS_BT_OUT), T, 2048, 2048, bid, nb, E, WGM_G6); } SEAM(8);
    if (IN(9)) { phase_normmod2(p, bid, nb); } SEAM(9);
    if (IN(10)) {
        LAS h16* bl = (LAS h16*)(lds + 131072 + 8192);
        __syncthreads();
        for (int i = threadIdx.x; i < D_FF / 4; i += NTHREADS) { const f32x4 b4 = *(const f32x4*)(p.b_mlp1 + 4 * i); *(LAS u32x2*)(bl + 4 * i) = pack_h4(b4); }
        __syncthreads();
        EpiMlp1 E{bl, (h16*)(ws + WS_R3)}; run_gemm(lds, (const h16*)(ws + WS_R2), (const h16*)(ws + WS_BT_1), T, D_FF, 2048, bid, nb, E, WGM_G7); } SEAM(10);
    if (IN(11)) { EpiF16 E{(h16*)(ws + WS_R2), p.b_mlp2}; run_gemm(lds, (const h16*)(ws + WS_R3), (const h16*)(ws + WS_BT_2), T, 2048, D_FF, bid, nb, E, WGM_G8); } SEAM(11);
    if (IN(12)) { phase_final(p, bid, nb); }
#undef IN
#undef SEAM
}

#ifndef N_LAUNCH_MODE
#define N_LAUNCH_MODE 1
#endif
extern "C" void kernel_launch(void* const* d_in, const int* in_sizes, int n_in, void* d_out, int out_size, void* d_ws, size_t ws_size, hipStream_t stream) {
    static int grid = 0;
    if (grid == 0) {
        if (ws_size < WS_END) { fprintf(stderr, "kernel_launch: workspace too small (%zu < %zu)\n", ws_size, (size_t)WS_END); grid = -1; return; }
        int dev = 0, cus = 0, per_cu = 0;
        hipGetDevice(&dev);
        hipDeviceGetAttribute(&cus, hipDeviceAttributeMultiprocessorCount, dev);
        if (hipFuncSetAttribute((const void*)fwd_kernel, hipFuncAttributeMaxDynamicSharedMemorySize, LDS_BYTES) != hipSuccess) { fprintf(stderr, "kernel_launch: hipFuncSetAttribute failed\n"); grid = -1; return; }
        hipOccupancyMaxActiveBlocksPerMultiprocessor(&per_cu, (const void*)fwd_kernel, NTHREADS, LDS_BYTES);
        if (per_cu < 1) { fprintf(stderr, "kernel_launch: occupancy query says %d\n", per_cu); per_cu = 1; }
        grid = cus;
        if (grid > 256) grid = 256;
    }
    if (grid < 0) return;
    Params p{};
    const float** f = (const float**)&p;
    for (int i = 0; i < 26; ++i) f[i] = (const float*)d_in[i];
    p.out = (float*)d_out; p.ws = (unsigned char*)d_ws;
#if N_LAUNCH_MODE == 1
    if (hipMemsetAsync((char*)d_ws + WS_CTL, 0, XCD_BAR_WORDS * 4, stream) != hipSuccess) { fprintf(stderr, "kernel_launch: memset failed\n"); return; }
    p.ph_lo = 0; p.ph_hi = NPHASES;
    void* args[] = {&p};
    hipError_t e = hipLaunchCooperativeKernel((const void*)fwd_kernel, dim3(grid), dim3(NTHREADS), args, LDS_BYTES, stream);
    if (e != hipSuccess) fprintf(stderr, "cooperative launch failed: %s (grid %d)\n", hipGetErrorString(e), grid);
#else
    for (int ph = 0; ph < 13; ++ph) {
        p.ph_lo = ph; p.ph_hi = ph + 1;
        hipLaunchKernelGGL(fwd_kernel, dim3(grid), dim3(NTHREADS), LDS_BYTES, stream, p);
    }
#endif
}
```

```cpp
#include <hip/hip_runtime.h>
#include <cstdio>
#include <cstdint>

#define LAS __attribute__((address_space(3)))
typedef _Float16 h16;
typedef _Float16 h16x8 __attribute__((ext_vector_type(8)));
typedef _Float16 h16x4 __attribute__((ext_vector_type(4)));
typedef _Float16 h16x2 __attribute__((ext_vector_type(2)));
typedef float f32x4 __attribute__((ext_vector_type(4)));
typedef float f32x2 __attribute__((ext_vector_type(2)));
typedef unsigned u32x4 __attribute__((ext_vector_type(4)));
typedef unsigned u32x2 __attribute__((ext_vector_type(2)));
typedef int i32x4 __attribute__((ext_vector_type(4)));

constexpr int D_MODEL = 2048, BATCH = 4, SEQ = 4096, T = BATCH * SEQ;
constexpr int ATTN_HEADS = 8, HEAD_DIM = 128, Q_LORA = 512, KV_LORA = 256, IDX_HEADS = 16, IDX_DIM = 64, TOPK = 256;
constexpr int CONV_WIDTH = 1024, D_FF = 8192, IN_COLS = 3920;
constexpr float EPS = 1e-6f;
constexpr int NTHREADS = 512, NWAVES = 8;
constexpr int N_IN = 4096;
constexpr int N_Q = 3072;

constexpr size_t MiB = (size_t)1 << 20;
constexpr size_t WS_CTL = 0;
constexpr size_t WS_MOD = 64 * 1024;
constexpr size_t WS_BT_IN = 1 * MiB;
constexpr size_t WS_BT_Q = WS_BT_IN + 16 * MiB;
constexpr size_t WS_BT_OUT = WS_BT_Q + 3 * MiB;
constexpr size_t WS_BT_1 = WS_BT_OUT + 8 * MiB;
constexpr size_t WS_BT_2 = WS_BT_1 + 32 * MiB;
constexpr size_t WS_WUVT = WS_BT_2 + 32 * MiB;
constexpr size_t WS_R2 = 93 * MiB;
constexpr size_t WS_R3 = WS_R2 + 64 * MiB;
constexpr size_t WS_PROJA = WS_R3;
constexpr size_t WS_PROJB = WS_R3 + 64 * MiB;
constexpr size_t WS_OLAT = WS_R3 + 64 * MiB;
constexpr size_t WS_QABS = WS_R3 + 160 * MiB;
constexpr size_t WS_IQ = WS_R3 + 224 * MiB;
constexpr size_t WS_R4 = WS_R3 + 256 * MiB;
constexpr size_t WS_CQ = WS_R4;
constexpr size_t WS_CKV = WS_CQ + 16 * MiB;
constexpr size_t WS_KIDX = WS_CKV + 8 * MiB;
constexpr size_t WS_WIDX = WS_KIDX + 2 * MiB;
constexpr size_t WS_SEL = WS_WIDX + 1 * MiB;
constexpr size_t WS_Y6 = WS_SEL + 8 * MiB;
constexpr size_t WS_END = WS_Y6 + 64 * MiB;

struct Params {
    const float *x, *c, *w_ada, *b_ada, *norm1_g, *norm2_g, *w_in, *cq_norm_g, *w_uq, *w_uk, *kv_norm_g, *q_abs_norm_g, *w_uv, *w_iq,
        *idx_k_norm_g, *idx_k_norm_b, *rel_bias, *conv_w, *conv_b, *attn_out_norm_g, *conv_out_norm_g, *w_out, *w_mlp1, *b_mlp1, *w_mlp2, *b_mlp2;
    float* out;
    unsigned char* ws;
    int ph_lo, ph_hi;
};

__device__ __forceinline__ float wave_sum(float v) {
#pragma unroll
    for (int o = 1; o < 64; o <<= 1) v += __shfl_xor(v, o);
    return v;
}
__device__ __forceinline__ float wave_max(float v) {
#pragma unroll
    for (int o = 1; o < 64; o <<= 1) v = fmaxf(v, __shfl_xor(v, o));
    return v;
}
#define LDS_WAIT() asm volatile("s_waitcnt lgkmcnt(0)" ::: "memory")

namespace pg8 {
constexpr int BM = 256, BK = 64, HALF = 128, HTB = HALF * BK * 2, STAGE_BYTES = 8 * HTB, NXCD = 8;
__host__ __device__ __forceinline__ int lds_byte(int r, int c) { const int st = (r >> 4) * 2 + (c >> 5), rr = r & 15, cc = c & 31, ob = rr * 64 + cc * 2; return st * 1024 + (ob ^ (((ob >> 9) & 1) << 5)); }
__host__ __device__ __forceinline__ int perm32(int rho) { const int n = rho >> 4, i = rho & 15; return 8 * (i >> 2) + 4 * n + (i & 3); }
__host__ __device__ __forceinline__ void stage_rc(int b, int& R, int& C) { const int st = b / 1024, sb = b % 1024, swz = sb ^ (((sb >> 9) & 1) << 5); R = (st >> 1) * 16 + swz / 64; C = (st & 1) * 32 + (swz % 64) / 2; }
struct Unit { int pm, pn; };
struct Gemm { const h16* A; const h16* Bt; int M, N, K; };
struct StaticOrder {
    int nM, nN, nwg, G, c, WGM;
    __host__ __device__ void init(int M, int N, int G_, int c_, int wgm) { nM = M / BM; nN = N / BM; nwg = nM * nN; G = G_; c = c_; WGM = wgm; }
    __host__ __device__ bool next(int i, Unit& u) const {
        const long L = (long)i * G + c; if (L >= nwg) return false;
        int wgid = (int)L; { const int q = nwg / NXCD, r = nwg % NXCD, xcd = wgid % NXCD, off = wgid / NXCD; wgid = (xcd < r ? xcd * (q + 1) : r * (q + 1) + (xcd - r) * q) + off; }
        const int nig = WGM * nN, gid = wgid / nig, fm = gid * WGM, gsz = (nM - fm) < WGM ? (nM - fm) : WGM;
        u.pm = fm + ((wgid % nig) % gsz); u.pn = (wgid % nig) / gsz; return true;
    }
};

#ifndef PG8_SP2
#define PG8_SP2 true
#endif
#ifndef PG8_ALIGN
#define PG8_ALIGN true
#endif
template <class Epi, bool ALIGN_EPI = PG8_ALIGN, bool SP2 = PG8_SP2>
__device__ __forceinline__ void gemm_phase(LAS unsigned char* lds, const Gemm g, const StaticOrder& S, const Epi& E) {
    const int tid = threadIdx.x, wid = __builtin_amdgcn_readfirstlane(tid >> 6), lane = tid & 63, wr = wid >> 2, wc = wid & 3, fr = lane & 15, fq = lane >> 4;
    const int K = g.K, nt = K / BK;
    unsigned voffA[2], voffB[2];
#pragma unroll
    for (int i = 0; i < 2; ++i) { int R, C; stage_rc(tid * 16 + i * 8192, R, C); const int Rb = Epi::PERM ? ((R & ~31) + perm32(R & 31)) : R; voffA[i] = (unsigned)(R * K + C) * 2u; voffB[i] = (unsigned)(Rb * K + C) * 2u; }
    const size_t kstep = (size_t)(BK * 2);
    const size_t hstep = (size_t)HALF * K * 2;
    const size_t tstep = 2 * hstep;
    const unsigned ldsw = (unsigned)wid * 1024u;
    const int aoff = lds_byte(wr * 64 + fr, fq * 8), boff = lds_byte(wc * 32 + fr, fq * 8);
#define PG8_SA(b, h) (((b) * 2 + (h)) * HTB)
#define PG8_SB(b, h) ((4 + (b) * 2 + (h)) * HTB)
#define PG8_STAGE(bufoff, gbase, voff) do { _Pragma("unroll") for (int _i = 0; _i < 2; ++_i) \
        __builtin_amdgcn_global_load_lds((const unsigned*)((const char*)(gbase) + (voff)[_i]), (LAS unsigned*)(lds + (bufoff) + ldsw + _i * 8192), 16, 0, 0); } while (0)
#define PG8_LDA(dst, b, h) do { _Pragma("unroll") for (int m = 0; m < 4; ++m) _Pragma("unroll") for (int k = 0; k < 2; ++k) dst[m][k] = *(const LAS h16x8*)(lds + PG8_SA(b, h) + aoff + m * 2048 + k * 1024); } while (0)
#define PG8_LDB(dst, b, h) do { _Pragma("unroll") for (int n = 0; n < 2; ++n) _Pragma("unroll") for (int k = 0; k < 2; ++k) dst[n][k] = *(const LAS h16x8*)(lds + PG8_SB(b, h) + boff + n * 2048 + k * 1024); } while (0)
#define PG8_MMA(ai, bj, At, Bt) do { __builtin_amdgcn_s_setprio(3); _Pragma("unroll") for (int m = 0; m < 4; ++m) _Pragma("unroll") for (int n = 0; n < 2; ++n) _Pragma("unroll") for (int k = 0; k < 2; ++k) \
        acc[ai][bj][m][n] = __builtin_amdgcn_mfma_f32_16x16x32_f16(Bt[n][k], At[m][k], acc[ai][bj][m][n], 0, 0, 0); __builtin_amdgcn_s_setprio(0); } while (0)
#define PG8_WAIT_V(n) asm volatile("s_waitcnt vmcnt(" #n ")" ::: "memory")
#define PG8_WAIT_L(n) asm volatile("s_waitcnt lgkmcnt(" #n ")" ::: "memory")
#define PG8_BAR __builtin_amdgcn_s_barrier()
#define PG8_SCHED __builtin_amdgcn_sched_barrier(0)
    Unit cur, nxt; int ui = 0;
    if (!S.next(0, cur)) return;
    f32x4 acc[2][2][4][2];
#pragma unroll
    for (int a = 0; a < 2; ++a)
#pragma unroll
        for (int b = 0; b < 2; ++b)
#pragma unroll
            for (int m = 0; m < 4; ++m)
#pragma unroll
                for (int n = 0; n < 2; ++n) acc[a][b][m][n] = (f32x4){0.f, 0.f, 0.f, 0.f};
    h16x8 At[4][2], B0[2][2], B1[2][2];
    const char* cA = (const char*)g.A + (size_t)cur.pm * tstep; const char* cB = (const char*)g.Bt + (size_t)cur.pn * tstep;
    if constexpr (SP2) {
        PG8_STAGE(PG8_SB(0, 0), cB, voffB); PG8_STAGE(PG8_SB(0, 1), cB + hstep, voffB); PG8_STAGE(PG8_SA(0, 0), cA, voffA); PG8_STAGE(PG8_SA(0, 1), cA + hstep, voffA);
        if (wr == 1) PG8_BAR;
        PG8_WAIT_V(2); PG8_BAR;
        PG8_STAGE(PG8_SB(1, 0), cB + kstep, voffB); PG8_STAGE(PG8_SA(1, 0), cA + kstep, voffA); PG8_STAGE(PG8_SB(1, 1), cB + hstep + kstep, voffB);
        PG8_WAIT_V(6); PG8_BAR;
    } else {
        PG8_STAGE(PG8_SB(0, 0), cB, voffB); PG8_STAGE(PG8_SA(0, 0), cA, voffA); PG8_STAGE(PG8_SB(0, 1), cB + hstep, voffB); PG8_STAGE(PG8_SA(0, 1), cA + hstep, voffA);
        if (wr == 1) PG8_BAR;
        PG8_WAIT_V(4); PG8_BAR;
        PG8_STAGE(PG8_SB(1, 0), cB + kstep, voffB); PG8_STAGE(PG8_SA(1, 0), cA + kstep, voffA); PG8_STAGE(PG8_SB(1, 1), cB + hstep + kstep, voffB);
        PG8_WAIT_V(6); PG8_BAR;
    }
    for (;;) {
        const bool has_next = S.next(ui + 1, nxt);
        const char* nA = has_next ? (const char*)g.A + (size_t)nxt.pm * tstep : cA; const char* nB = has_next ? (const char*)g.Bt + (size_t)nxt.pn * tstep : cB;
        for (int t = 0; t < nt; t += 2) {
            const bool last = (t == nt - 2);
            const char* a1 = cA + (size_t)(t + 1) * kstep;
            const char* a2 = last ? nA : cA + (size_t)(t + 2) * kstep; const char* b2 = last ? nB : cB + (size_t)(t + 2) * kstep;
            const char* a3 = a2 + kstep; const char* b3 = b2 + kstep;
            if constexpr (SP2) {
            PG8_LDB(B0, 0, 0); PG8_LDB(B1, 0, 1); PG8_SCHED; PG8_LDA(At, 0, 0); PG8_STAGE(PG8_SA(1, 1), a1 + hstep, voffA);
            PG8_WAIT_V(8); PG8_WAIT_L(0); PG8_BAR; PG8_MMA(0, 0, At, B0); PG8_MMA(0, 1, At, B1); PG8_BAR; PG8_SCHED;
            PG8_LDA(At, 0, 1); PG8_STAGE(PG8_SB(0, 0), b2, voffB); PG8_STAGE(PG8_SB(0, 1), b2 + hstep, voffB); PG8_STAGE(PG8_SA(0, 0), a2, voffA);
            PG8_WAIT_V(8); PG8_WAIT_L(0); PG8_BAR; PG8_MMA(1, 0, At, B0); PG8_MMA(1, 1, At, B1); PG8_BAR; PG8_SCHED;
            PG8_LDB(B0, 1, 0); PG8_LDB(B1, 1, 1); PG8_SCHED; PG8_LDA(At, 1, 0); PG8_STAGE(PG8_SA(0, 1), a2 + hstep, voffA);
            PG8_WAIT_V(8); PG8_WAIT_L(0); PG8_BAR; PG8_MMA(0, 0, At, B0); PG8_MMA(0, 1, At, B1); PG8_BAR; PG8_SCHED;
            PG8_LDA(At, 1, 1); PG8_STAGE(PG8_SB(1, 0), b3, voffB); PG8_STAGE(PG8_SB(1, 1), b3 + hstep, voffB); PG8_STAGE(PG8_SA(1, 0), a3, voffA);
            PG8_WAIT_V(8); PG8_WAIT_L(0); PG8_BAR; PG8_MMA(1, 0, At, B0); PG8_MMA(1, 1, At, B1); PG8_BAR; PG8_SCHED;
            } else {
            PG8_LDB(B0, 0, 0); PG8_SCHED; PG8_LDA(At, 0, 0); PG8_STAGE(PG8_SA(1, 1), a1 + hstep, voffA);
            PG8_WAIT_L(8); PG8_BAR; PG8_WAIT_L(0); PG8_MMA(0, 0, At, B0); PG8_BAR; PG8_SCHED;
            PG8_LDB(B1, 0, 1); PG8_STAGE(PG8_SB(0, 0), b2, voffB);
            PG8_BAR; PG8_WAIT_L(0); PG8_MMA(0, 1, At, B1); PG8_BAR;
            PG8_LDA(At, 0, 1); PG8_STAGE(PG8_SA(0, 0), a2, voffA);
            PG8_BAR; PG8_WAIT_L(0); PG8_MMA(1, 0, At, B0); PG8_BAR; PG8_SCHED;
            PG8_STAGE(PG8_SB(0, 1), b2 + hstep, voffB);
            PG8_WAIT_V(6); PG8_BAR; PG8_MMA(1, 1, At, B1); PG8_BAR;
            PG8_LDB(B0, 1, 0); PG8_SCHED; PG8_LDA(At, 1, 0); PG8_STAGE(PG8_SA(0, 1), a2 + hstep, voffA);
            PG8_WAIT_L(8); PG8_BAR; PG8_WAIT_L(0); PG8_MMA(0, 0, At, B0); PG8_BAR; PG8_SCHED;
            PG8_LDB(B1, 1, 1); PG8_STAGE(PG8_SB(1, 0), b3, voffB);
            PG8_BAR; PG8_WAIT_L(0); PG8_MMA(0, 1, At, B1); PG8_BAR;
            PG8_LDA(At, 1, 1); PG8_STAGE(PG8_SA(1, 0), a3, voffA);
            PG8_BAR; PG8_WAIT_L(0); PG8_MMA(1, 0, At, B0); PG8_BAR; PG8_SCHED;
            PG8_STAGE(PG8_SB(1, 1), b3 + hstep, voffB);
            PG8_WAIT_V(6); PG8_BAR; PG8_MMA(1, 1, At, B1); PG8_BAR;
            }
        }
        if constexpr (ALIGN_EPI) { if (wr == 0) PG8_BAR; }
        if constexpr (Epi::CUSTOM) { E.run(acc, cur, wr, wc, fr, fq, lds); }
        else if constexpr (Epi::PERM) {
            const int row0 = cur.pm * BM + wr * 64 + fr, col0 = cur.pn * BM + wc * 32 + 8 * fq;
            E.begin_unit(cur.pn, col0);
#pragma unroll
            for (int ai = 0; ai < 2; ++ai)
#pragma unroll
                for (int m = 0; m < 4; ++m)
#pragma unroll
                    for (int bj = 0; bj < 2; ++bj) E.store8(row0 + ai * HALF + m * 16, col0 + bj * HALF, acc[ai][bj][m][0], acc[ai][bj][m][1]);
        } else {
            const int row0 = cur.pm * BM + wr * 64 + fr, col0 = cur.pn * BM + wc * 32 + 4 * fq;
#pragma unroll
            for (int ai = 0; ai < 2; ++ai)
#pragma unroll
                for (int m = 0; m < 4; ++m)
#pragma unroll
                    for (int bj = 0; bj < 2; ++bj)
#pragma unroll
                        for (int n = 0; n < 2; ++n) E.store4(row0 + ai * HALF + m * 16, col0 + bj * HALF + n * 16, acc[ai][bj][m][n]);
        }
        if (!has_next) break;
#pragma unroll
        for (int a = 0; a < 2; ++a)
#pragma unroll
            for (int b = 0; b < 2; ++b)
#pragma unroll
                for (int m = 0; m < 4; ++m)
#pragma unroll
                    for (int n = 0; n < 2; ++n) acc[a][b][m][n] = (f32x4){0.f, 0.f, 0.f, 0.f};
        cur = nxt; cA = nA; cB = nB; ++ui;
        if constexpr (ALIGN_EPI) { if (wr == 1) PG8_BAR; }
    }
    PG8_WAIT_V(0);
    if constexpr (!ALIGN_EPI) { if (wr == 0) PG8_BAR; }
    PG8_BAR;
#undef PG8_SA
#undef PG8_SB
#undef PG8_STAGE
#undef PG8_LDA
#undef PG8_LDB
#undef PG8_MMA
#undef PG8_WAIT_V
#undef PG8_WAIT_L
#undef PG8_BAR
#undef PG8_SCHED
}

}

template <class Epi>
__device__ __forceinline__ void run_gemm(LAS unsigned char* lds, const h16* A, const h16* Bt, int M, int N, int K, int bid, int nb, const Epi& E, int wgm) {
    pg8::Gemm g{A, Bt, M, N, K};
    pg8::StaticOrder S; S.init(M, N, nb, bid, wgm);
    pg8::gemm_phase(lds, g, S, E);
}

__device__ __forceinline__ u32x2 pack_h4(f32x4 v) {
    h16x2 a = {(h16)v[0], (h16)v[1]}, b = {(h16)v[2], (h16)v[3]};
    u32x2 r; r.x = __builtin_bit_cast(unsigned, a); r.y = __builtin_bit_cast(unsigned, b); return r;
}

__device__ __forceinline__ u32x4 pack_h8(f32x4 a, f32x4 b) { const u32x2 x = pack_h4(a), y = pack_h4(b); return (u32x4){x.x, x.y, y.x, y.y}; }
struct EpiProj {
    static constexpr bool PERM = true, CUSTOM = true;
    h16* cq; float* ssq; h16* ckv; h16* kidx; float* widx; h16* projB; const float* gkv; const float* gk; const float* bk;
    __device__ __forceinline__ void run(const f32x4 (&acc)[2][2][4][2], const pg8::Unit& u, int wr, int wc, int fr, int fq, LAS unsigned char* lds) const {
        const int row0 = u.pm * 256 + wr * 64 + fr, cin = wc * 32 + 8 * fq;
        if (u.pn >= 4) {
            h16* base = projB + (size_t)row0 * 3072 + (u.pn - 4) * 256 + cin;
#pragma unroll
            for (int ai = 0; ai < 2; ++ai)
#pragma unroll
                for (int m = 0; m < 4; ++m)
#pragma unroll
                    for (int bj = 0; bj < 2; ++bj) *(u32x4*)(base + (size_t)(ai * 128 + m * 16) * 3072 + bj * 128) = pack_h8(acc[ai][bj][m][0], acc[ai][bj][m][1]);
            return;
        }
        LAS float* P = (LAS float*)(lds + 131072);
        if (u.pn == 3) {
            if (wc < 2) {
#pragma unroll
                for (int ai = 0; ai < 2; ++ai)
#pragma unroll
                    for (int m = 0; m < 4; ++m) {
                        const f32x4 a = acc[ai][0][m][0], b = acc[ai][0][m][1];
                        float sm = (a[0] + a[1]) + (a[2] + a[3]) + (b[0] + b[1]) + (b[2] + b[3]);
                        float sq = (a[0] * a[0] + a[1] * a[1]) + (a[2] * a[2] + a[3] * a[3]) + (b[0] * b[0] + b[1] * b[1]) + (b[2] * b[2] + b[3] * b[3]);
                        sm += __shfl_xor(sm, 16); sm += __shfl_xor(sm, 32); sq += __shfl_xor(sq, 16); sq += __shfl_xor(sq, 32);
                        if (fq == 0) *(LAS f32x2*)(P + ((ai * 128 + wr * 64 + m * 16 + fr) * 2 + wc) * 2) = (f32x2){sm, sq};
                    }
            }
            asm volatile("s_waitcnt lgkmcnt(0)" ::: "memory"); __builtin_amdgcn_s_barrier(); asm volatile("" ::: "memory");
            if (wc < 2) {
                const f32x4 g0 = *(const f32x4*)(gk + cin), g1 = *(const f32x4*)(gk + cin + 4), b0 = *(const f32x4*)(bk + cin), b1 = *(const f32x4*)(bk + cin + 4);
#pragma unroll
                for (int ai = 0; ai < 2; ++ai)
#pragma unroll
                    for (int m = 0; m < 4; ++m) {
                        const f32x4 pp = *(const LAS f32x4*)(P + (ai * 128 + wr * 64 + m * 16 + fr) * 4);
                        const float mean = (pp[0] + pp[2]) * (1.f / 64.f);
                        const f32x4 xa = acc[ai][0][m][0] - mean, xb = acc[ai][0][m][1] - mean;
                        const float var = fmaxf((pp[1] + pp[3]) * (1.f / 64.f) - mean * mean, 0.f);
                        const float rstd = rsqrtf(var + EPS);
                        *(u32x4*)(kidx + (size_t)(row0 + ai * 128 + m * 16) * 64 + cin) = pack_h8(xa * rstd * g0 + b0, xb * rstd * g1 + b1);
                    }
            } else if (wc == 2 && fq < 2) {
#pragma unroll
                for (int ai = 0; ai < 2; ++ai)
#pragma unroll
                    for (int m = 0; m < 4; ++m) {
                        float* o = widx + (size_t)(row0 + ai * 128 + m * 16) * 16 + 8 * fq;
                        *(f32x4*)o = acc[ai][0][m][0] * (1.f / 32.f); *(f32x4*)(o + 4) = acc[ai][0][m][1] * (1.f / 32.f);
                    }
            }
            return;
        }
#pragma unroll
        for (int ai = 0; ai < 2; ++ai)
#pragma unroll
            for (int m = 0; m < 4; ++m) {
                float ss = 0.f;
#pragma unroll
                for (int bj = 0; bj < 2; ++bj)
#pragma unroll
                    for (int n = 0; n < 2; ++n) { const f32x4 v = acc[ai][bj][m][n]; ss += (v[0] * v[0] + v[1] * v[1]) + (v[2] * v[2] + v[3] * v[3]); }
                ss += __shfl_xor(ss, 16); ss += __shfl_xor(ss, 32);
                if (fq == 0) P[(ai * 128 + wr * 64 + m * 16 + fr) * 4 + wc] = ss;
            }
        asm volatile("s_waitcnt lgkmcnt(0)" ::: "memory"); __builtin_amdgcn_s_barrier(); asm volatile("" ::: "memory");
        if (u.pn < 2) {
            h16* base = cq + (size_t)row0 * 512 + u.pn * 256 + cin;
#pragma unroll
            for (int ai = 0; ai < 2; ++ai)
#pragma unroll
                for (int m = 0; m < 4; ++m) {
#pragma unroll
                    for (int bj = 0; bj < 2; ++bj) *(u32x4*)(base + (size_t)(ai * 128 + m * 16) * 512 + bj * 128) = pack_h8(acc[ai][bj][m][0], acc[ai][bj][m][1]);
                    if (wc == 0 && fq == 0) { const f32x4 pp = *(const LAS f32x4*)(P + (ai * 128 + wr * 64 + m * 16 + fr) * 4); ssq[(size_t)(row0 + ai * 128 + m * 16) * 2 + u.pn] = (pp[0] + pp[1]) + (pp[2] + pp[3]); }
                }
        } else {
            h16* base = ckv + (size_t)row0 * 256 + cin;
            f32x4 g[2][2];
#pragma unroll
            for (int bj = 0; bj < 2; ++bj)
#pragma unroll
                for (int n = 0; n < 2; ++n) g[bj][n] = *(const f32x4*)(gkv + cin + bj * 128 + 4 * n);
#pragma unroll
            for (int ai = 0; ai < 2; ++ai)
#pragma unroll
                for (int m = 0; m < 4; ++m) {
                    const f32x4 pp = *(const LAS f32x4*)(P + (ai * 128 + wr * 64 + m * 16 + fr) * 4);
                    const float rstd = rsqrtf(((pp[0] + pp[1]) + (pp[2] + pp[3])) * (1.f / 256.f) + EPS);
#pragma unroll
                    for (int bj = 0; bj < 2; ++bj) *(u32x4*)(base + (size_t)(ai * 128 + m * 16) * 256 + bj * 128) = pack_h8(acc[ai][bj][m][0] * rstd * g[bj][0], acc[ai][bj][m][1] * rstd * g[bj][1]);
                }
        }
    }
};
struct EpiQ {
    static constexpr bool PERM = true, CUSTOM = true;
    h16* qabs; h16* iq; const float* gq; const float* ssq;
    __device__ __forceinline__ void run(const f32x4 (&acc)[2][2][4][2], const pg8::Unit& u, int wr, int wc, int fr, int fq, LAS unsigned char* lds) const {
        const int row0 = u.pm * 256 + wr * 64 + fr, cin = wc * 32 + 8 * fq;
        float rr[2][4];
#pragma unroll
        for (int ai = 0; ai < 2; ++ai)
#pragma unroll
            for (int m = 0; m < 4; ++m) { const f32x2 s2 = *(const f32x2*)(ssq + (size_t)(row0 + ai * 128 + m * 16) * 2); rr[ai][m] = rsqrtf((s2[0] + s2[1]) * (1.f / 512.f) + EPS); }
        if (u.pn >= 8) {
            h16* base = iq + (size_t)row0 * 1024 + (u.pn - 8) * 256 + cin;
#pragma unroll
            for (int ai = 0; ai < 2; ++ai)
#pragma unroll
                for (int m = 0; m < 4; ++m)
#pragma unroll
                    for (int bj = 0; bj < 2; ++bj) *(u32x4*)(base + (size_t)(ai * 128 + m * 16) * 1024 + bj * 128) = pack_h8(acc[ai][bj][m][0] * rr[ai][m], acc[ai][bj][m][1] * rr[ai][m]);
            return;
        }
        LAS float* P = (LAS float*)(lds + 131072);
#pragma unroll
        for (int ai = 0; ai < 2; ++ai)
#pragma unroll
            for (int m = 0; m < 4; ++m) {
                float ss = 0.f;
#pragma unroll
                for (int bj = 0; bj < 2; ++bj)
#pragma unroll
                    for (int n = 0; n < 2; ++n) { const f32x4 v = acc[ai][bj][m][n]; ss += (v[0] * v[0] + v[1] * v[1]) + (v[2] * v[2] + v[3] * v[3]); }
                ss += __shfl_xor(ss, 16); ss += __shfl_xor(ss, 32);
                if (fq == 0) P[(ai * 128 + wr * 64 + m * 16 + fr) * 4 + wc] = ss * (rr[ai][m] * rr[ai][m]);
            }
        asm volatile("s_waitcnt lgkmcnt(0)" ::: "memory"); __builtin_amdgcn_s_barrier(); asm volatile("" ::: "memory");
        h16* base = qabs + (size_t)row0 * 2048 + u.pn * 256 + cin;
        f32x4 g[2][2];
#pragma unroll
        for (int bj = 0; bj < 2; ++bj)
#pragma unroll
            for (int n = 0; n < 2; ++n) g[bj][n] = *(const f32x4*)(gq + cin + bj * 128 + 4 * n) * 0.0625f;
#pragma unroll
        for (int ai = 0; ai < 2; ++ai)
#pragma unroll
            for (int m = 0; m < 4; ++m) {
                const f32x4 pp = *(const LAS f32x4*)(P + (ai * 128 + wr * 64 + m * 16 + fr) * 4);
                const float rstd = rsqrtf(((pp[0] + pp[1]) + (pp[2] + pp[3])) * (1.f / 256.f) + EPS) * rr[ai][m];
#pragma unroll
                for (int bj = 0; bj < 2; ++bj) *(u32x4*)(base + (size_t)(ai * 128 + m * 16) * 2048 + bj * 128) = pack_h8(acc[ai][bj][m][0] * rstd * g[bj][0], acc[ai][bj][m][1] * rstd * g[bj][1]);
            }
    }
};
struct EpiF16 {
    static constexpr bool PERM = true, CUSTOM = false;
    h16* o; const float* bias; mutable f32x4 bz[2][2]; mutable int cbase;
    __device__ __forceinline__ void begin_unit(int, int col0) const {
        cbase = col0;
#pragma unroll
        for (int bj = 0; bj < 2; ++bj)
#pragma unroll
            for (int n = 0; n < 2; ++n) bz[bj][n] = bias ? *(const f32x4*)(bias + col0 + bj * 128 + 4 * n) : (f32x4){0.f, 0.f, 0.f, 0.f};
    }
    __device__ __forceinline__ void store8(int row, int col, f32x4 v0, f32x4 v1) const {
        const int bj = (col - cbase) >> 7;
        *(u32x4*)(o + (size_t)row * 2048 + col) = pack_h8(v0 + (bj ? bz[1][0] : bz[0][0]), v1 + (bj ? bz[1][1] : bz[0][1]));
    }
};
struct EpiMlp1 {
    static constexpr bool PERM = true, CUSTOM = false;
    LAS const h16* b1l; h16* a; mutable f32x4 bz[2][2]; mutable int cbase;
    __device__ __forceinline__ void begin_unit(int, int col0) const {
        cbase = col0;
#pragma unroll
        for (int bj = 0; bj < 2; ++bj)
#pragma unroll
            for (int n = 0; n < 2; ++n) { const h16x4 hb = *(LAS const h16x4*)(b1l + col0 + bj * 128 + 4 * n); bz[bj][n] = (f32x4){(float)hb[0], (float)hb[1], (float)hb[2], (float)hb[3]}; }
    }
    __device__ __forceinline__ f32x4 actb(f32x4 v, f32x4 b) const {
        f32x4 z = v + b;
#pragma unroll
        for (int j = 0; j < 4; ++j) { const float r = fmaxf(z[j], 0.f); z[j] = r * r; }
        return z;
    }
    __device__ __forceinline__ void store8(int row, int col, f32x4 v0, f32x4 v1) const {
        const int bj = (col - cbase) >> 7;
        *(u32x4*)(a + (size_t)row * D_FF + col) = pack_h8(actb(v0, bj ? bz[1][0] : bz[0][0]), actb(v1, bj ? bz[1][1] : bz[0][1]));
    }
};
template <bool SCALE>
__device__ __forceinline__ void transpose_item(const float* __restrict__ src, int ld, int k0, int n0, int nvalid, const float* __restrict__ kscale,
                                               h16* __restrict__ dst, int dst_ld, int dst_row0, int dst_k0, LAS float* scr, int lane) {
    const int n = lane & 31, nn = n < nvalid ? n : nvalid - 1;
    const float msk = n < nvalid ? 1.f : 0.f;
    const float* sp = src + (size_t)(k0 + (lane >> 5)) * ld + n0 + nn;
    float v[32];
#pragma unroll
    for (int i = 0; i < 32; ++i) v[i] = sp[(size_t)(2 * i) * ld];
    if (SCALE) {
        float sc[32];
#pragma unroll
        for (int i = 0; i < 32; ++i) sc[i] = kscale[k0 + 2 * i + (lane >> 5)];
#pragma unroll
        for (int i = 0; i < 32; ++i) v[i] *= sc[i];
    }
#pragma unroll
    for (int i = 0; i < 32; ++i) scr[(2 * i + (lane >> 5)) * 33 + n] = v[i] * msk;
    LDS_WAIT(); asm volatile("" ::: "memory");
    const int c = lane & 7;
#pragma unroll
    for (int j = 0; j < 4; ++j) {
        const int nr = (lane >> 3) + 8 * j; const LAS float* s = scr + (8 * c) * 33 + nr;
        h16x8 o;
#pragma unroll
        for (int q = 0; q < 8; ++q) o[q] = (h16)s[q * 33];
        *(h16x8*)(dst + (size_t)(dst_row0 + nr) * dst_ld + dst_k0 + 8 * c) = o;
    }
    LDS_WAIT(); asm volatile("" ::: "memory");
}

__device__ __forceinline__ void phase_prep(const Params& p, LAS unsigned char* lds, int bid, int nb) {
    const int tid = threadIdx.x, lane = tid & 63, wave = tid >> 6;
    unsigned char* ws = p.ws;
    __syncthreads();
    {
        LAS f32x4* cact = (LAS f32x4*)lds;
        LAS float* red = (LAS float*)(lds + 32768);
        for (int i = tid; i < 4 * 2048; i += NTHREADS) { const int b = i >> 11, k = i & 2047; const float v = p.c[b * 2048 + k]; ((LAS float*)cact)[k * 4 + b] = v / (1.f + __expf(-v)); }
        __syncthreads();
        float* mod = (float*)(ws + WS_MOD);
        for (int cgp = bid; cgp < 192; cgp += nb) {
            const int col = cgp * 64 + lane;
            float a0 = 0.f, a1 = 0.f, a2 = 0.f, a3 = 0.f;
            const float* wp = p.w_ada + (size_t)(wave * 256) * 12288 + col;
            for (int kb = 0; kb < 256; kb += 32) {
                float wv[32];
#pragma unroll
                for (int j = 0; j < 32; ++j) wv[j] = wp[(size_t)(kb + j) * 12288];
#pragma unroll
                for (int j = 0; j < 32; ++j) { const f32x4 cv = cact[wave * 256 + kb + j]; a0 += cv[0] * wv[j]; a1 += cv[1] * wv[j]; a2 += cv[2] * wv[j]; a3 += cv[3] * wv[j]; }
            }
            red[(wave * 4 + 0) * 64 + lane] = a0; red[(wave * 4 + 1) * 64 + lane] = a1; red[(wave * 4 + 2) * 64 + lane] = a2; red[(wave * 4 + 3) * 64 + lane] = a3;
            __syncthreads();
            if (tid < 256) {
                const int b = tid >> 6, l = tid & 63; float s = 0.f;
#pragma unroll
                for (int w = 0; w < 8; ++w) s += red[(w * 4 + b) * 64 + l];
                const int cc = cgp * 64 + l;
                mod[b * 12288 + cc] = s + p.b_ada[cc];
            }
            __syncthreads();
        }
    }
    LAS float* scr = (LAS float*)(lds + wave * 16384);
    const int gw = bid * NWAVES + wave, NGW = nb * NWAVES;
    constexpr int I_IN = 32 * 128, I_1 = 32 * 256, I_2 = 128 * 64, I_OUT = 32 * 64, I_IQ = 8 * 32, I_UV = 8 * 4 * 4, I_QA = 8 * 8 * 8;
    constexpr int NITEMS = I_IN + I_1 + I_2 + I_OUT + I_IQ + I_UV + I_QA;
    const bool bal = (nb == 256);
    const int nextra = bal ? 6 : 0, base_it = bal ? 3072 : 0;
    const int nstr = (NITEMS - I_QA - base_it - gw + NGW - 1) / NGW;
    for (int kk = 0; kk < nextra + nstr; ++kk) {
        int it;
        if (kk < nextra) { if (bid < 192) continue; it = ((bid - 192) * NWAVES + wave) + 512 * kk; }
        else it = base_it + gw + (kk - nextra) * NGW;
        int r = it;
        const float* src; int ld, k0, n0, nvalid = 32, dld, drow0; const float* ksc = nullptr; h16* dst;
        if (r < I_IN) {
            const int kb = r / 128, nbk = r % 128, n0d = nbk * 32;
            if (n0d >= 864 && n0d < 1024) continue;
            src = p.w_in; ld = IN_COLS; k0 = kb * 64; n0 = n0d < 1024 ? n0d : n0d - 176; nvalid = (n0d == 832) ? 16 : 32; dst = (h16*)(ws + WS_BT_IN); dld = 2048; drow0 = n0d;
        } else if ((r -= I_IN) < I_1) { const int kb = r / 256, nbk = r % 256; src = p.w_mlp1; ld = D_FF; k0 = kb * 64; n0 = nbk * 32; dst = (h16*)(ws + WS_BT_1); dld = 2048; drow0 = n0; }
        else if ((r -= I_1) < I_2) { const int kb = r / 64, nbk = r % 64; src = p.w_mlp2; ld = 2048; k0 = kb * 64; n0 = nbk * 32; dst = (h16*)(ws + WS_BT_2); dld = 8192; drow0 = n0; }
        else if ((r -= I_2) < I_OUT) { const int kb = r / 64, nbk = r % 64; src = p.w_out; ld = 2048; k0 = kb * 64; n0 = nbk * 32; dst = (h16*)(ws + WS_BT_OUT); dld = 2048; drow0 = n0; }
        else if ((r -= I_OUT) < I_IQ) { const int kb = r / 32, nbk = r % 32; src = p.w_iq; ld = 1024; k0 = kb * 64; n0 = nbk * 32; ksc = p.cq_norm_g; dst = (h16*)(ws + WS_BT_Q); dld = 512; drow0 = 2048 + n0; }
        else { r -= I_IQ; const int h = r / 16, kb = (r % 16) / 4, nbk = r % 4; src = p.w_uv + (size_t)h * 256 * 128; ld = 128; k0 = kb * 64; n0 = nbk * 32; dst = (h16*)(ws + WS_WUVT) + (size_t)h * 128 * 256; dld = 256; drow0 = n0; }
        if (ksc) transpose_item<true>(src, ld, k0, n0, nvalid, ksc, dst, dld, drow0, k0, scr, lane);
        else transpose_item<false>(src, ld, k0, n0, nvalid, ksc, dst, dld, drow0, k0, scr, lane);
    }
    for (int r = gw; r < I_QA; r += NGW) {
        {
            const int h = r / 64, kb = (r % 64) / 8, cb = r % 8, k0 = kb * 64, c0 = cb * 32;
#pragma unroll 8
            for (int e = lane; e < 128 * 32; e += 64) { const int d = e >> 5, c = e & 31; scr[e] = p.w_uk[((size_t)h * 128 + d) * 256 + c0 + c]; }
            LDS_WAIT(); asm volatile("" ::: "memory");
            float acc[32];
#pragma unroll
            for (int c = 0; c < 32; ++c) acc[c] = 0.f;
            const float* uq = p.w_uq + (size_t)(k0 + lane) * 1024 + h * 128;
#pragma unroll 1
            for (int d0 = 0; d0 < 128; d0 += 4) {
                const f32x4 a = *(const f32x4*)(uq + d0);
#pragma unroll
                for (int dd = 0; dd < 4; ++dd) {
#pragma unroll
                    for (int c4 = 0; c4 < 8; ++c4) { const f32x4 w = *(const LAS f32x4*)(scr + (d0 + dd) * 32 + c4 * 4);
                        acc[c4 * 4 + 0] += a[dd] * w[0]; acc[c4 * 4 + 1] += a[dd] * w[1]; acc[c4 * 4 + 2] += a[dd] * w[2]; acc[c4 * 4 + 3] += a[dd] * w[3]; }
                    asm volatile("" ::: "memory");
                }
            }
            const float gk = p.cq_norm_g[k0 + lane];
            h16* dst = (h16*)(ws + WS_BT_Q);
            h16* dp = dst + (size_t)(h * 256 + c0) * 512 + k0 + lane;
#pragma unroll
            for (int c = 0; c < 32; ++c) { dp[(size_t)c * 512] = (h16)(acc[c] * gk); if ((c & 3) == 3) asm volatile("" ::: "memory"); }
            LDS_WAIT(); asm volatile("" ::: "memory");
        }
    }
    {
        u32x4* z = (u32x4*)((h16*)(ws + WS_BT_IN) + (size_t)848 * 2048);
        const int n16 = 176 * 2048 * 2 / 16;
        for (int i = bid * NTHREADS + tid; i < n16; i += nb * NTHREADS) z[i] = (u32x4){0u, 0u, 0u, 0u};
    }
}

__device__ __forceinline__ void phase_normmod(const float* __restrict__ xin, const float* __restrict__ g, const float* __restrict__ mod, int sh_off, int sc_off, h16* __restrict__ hout, int bid, int nb) {
    const int tid = threadIdx.x, lane = tid & 63, wave = tid >> 6;
    for (int t = bid * NWAVES + wave; t < T; t += nb * NWAVES) {
        const int b = t >> 12;
        const f32x4* xr = (const f32x4*)(xin + (size_t)t * 2048) + lane;
        f32x4 v[8]; float ss = 0.f;
#pragma unroll
        for (int j = 0; j < 8; ++j) { v[j] = xr[64 * j]; ss += (v[j][0] * v[j][0] + v[j][1] * v[j][1]) + (v[j][2] * v[j][2] + v[j][3] * v[j][3]); }
        const float rstd = rsqrtf(wave_sum(ss) * (1.f / 2048.f) + EPS);
        const float* mb = mod + b * 12288;
        u32x2* o = (u32x2*)(hout + (size_t)t * 2048) + lane;
#pragma unroll
        for (int j = 0; j < 8; ++j) {
            const int d = (lane + 64 * j) * 4;
            const f32x4 gg = *(const f32x4*)(g + d), sc = *(const f32x4*)(mb + sc_off + d), sh = *(const f32x4*)(mb + sh_off + d);
            f32x4 y = (v[j] * rstd) * gg;
            y = y * (sc + 1.f) + sh;
            o[64 * j] = pack_h4(y);
        }
    }
}

__device__ __forceinline__ void phase_normmod2(const Params& p, int bid, int nb) {
    const int tid = threadIdx.x, lane = tid & 63, wave = tid >> 6;
    const float* mod = (const float*)(p.ws + WS_MOD); const h16* y6 = (const h16*)(p.ws + WS_Y6); h16* hout = (h16*)(p.ws + WS_R2);
    for (int t = bid * NWAVES + wave; t < T; t += nb * NWAVES) {
        const int b = t >> 12; const float* mb = mod + b * 12288;
        const f32x4* xr = (const f32x4*)(p.x + (size_t)t * 2048) + lane;
        const u32x2* yr = (const u32x2*)(y6 + (size_t)t * 2048) + lane;
        f32x4 v[8]; float ss = 0.f;
#pragma unroll
        for (int j = 0; j < 8; ++j) {
            const int d = (lane + 64 * j) * 4;
            const f32x4 xv = xr[64 * j]; const h16x4 yh = __builtin_bit_cast(h16x4, yr[64 * j]); const f32x4 g1 = *(const f32x4*)(mb + 2 * 2048 + d);
            const f32x4 yv = {(float)yh[0], (float)yh[1], (float)yh[2], (float)yh[3]};
            v[j] = xv + g1 * yv;
            ss += (v[j][0] * v[j][0] + v[j][1] * v[j][1]) + (v[j][2] * v[j][2] + v[j][3] * v[j][3]);
        }
        const float rstd = rsqrtf(wave_sum(ss) * (1.f / 2048.f) + EPS);
        u32x2* o = (u32x2*)(hout + (size_t)t * 2048) + lane;
#pragma unroll
        for (int j = 0; j < 8; ++j) {
            const int d = (lane + 64 * j) * 4;
            const f32x4 gg = *(const f32x4*)(p.norm2_g + d), sc = *(const f32x4*)(mb + 4 * 2048 + d), sh = *(const f32x4*)(mb + 3 * 2048 + d);
            f32x4 y = (v[j] * rstd) * gg;
            y = y * (sc + 1.f) + sh;
            o[64 * j] = pack_h4(y);
        }
    }
}
__device__ __forceinline__ void phase_final(const Params& p, int bid, int nb) {
    const int tid = threadIdx.x, lane = tid & 63, wave = tid >> 6;
    const float* mod = (const float*)(p.ws + WS_MOD); const h16* y6 = (const h16*)(p.ws + WS_Y6); const h16* m16 = (const h16*)(p.ws + WS_R2);
    for (int t = bid * NWAVES + wave; t < T; t += nb * NWAVES) {
        const int b = t >> 12; const float* mb = mod + b * 12288;
        const f32x4* xr = (const f32x4*)(p.x + (size_t)t * 2048) + lane;
        const u32x2* yr = (const u32x2*)(y6 + (size_t)t * 2048) + lane;
        const u32x2* mr = (const u32x2*)(m16 + (size_t)t * 2048) + lane;
        f32x4* orow = (f32x4*)(p.out + (size_t)t * 2048) + lane;
#pragma unroll
        for (int j = 0; j < 8; ++j) {
            const int d = (lane + 64 * j) * 4;
            const f32x4 xv = xr[64 * j]; const h16x4 yh = __builtin_bit_cast(h16x4, yr[64 * j]), mh = __builtin_bit_cast(h16x4, mr[64 * j]);
            const f32x4 g1 = *(const f32x4*)(mb + 2 * 2048 + d), g2 = *(const f32x4*)(mb + 5 * 2048 + d);
            const f32x4 yv = {(float)yh[0], (float)yh[1], (float)yh[2], (float)yh[3]}, mv = {(float)mh[0], (float)mh[1], (float)mh[2], (float)mh[3]};
            orow[64 * j] = (xv + g1 * yv) + g2 * mv;
        }
    }
}

__device__ __forceinline__ void phase_rows3(const Params& p, int bid, int nb) {
    const int tid = threadIdx.x, lane = tid & 63, wave = tid >> 6;
    unsigned char* ws = p.ws;
    const h16* projB = (const h16*)(ws + WS_PROJB);
    h16* ymix = (h16*)(ws + WS_R2);
    f32x4 w0[4], w1[4], w2[4], bb[4], gn[4];
#pragma unroll
    for (int q4 = 0; q4 < 4; ++q4) {
        const int c = lane * 16 + q4 * 4;
        w0[q4] = *(const f32x4*)(p.conv_w + c); w1[q4] = *(const f32x4*)(p.conv_w + 1024 + c); w2[q4] = *(const f32x4*)(p.conv_w + 2048 + c);
        bb[q4] = *(const f32x4*)(p.conv_b + c); gn[q4] = *(const f32x4*)(p.conv_out_norm_g + c);
    }
    for (int t = bid * NWAVES + wave; t < T; t += nb * NWAVES) {
        const int tl = t & (SEQ - 1);
        const h16* pb = projB + (size_t)t * 3072 + lane * 16;
        const int d1 = tl >= 1 ? 1 : 0, d2 = tl >= 2 ? 2 : 0;
        const float m1 = tl >= 1 ? 1.f : 0.f, m2 = tl >= 2 ? 1.f : 0.f;
        h16x8 gbv[2], cv[3][2], hv[3][2];
#pragma unroll
        for (int hh = 0; hh < 2; ++hh) {
            gbv[hh] = *(const h16x8*)(pb + hh * 8);
            cv[2][hh] = *(const h16x8*)(pb + 1024 + hh * 8); hv[2][hh] = *(const h16x8*)(pb + 2048 + hh * 8);
            cv[1][hh] = *(const h16x8*)(pb - (size_t)d1 * 3072 + 1024 + hh * 8); hv[1][hh] = *(const h16x8*)(pb - (size_t)d1 * 3072 + 2048 + hh * 8);
            cv[0][hh] = *(const h16x8*)(pb - (size_t)d2 * 3072 + 1024 + hh * 8); hv[0][hh] = *(const h16x8*)(pb - (size_t)d2 * 3072 + 2048 + hh * 8);
        }
        float y[16], ss = 0.f;
#pragma unroll
        for (int i = 0; i < 16; ++i) {
            const int hh = i >> 3, q = i & 7, q4 = i >> 2, qq = i & 3;
            const float u0 = (float)cv[0][hh][q] * (float)hv[0][hh][q] * m2, u1 = (float)cv[1][hh][q] * (float)hv[1][hh][q] * m1, u2 = (float)cv[2][hh][q] * (float)hv[2][hh][q];
            float sacc = bb[q4][qq] + w0[q4][qq] * u0; sacc = sacc + w1[q4][qq] * u1; sacc = sacc + w2[q4][qq] * u2;
            y[i] = (float)gbv[hh][q] * sacc; ss += y[i] * y[i];
        }
        ss += __shfl_xor(ss, 1); ss += __shfl_xor(ss, 2); ss += __shfl_xor(ss, 4);
        const float rstd = rsqrtf(ss * (1.f / 128.f) + EPS);
        h16x8 o0, o1;
#pragma unroll
        for (int q = 0; q < 8; ++q) { o0[q] = (h16)(y[q] * rstd * gn[q >> 2][q & 3]); o1[q] = (h16)(y[8 + q] * rstd * gn[2 + (q >> 2)][q & 3]); }
        *(h16x8*)(ymix + (size_t)t * 2048 + 1024 + lane * 16) = o0;
        *(h16x8*)(ymix + (size_t)t * 2048 + 1024 + lane * 16 + 8) = o1;
    }
}

__constant__ unsigned char c_bucket_thr[15] = {19, 21, 24, 27, 31, 35, 40, 46, 52, 59, 67, 77, 87, 99, 113};
__device__ __forceinline__ int t5_bucket(int n) {
    if (n < 16) return n;
    int bkt = 16;
#pragma unroll
    for (int i = 0; i < 15; ++i) bkt += (n >= (int)c_bucket_thr[i]) ? 1 : 0;
    return bkt;
}
typedef float f32x16 __attribute__((ext_vector_type(16)));
__device__ __forceinline__ float next_up(float x) {
    const unsigned u = __float_as_uint(x);
    if ((u << 1) == 0u) return __uint_as_float(1u);
    return __uint_as_float((u >> 31) ? u - 1u : u + 1u);
}
__device__ __forceinline__ int wave_sum_dpp(int x) {
    x += __builtin_amdgcn_update_dpp(0, x, 0xB1, 0xf, 0xf, false);
    x += __builtin_amdgcn_update_dpp(0, x, 0x4E, 0xf, 0xf, false);
    x += __builtin_amdgcn_update_dpp(0, x, 0x124, 0xf, 0xf, false);
    x += __builtin_amdgcn_update_dpp(0, x, 0x128, 0xf, 0xf, false);
    return (__builtin_amdgcn_readlane(x, 0) + __builtin_amdgcn_readlane(x, 16)) + (__builtin_amdgcn_readlane(x, 32) + __builtin_amdgcn_readlane(x, 48));
}
__device__ __forceinline__ float dpp_f(float v, const int ctrl_sel) {
    const int i = __float_as_int(v);
    int r;
    if (ctrl_sel == 0) r = __builtin_amdgcn_update_dpp(i, i, 0xB1, 0xf, 0xf, false);
    else if (ctrl_sel == 1) r = __builtin_amdgcn_update_dpp(i, i, 0x4E, 0xf, 0xf, false);
    else if (ctrl_sel == 2) r = __builtin_amdgcn_update_dpp(i, i, 0x124, 0xf, 0xf, false);
    else r = __builtin_amdgcn_update_dpp(i, i, 0x128, 0xf, 0xf, false);
    return __int_as_float(r);
}
__device__ __forceinline__ float wave_min_dpp(float v) {
    v = fminf(v, dpp_f(v, 0)); v = fminf(v, dpp_f(v, 1)); v = fminf(v, dpp_f(v, 2)); v = fminf(v, dpp_f(v, 3));
    const float a = __int_as_float(__builtin_amdgcn_readlane(__float_as_int(v), 0)), b = __int_as_float(__builtin_amdgcn_readlane(__float_as_int(v), 16));
    const float c = __int_as_float(__builtin_amdgcn_readlane(__float_as_int(v), 32)), d = __int_as_float(__builtin_amdgcn_readlane(__float_as_int(v), 48));
    return fminf(fminf(a, b), fminf(c, d));
}
__device__ __forceinline__ float wave_max_dpp(float v) {
    v = fmaxf(v, dpp_f(v, 0)); v = fmaxf(v, dpp_f(v, 1)); v = fmaxf(v, dpp_f(v, 2)); v = fmaxf(v, dpp_f(v, 3));
    const float a = __int_as_float(__builtin_amdgcn_readlane(__float_as_int(v), 0)), b = __int_as_float(__builtin_amdgcn_readlane(__float_as_int(v), 16));
    const float c = __int_as_float(__builtin_amdgcn_readlane(__float_as_int(v), 32)), d = __int_as_float(__builtin_amdgcn_readlane(__float_as_int(v), 48));
    return fmaxf(fmaxf(a, b), fmaxf(c, d));
}
typedef short s16x2 __attribute__((ext_vector_type(2)));
__device__ __forceinline__ h16x2 relu_pk(h16x2 x) { const s16x2 z = {0, 0}; return __builtin_bit_cast(h16x2, __builtin_elementwise_max(__builtin_bit_cast(s16x2, x), z)); }
__device__ __forceinline__ float relu_asm(float x) { const int i = __builtin_bit_cast(int, x); return __builtin_bit_cast(float, i > 0 ? i : 0); }
constexpr int IDX_CHUNK = 512;
constexpr int IDX_NG = IDX_CHUNK / 64;
constexpr int IDX_CHB = IDX_CHUNK * 128;
__device__ __forceinline__ void phase_index(const Params& p, LAS unsigned char* lds, int bid, int nb) {
    const int tid = threadIdx.x, lane = tid & 63, wave = __builtin_amdgcn_readfirstlane(tid >> 6), k16 = lane & 15, g = lane >> 4;
    unsigned char* ws = p.ws;
    const h16* iq = (const h16*)(ws + WS_IQ); const h16* kidx = (const h16*)(ws + WS_KIDX); const float* widx = (const float*)(ws + WS_WIDX);
    unsigned short* sel = (unsigned short*)(ws + WS_SEL);
    const int ksw = (k16 >> 1) & 7;
    const int sp0 = tid & 7;
    unsigned soff[IDX_NG];
#pragma unroll
    for (int q = 0; q < IDX_NG; ++q) { const int sk = (tid >> 3) + 64 * q; soff[q] = (unsigned)(sk * 128 + ((sp0 ^ ((sk >> 1) & 7)) << 4)); }
    const int nitems = (nb == 256) ? 8 : (2048 + nb - 1) / nb;
    for (int ii = 0; ii < nitems; ++ii) {
        int b, i;
        if (nb == 256) { b = (bid & 7) >> 1; const int idx = ((bid >> 3) << 1) | (bid & 1); const int pr = ii >> 1; i = (ii & 1) ? (128 * pr + idx) : (128 * pr + 127 - idx); }
        else { const int item = bid + ii * nb; if (item >= 2048) break; b = item >> 9; i = item & 511; }
        if (i < 32) continue;
        const int t0 = i * 8;
        const int nchunk = (t0 + 7) / IDX_CHUNK + 1;
        const int tq = t0 + wave;
        const size_t tg = (size_t)b * SEQ + tq;
        const h16* kb = kidx + (size_t)b * SEQ * 64;
        h16x8 Af[2];
        {
            const h16* ap = iq + tg * 1024 + k16 * 64 + g * 8;
            Af[0] = *(const h16x8*)ap; Af[1] = *(const h16x8*)(ap + 32);
        }
        h16x8 A2[2];
        {
            const f32x4 wv = *(const f32x4*)(widx + tg * 16 + 4 * g);
            h16x4 whi, wlo;
#pragma unroll
            for (int r = 0; r < 4; ++r) { whi[r] = (h16)wv[r]; wlo[r] = (h16)(wv[r] - (float)whi[r]); }
#pragma unroll
            for (int pp = 0; pp < 2; ++pp) {
#pragma unroll
                for (int r = 0; r < 4; ++r) {
                    A2[pp][r] = (k16 == 8 * pp) ? whi[r] : ((k16 == 8 * pp + 1) ? wlo[r] : (h16)0.f);
                    A2[pp][4 + r] = (k16 == 8 * pp + 4) ? whi[r] : ((k16 == 8 * pp + 5) ? wlo[r] : (h16)0.f);
                }
            }
        }
        float sc[64];
#pragma unroll
        for (int j = 0; j < 64; ++j) sc[j] = -INFINITY;
        {
            u32x4 a[IDX_NG];
#pragma unroll
            for (int q = 0; q < IDX_NG; ++q) a[q] = *(const u32x4*)(kb + (size_t)((tid >> 3) + 64 * q) * 64 + sp0 * 8);
#pragma unroll
            for (int q = 0; q < IDX_NG; ++q) *(LAS u32x4*)(lds + soff[q]) = a[q];
        }
        __builtin_amdgcn_s_waitcnt(0x0F70);
        __syncthreads();
#pragma unroll 1
        for (int c = 0; c < nchunk; ++c) {
            {
                const int cn1 = (c + 1 < nchunk) ? c + 1 : c;
                u32x4 st[IDX_NG];
#pragma unroll
                for (int q = 0; q < IDX_NG; ++q) st[q] = *(const u32x4*)(kb + (size_t)(IDX_CHUNK * cn1 + (tid >> 3) + 64 * q) * 64 + sp0 * 8);
                const LAS unsigned char* buf = lds + (c & 1) * IDX_CHB;
                float vy[IDX_CHUNK / 64];
                h16x8 Bc[8];
                {
                    const LAS unsigned char* rp = buf + k16 * 128;
#pragma unroll
                    for (int x = 0; x < 4; ++x)
#pragma unroll
                        for (int ks = 0; ks < 2; ++ks) Bc[2 * x + ks] = *(const LAS h16x8*)(rp + x * 2048 + (((4 * ks + g) ^ ksw) << 4));
                }
#pragma unroll
                for (int yy = 0; yy < IDX_CHUNK / 64; ++yy) {
                    h16x8 Bn[8];
                    if (yy + 1 < IDX_CHUNK / 64) {
                        const LAS unsigned char* rp = buf + ((yy + 1) * 64 + k16) * 128;
#pragma unroll
                        for (int x = 0; x < 4; ++x)
#pragma unroll
                            for (int ks = 0; ks < 2; ++ks) Bn[2 * x + ks] = *(const LAS h16x8*)(rp + x * 2048 + (((4 * ks + g) ^ ksw) << 4));
                    }
                    f32x4 acc[4];
#pragma unroll
                    for (int x = 0; x < 4; ++x) acc[x] = __builtin_amdgcn_mfma_f32_16x16x32_f16(Af[0], Bc[2 * x], (f32x4){0.f, 0.f, 0.f, 0.f}, 0, 0, 0);
#pragma unroll
                    for (int x = 0; x < 4; ++x) acc[x] = __builtin_amdgcn_mfma_f32_16x16x32_f16(Af[1], Bc[2 * x + 1], acc[x], 0, 0, 0);
                    f32x4 D2 = {0.f, 0.f, 0.f, 0.f};
#pragma unroll
                    for (int pp = 0; pp < 2; ++pp) {
                        h16x2 q[4];
#pragma unroll
                        for (int e = 0; e < 2; ++e) {
                            const f32x2 r01 = {acc[2 * pp + e][0], acc[2 * pp + e][1]}, r23 = {acc[2 * pp + e][2], acc[2 * pp + e][3]};
                            q[2 * e] = relu_pk(__builtin_convertvector(r01, h16x2)); q[2 * e + 1] = relu_pk(__builtin_convertvector(r23, h16x2));
                        }
                        h16x8 B2; B2[0] = q[0][0]; B2[1] = q[0][1]; B2[2] = q[1][0]; B2[3] = q[1][1]; B2[4] = q[2][0]; B2[5] = q[2][1]; B2[6] = q[3][0]; B2[7] = q[3][1];
                        D2 = __builtin_amdgcn_mfma_f32_16x16x32_f16(A2[pp], B2, D2, 0, 0, 0);
                    }
                    const int k = (c * (IDX_CHUNK / 64) + yy) * 64 + lane;
                    vy[yy] = (k <= tq) ? D2[0] + D2[1] : -INFINITY;
                    if (yy + 1 < IDX_CHUNK / 64) {
#pragma unroll
                        for (int q = 0; q < 8; ++q) Bc[q] = Bn[q];
                    }
                }
                switch (c) {
#define IDX_CASE(C) case C: _Pragma("unroll") for (int j = 0; j < IDX_NG; ++j) sc[IDX_NG * C + j] = vy[j]; break;
                    IDX_CASE(0) IDX_CASE(1) IDX_CASE(2) IDX_CASE(3) IDX_CASE(4) IDX_CASE(5) IDX_CASE(6) IDX_CASE(7)
#undef IDX_CASE
                    default: break;
                }
                {
                    LAS unsigned char* nbuf = lds + ((c + 1) & 1) * IDX_CHB;
#pragma unroll
                    for (int q = 0; q < IDX_NG; ++q) *(LAS u32x4*)(nbuf + soff[q]) = st[q];
                    __syncthreads();
                }
            }
        }
        const int nq = (tq >> 10) + 1;
        float vmin = INFINITY, vmax = -INFINITY;
#pragma unroll
        for (int q = 0; q < 4; ++q) if (q < nq) {
#pragma unroll
            for (int j = 16 * q; j < 16 * q + 16; ++j) { const float v = sc[j]; vmax = fmaxf(vmax, v); vmin = fminf(vmin, (v == -INFINITY) ? INFINITY : v); }
        }
        float lo = wave_min_dpp(vmin), hi = next_up(wave_max_dpp(vmax));
        int clo = tq + 1, chi = 0;
        float Tsel = lo; bool exact = false;
        for (int it = 0; it < 200; ++it) {
            float mid = 0.5f * lo + 0.5f * hi;
            if (!(it & 1)) { const float frac = ((float)(clo - TOPK) - 0.5f) / (float)(clo - chi); const float sm = lo + (hi - lo) * frac; if (sm > lo && sm < hi) mid = sm; }
            if (!(mid > lo && mid < hi)) { Tsel = lo; break; }
            int cn = 0;
#pragma unroll
            for (int q = 0; q < 4; ++q) if (q < nq) {
#pragma unroll
                for (int j = 16 * q; j < 16 * q + 16; ++j) cn += (sc[j] >= mid) ? 1 : 0;
            }
            cn = wave_sum_dpp(cn);
            if (cn == TOPK) { Tsel = mid; exact = true; break; }
            if (cn > TOPK) { lo = mid; clo = cn; } else { hi = mid; chi = cn; }
            Tsel = lo;
        }
        unsigned short* so = sel + tg * TOPK;
        if (exact) {
            int outb = 0;
#pragma unroll
            for (int q = 0; q < 4; ++q) if (q < nq) {
#pragma unroll
                for (int j = 16 * q; j < 16 * q + 16; ++j) {
                    const bool take = sc[j] >= Tsel;
                    const unsigned long long bt = __ballot(take);
                    const int tr = __builtin_amdgcn_mbcnt_hi((unsigned)(bt >> 32), __builtin_amdgcn_mbcnt_lo((unsigned)bt, 0u));
                    if (take) so[outb + tr] = (unsigned short)(j * 64 + lane);
                    outb += __popcll(bt);
                }
            }
        } else {
            int ngt = 0;
#pragma unroll
            for (int j = 0; j < 64; ++j) ngt += (sc[j] > Tsel) ? 1 : 0;
            ngt = wave_sum_dpp(ngt);
            const int quota = TOPK - ngt;
            int outb = 0, eqb = 0;
#pragma unroll
            for (int j = 0; j < 64; ++j) {
                const float v = sc[j];
                const bool gt = v > Tsel, eq = v == Tsel;
                const unsigned long long beq = __ballot(eq);
                const int eqr = __builtin_amdgcn_mbcnt_hi((unsigned)(beq >> 32), __builtin_amdgcn_mbcnt_lo((unsigned)beq, 0u));
                const bool take = gt || (eq && (eqb + eqr) < quota);
                const unsigned long long bt = __ballot(take);
                const int tr = __builtin_amdgcn_mbcnt_hi((unsigned)(bt >> 32), __builtin_amdgcn_mbcnt_lo((unsigned)bt, 0u));
                if (take) so[outb + tr] = (unsigned short)(j * 64 + lane);
                outb += __popcll(bt); eqb += __popcll(beq);
            }
        }
    }
    __syncthreads();
}

typedef short s16x4v __attribute__((__vector_size__(4 * sizeof(short))));
__device__ __forceinline__ h16x4 lds_tr_read(const LAS unsigned char* p) {
    return __builtin_bit_cast(h16x4, __builtin_amdgcn_ds_read_tr16_b64_v4i16((LAS s16x4v*)p));
}
__device__ __forceinline__ void phase_attn(const Params& p, LAS unsigned char* lds, int bid, int nb) {
    const int tid = threadIdx.x, lane = tid & 63, wave = __builtin_amdgcn_readfirstlane(tid >> 6), g = lane >> 4, hd = lane & 15;
    unsigned char* ws = p.ws;
    const h16* qabs = (const h16*)(ws + WS_QABS); const h16* ckv = (const h16*)(ws + WS_CKV);
    const unsigned short* sel = (const unsigned short*)(ws + WS_SEL);
    h16* olat = (h16*)(ws + WS_OLAT);
    LAS unsigned char* kv = lds + wave * 16384;
    LAS int* sidx = (LAS int*)(lds + 131072 + wave * 1024);
    LAS float* biasT = (LAS float*)(lds + 131072 + 8192);
    LAS unsigned char* bktT = lds + 131072 + 8192 + 1024;
    __syncthreads();
    if (tid < 256) biasT[tid] = p.rel_bias[tid];
    if (tid < 128) bktT[tid] = (unsigned char)t5_bucket(tid);
    __syncthreads();
    int tstart, tstride, tcount;
    if (nb == 256) { const int b = (bid & 7) >> 1, wq = ((((bid >> 3) << 1) | (bid & 1)) << 3) + wave; tstart = b * SEQ + wq; tstride = 512; tcount = 8; }
    else { tstart = bid * NWAVES + wave; tstride = nb * NWAVES; tcount = (T - tstart + tstride - 1) / tstride; }
    const int rowA = hd;
    const int fswA = ((rowA & 3) << 1) | (((rowA >> 2) & 1) << 3);
    const int q4 = hd >> 2, p4 = hd & 3;
    const int rowT = 4 * g + q4;
    const int fswT = ((rowT & 3) << 1) | (((rowT >> 2) & 1) << 3);
    const LAS unsigned char* trbase = kv + rowT * 512 + 8 * (p4 & 1);
    for (int qi = 0; qi < tcount; ++qi) {
        const int tg = tstart + qi * tstride;
        const int b = tg >> 12, tl = tg & (SEQ - 1);
        const int cnt = tl + 1 < TOPK ? tl + 1 : TOPK, nch = (cnt + 31) >> 5;
        {
            int i0, i1, i2, i3;
            if (tl + 1 > TOPK) { const u32x2 s4 = *(const u32x2*)(sel + (size_t)tg * TOPK + lane * 4); i0 = s4.x & 0xffff; i1 = s4.x >> 16; i2 = s4.y & 0xffff; i3 = s4.y >> 16; }
            else { const int j = lane * 4; i0 = j < cnt ? j : 0; i1 = j + 1 < cnt ? j + 1 : 0; i2 = j + 2 < cnt ? j + 2 : 0; i3 = j + 3 < cnt ? j + 3 : 0; }
            *(LAS i32x4*)(sidx + lane * 4) = (i32x4){i0, i1, i2, i3};
        }
        h16x8 Qf[8];
#pragma unroll
        for (int ks = 0; ks < 8; ++ks) {
            h16x8 z;
#pragma unroll
            for (int e = 0; e < 8; ++e) z[e] = (h16)0.f;
            Qf[ks] = (hd < 8) ? *(const h16x8*)(qabs + (size_t)tg * 2048 + hd * 256 + ks * 32 + g * 8) : z;
        }
        f32x4 O[16];
#pragma unroll
        for (int ct = 0; ct < 16; ++ct) O[ct] = (f32x4){0.f, 0.f, 0.f, 0.f};
        float m = -INFINITY, l = 0.f;
        const unsigned char* ckvb = (const unsigned char*)(ckv + (size_t)b * SEQ * 256);
        LDS_WAIT();
        for (int c = 0; c < nch; ++c) {
            asm volatile("" ::: "memory");
#pragma unroll
            for (int i = 0; i < 16; ++i) {
                const int row = 2 * i + (lane >> 5);
                const int idx = sidx[32 * c + row];
                const int fsw = ((row & 3) << 1) | (((row >> 2) & 1) << 3);
                const unsigned char* src = ckvb + (size_t)idx * 512 + ((((lane & 31) ^ fsw)) << 4);
                __builtin_amdgcn_global_load_lds((const unsigned*)src, (LAS unsigned*)(kv + i * 1024), 16, 0, 0);
            }
            const i32x4 ia = *(const LAS i32x4*)(sidx + 32 * c + 4 * g), ib = *(const LAS i32x4*)(sidx + 32 * c + 16 + 4 * g);
            const int h7 = hd & 7;
            const int kk8[8] = {ia.x, ia.y, ia.z, ia.w, ib.x, ib.y, ib.z, ib.w};
            float bias8[8];
#pragma unroll
            for (int r = 0; r < 8; ++r) {
                const int slot = 32 * c + (r < 4 ? 4 * g + r : 16 + 4 * g + (r - 4));
                int dist = tl - kk8[r]; dist = dist < 0 ? 0 : (dist > 127 ? 127 : dist);
                bias8[r] = (slot < cnt) ? biasT[(int)bktT[dist] * 8 + h7] : -INFINITY;
            }
            asm volatile("s_waitcnt vmcnt(0)" ::: "memory");
            __builtin_amdgcn_sched_barrier(0);
            f32x4 S0 = {0.f, 0.f, 0.f, 0.f}, S1 = {0.f, 0.f, 0.f, 0.f};
#pragma unroll
            for (int ks = 0; ks < 8; ++ks) {
                const h16x8 A0 = *(const LAS h16x8*)(kv + rowA * 512 + (((4 * ks + g) ^ fswA) << 4));
                const h16x8 A1 = *(const LAS h16x8*)(kv + (rowA + 16) * 512 + (((4 * ks + g) ^ fswA) << 4));
                S0 = __builtin_amdgcn_mfma_f32_16x16x32_f16(A0, Qf[ks], S0, 0, 0, 0);
                S1 = __builtin_amdgcn_mfma_f32_16x16x32_f16(A1, Qf[ks], S1, 0, 0, 0);
            }
            float sv[8]; float cmax = -INFINITY;
#pragma unroll
            for (int r = 0; r < 8; ++r) { sv[r] = ((r < 4) ? S0[r] : S1[r - 4]) + bias8[r]; cmax = fmaxf(cmax, sv[r]); }
            if (__any(cmax > m + 8.f)) {
                cmax = fmaxf(cmax, __shfl_xor(cmax, 16)); cmax = fmaxf(cmax, __shfl_xor(cmax, 32));
                const float mnew = fmaxf(m, cmax);
                const float alpha = __expf(m - mnew);
                l *= alpha; m = mnew;
#pragma unroll
                for (int ct = 0; ct < 16; ++ct) O[ct] *= alpha;
            }
            h16x8 Pf;
#pragma unroll
            for (int r = 0; r < 8; ++r) { const float pv = __expf(sv[r] - m); l += pv; Pf[r] = (h16)pv; }
#pragma unroll
            for (int ct = 0; ct < 16; ++ct) {
                const int choff = ((((2 * (ct & 7)) ^ fswT) + (p4 >> 1)) << 4) + (ct >> 3) * 256;
                const h16x4 a0 = lds_tr_read(trbase + choff);
                const h16x4 a1 = lds_tr_read(trbase + 16 * 512 + choff);
                h16x8 Av; Av[0] = a0[0]; Av[1] = a0[1]; Av[2] = a0[2]; Av[3] = a0[3]; Av[4] = a1[0]; Av[5] = a1[1]; Av[6] = a1[2]; Av[7] = a1[3];
                O[ct] = __builtin_amdgcn_mfma_f32_16x16x32_f16(Av, Pf, O[ct], 0, 0, 0);
            }
            asm volatile("" ::: "memory");
        }
        l += __shfl_xor(l, 16); l += __shfl_xor(l, 32);
        if (hd < 8) {
            const float inv = 1.f / l;
            h16* op = olat + (size_t)tg * 2048 + hd * 256 + 4 * g;
#pragma unroll
            for (int ct = 0; ct < 16; ++ct) *(u32x2*)(op + 16 * ct) = pack_h4(O[ct] * inv);
        }
    }
    __syncthreads();
}

__device__ __forceinline__ void phase_uv(const Params& p, LAS unsigned char* lds, int bid, int nb) {
    const int tid = threadIdx.x, lane = tid & 63, wave = tid >> 6, r31 = lane & 31, hh = lane >> 5;
    unsigned char* ws = p.ws;
    const h16* olat = (const h16*)(ws + WS_OLAT); const h16* wuvT = (const h16*)(ws + WS_WUVT);
    h16* ymix = (h16*)(ws + WS_R2);
    for (int u = bid; u < 256; u += nb) {
        const int h = u & 7, rb = u >> 3;
        __syncthreads();
        for (int e = tid; e < 128 * 32; e += NTHREADS) { const int v = e >> 5, ch = e & 31; *(LAS u32x4*)(lds + v * 528 + ch * 16) = *(const u32x4*)(wuvT + ((size_t)h * 128 + v) * 256 + ch * 8); }
        __syncthreads();
        for (int tile = wave; tile < 16; tile += NWAVES) {
            const int row0 = rb * 512 + tile * 32;
            f32x16 acc[4];
#pragma unroll
            for (int vt = 0; vt < 4; ++vt)
#pragma unroll
                for (int r = 0; r < 16; ++r) acc[vt][r] = 0.f;
            const h16* bp = olat + (size_t)(row0 + r31) * 2048 + h * 256 + hh * 8;
#pragma unroll 4
            for (int ks = 0; ks < 16; ++ks) {
                const h16x8 Bf = *(const h16x8*)(bp + ks * 16);
#pragma unroll
                for (int vt = 0; vt < 4; ++vt) {
                    const h16x8 Af = *(const LAS h16x8*)(lds + (vt * 32 + r31) * 528 + ks * 32 + hh * 16);
                    acc[vt] = __builtin_amdgcn_mfma_f32_32x32x16_f16(Af, Bf, acc[vt], 0, 0, 0);
                }
            }
            float ss = 0.f;
#pragma unroll
            for (int vt = 0; vt < 4; ++vt)
#pragma unroll
                for (int r = 0; r < 16; ++r) ss += acc[vt][r] * acc[vt][r];
            ss += __shfl_xor(ss, 32);
            const float rstd = rsqrtf(ss * (1.f / 128.f) + EPS);
            h16* yp = ymix + (size_t)(row0 + r31) * 2048 + h * 128 + 4 * hh;
            const float* gp = p.attn_out_norm_g + h * 128 + 4 * hh;
#pragma unroll
            for (int vt = 0; vt < 4; ++vt)
#pragma unroll
                for (int rq = 0; rq < 4; ++rq) {
                    const f32x4 gg = *(const f32x4*)(gp + vt * 32 + 8 * rq);
                    const f32x4 y = {acc[vt][4 * rq + 0] * rstd * gg[0], acc[vt][4 * rq + 1] * rstd * gg[1], acc[vt][4 * rq + 2] * rstd * gg[2], acc[vt][4 * rq + 3] * rstd * gg[3]};
                    *(u32x2*)(yp + vt * 32 + 8 * rq) = pack_h4(y);
                }
        }
    }
    __syncthreads();
}

#define XB_TMO      128
#define XB_XCNT(j)  (256  + 64 * (j))
#define XB_XSUB(j)  (1280 + 64 * (j))
#define XB_XGEN(j)  (2304 + 64 * (j))
#define XB_TOP      3328
#define XB_TOPGEN   3392
#define XCD_BAR_WORDS 3456
#define XB_SPIN_CAP (1u << 22)
__device__ __forceinline__ unsigned xb_ld(unsigned* p)              { return __hip_atomic_load(p, __ATOMIC_RELAXED, __HIP_MEMORY_SCOPE_AGENT); }
__device__ __forceinline__ unsigned xb_add(unsigned* p, unsigned v) { return __hip_atomic_fetch_add(p, v, __ATOMIC_RELAXED, __HIP_MEMORY_SCOPE_AGENT); }
__device__ __forceinline__ unsigned xb_xcc_id() { return (unsigned)__builtin_amdgcn_s_getreg((3 << 11) | 20) & 0xFu; }
#define XB_SPIN(cond, bar) do { unsigned _sp = 0; while (cond) { __builtin_amdgcn_s_sleep(1); \
    if ((++_sp & 255u) == 0u) { if (xb_ld(&(bar)[XB_TMO])) break; if (_sp > XB_SPIN_CAP) { atomicAdd(&(bar)[XB_TMO], 1u); break; } } } } while (0)
struct XcdBarrier { unsigned* bar; unsigned x; volatile LAS unsigned* st; };
__device__ __forceinline__ XcdBarrier xcd_barrier_post(unsigned* bar, volatile LAS unsigned* st) {
    XcdBarrier b; b.bar = bar; b.x = xb_xcc_id(); b.st = st;
    if (threadIdx.x == 0) (void)xb_add(&bar[XB_XCNT(b.x)], 1u);
    return b;
}
__device__ __forceinline__ void xcd_barrier_complete(unsigned* bar, unsigned x, unsigned& nloc, unsigned& nx) {
    const unsigned G = gridDim.x * gridDim.y * gridDim.z;
    unsigned sum, cnt, mine, sp = 0u;
    for (;;) {
        sum = 0u; cnt = 0u; mine = 0u;
#pragma unroll
        for (unsigned j = 0; j < 16; ++j) { const unsigned c = xb_ld(&bar[XB_XCNT(j)]); sum += c; cnt += (c > 0u) ? 1u : 0u; mine = (j == x) ? c : mine; }
        if (sum == G) break;
        __builtin_amdgcn_s_sleep(1);
        if ((++sp & 255u) == 0u) { if (xb_ld(&bar[XB_TMO])) break; if (sp > XB_SPIN_CAP) { atomicAdd(&bar[XB_TMO], 1u); break; } }
    }
    nloc = mine > 0u ? mine : 1u; nx = cnt > 0u ? cnt : 1u;
}
__device__ __forceinline__ void xcd_barrier(const XcdBarrier& b) {
    asm volatile("s_waitcnt vmcnt(0)" ::: "memory");
    __syncthreads();
    if (threadIdx.x == 0) {
        unsigned* bar = b.bar;
        __builtin_amdgcn_s_waitcnt(0);
        unsigned nloc = b.st[0], nx = b.st[1];
        if (nloc == 0u) { xcd_barrier_complete(bar, b.x, nloc, nx); b.st[0] = nloc; b.st[1] = nx; }
        const unsigned old = xb_add(&bar[XB_XSUB(b.x)], 1u);
        const unsigned gen = old / nloc;
        if (old + 1u == (gen + 1u) * nloc) {
            __builtin_amdgcn_fence(__ATOMIC_RELEASE, "agent");
            asm volatile("s_waitcnt vmcnt(0)" ::: "memory");
            const unsigned og = xb_add(&bar[XB_TOP], 1u);
            const unsigned tg = og / nx;
            if (og + 1u == (tg + 1u) * nx) xb_add(&bar[XB_TOPGEN], 1u);
            else XB_SPIN(xb_ld(&bar[XB_TOPGEN]) == tg, bar);
            __builtin_amdgcn_fence(__ATOMIC_ACQUIRE, "agent");
            xb_add(&bar[XB_XGEN(b.x)], 1u);
            asm volatile("s_waitcnt vmcnt(0)" ::: "memory");
        } else {
            XB_SPIN(xb_ld(&bar[XB_XGEN(b.x)]) == gen, bar);
            __builtin_amdgcn_fence(__ATOMIC_ACQUIRE, "agent");
            asm volatile("s_waitcnt vmcnt(0)" ::: "memory");
        }
    }
    __syncthreads();
}

constexpr int LDS_BYTES = 160 * 1024;
constexpr int WGM_G1 = 2, WGM_G2 = 2, WGM_G6 = 2, WGM_G7 = 8, WGM_G8 = 2;
constexpr int NPHASES = 13;
__global__ void __launch_bounds__(NTHREADS, 2) fwd_kernel(Params p) {
    extern __shared__ __attribute__((aligned(16))) unsigned char lds_raw[];
    LAS unsigned char* lds = (LAS unsigned char*)lds_raw;
    const int bid = blockIdx.x, nb = gridDim.x;
    unsigned char* ws = p.ws;
    float* mod = (float*)(ws + WS_MOD);
    volatile LAS unsigned* bst = (volatile LAS unsigned*)(lds + LDS_BYTES - 64);
    if (threadIdx.x < 2) bst[threadIdx.x] = 0u;
    __syncthreads();
    XcdBarrier xbar = xcd_barrier_post((unsigned*)(ws + WS_CTL), bst);
#define IN(k) (p.ph_lo <= (k) && (k) < p.ph_hi)
#define SEAM(k) do { if (IN(k) && IN((k) + 1)) xcd_barrier(xbar); } while (0)
    if (IN(0)) { phase_prep(p, lds, bid, nb); } SEAM(0);
    if (IN(1)) { phase_normmod(p.x, p.norm1_g, mod, 0, 2048, (h16*)(ws + WS_R2), bid, nb); } SEAM(1);
    if (IN(2)) { EpiProj E{(h16*)(ws + WS_CQ), (float*)(ws + WS_PROJA), (h16*)(ws + WS_CKV), (h16*)(ws + WS_KIDX), (float*)(ws + WS_WIDX), (h16*)(ws + WS_PROJB), p.kv_norm_g, p.idx_k_norm_g, p.idx_k_norm_b};
                 run_gemm(lds, (const h16*)(ws + WS_R2), (const h16*)(ws + WS_BT_IN), T, N_IN, 2048, bid, nb, E, WGM_G1); } SEAM(2);
    if (IN(3)) { phase_rows3(p, bid, nb); } SEAM(3);
    if (IN(4)) { EpiQ E{(h16*)(ws + WS_QABS), (h16*)(ws + WS_IQ), p.q_abs_norm_g, (const float*)(ws + WS_PROJA)}; run_gemm(lds, (const h16*)(ws + WS_CQ), (const h16*)(ws + WS_BT_Q), T, N_Q, 512, bid, nb, E, WGM_G2); } SEAM(4);
    if (IN(5)) { phase_index(p, lds, bid, nb); } SEAM(5);
    if (IN(6)) { phase_attn(p, lds, bid, nb); } SEAM(6);
    if (IN(7)) { phase_uv(p, lds, bid, nb); } SEAM(7);
    if (IN(8)) { EpiF16 E{(h16*)(ws + WS_Y6), nullptr}; run_gemm(lds, (const h16*)(ws + WS_R2), (const h16*)(ws + WS_BT_OUT), T, 2048, 2048, bid, nb, E, WGM_G6); } SEAM(8);
    if (IN(9)) { phase_normmod2(p, bid, nb); } SEAM(9);
    if (IN(10)) {
        LAS h16* bl = (LAS h16*)(lds + 131072 + 8192);
        __syncthreads();
        for (int i = threadIdx.x; i < D_FF / 4; i += NTHREADS) { const f32x4 b4 = *(const f32x4*)(p.b_mlp1 + 4 * i); *(LAS u32x2*)(bl + 4 * i) = pack_h4(b4); }
        __syncthreads();
        EpiMlp1 E{bl, (h16*)(ws + WS_R3)}; run_gemm(lds, (const h16*)(ws + WS_R2), (const h16*)(ws + WS_BT_1), T, D_FF, 2048, bid, nb, E, WGM_G7); } SEAM(10);
    if (IN(11)) { EpiF16 E{(h16*)(ws + WS_R2), p.b_mlp2}; run_gemm(lds, (const h16*)(ws + WS_R3), (const h16*)(ws + WS_BT_2), T, 2048, D_FF, bid, nb, E, WGM_G8); } SEAM(11);
    if (IN(12)) { phase_final(p, bid, nb); }
#undef IN
#undef SEAM
}

#ifndef N_LAUNCH_MODE
#define N_LAUNCH_MODE 1
#endif
extern "C" void kernel_launch(void* const* d_in, const int* in_sizes, int n_in, void* d_out, int out_size, void* d_ws, size_t ws_size, hipStream_t stream) {
    static int grid = 0;
    if (grid == 0) {
        if (ws_size < WS_END) { fprintf(stderr, "kernel_launch: workspace too small (%zu < %zu)\n", ws_size, (size_t)WS_END); grid = -1; return; }
        int dev = 0, cus = 0, per_cu = 0;
        hipGetDevice(&dev);
        hipDeviceGetAttribute(&cus, hipDeviceAttributeMultiprocessorCount, dev);
        if (hipFuncSetAttribute((const void*)fwd_kernel, hipFuncAttributeMaxDynamicSharedMemorySize, LDS_BYTES) != hipSuccess) { fprintf(stderr, "kernel_launch: hipFuncSetAttribute failed\n"); grid = -1; return; }
        hipOccupancyMaxActiveBlocksPerMultiprocessor(&per_cu, (const void*)fwd_kernel, NTHREADS, LDS_BYTES);
        if (per_cu < 1) { fprintf(stderr, "kernel_launch: occupancy query says %d\n", per_cu); per_cu = 1; }
        grid = cus;
        if (grid > 256) grid = 256;
    }
    if (grid < 0) return;
    Params p{};
    const float** f = (const float**)&p;
    for (int i = 0; i < 26; ++i) f[i] = (const float*)d_in[i];
    p.out = (float*)d_out; p.ws = (unsigned char*)d_ws;
#if N_LAUNCH_MODE == 1
    if (hipMemsetAsync((char*)d_ws + WS_CTL, 0, XCD_BAR_WORDS * 4, stream) != hipSuccess) { fprintf(stderr, "kernel_launch: memset failed\n"); return; }
    p.ph_lo = 0; p.ph_hi = NPHASES;
    void* args[] = {&p};
    hipError_t e = hipLaunchCooperativeKernel((const void*)fwd_kernel, dim3(grid), dim3(NTHREADS), args, LDS_BYTES, stream);
    if (e != hipSuccess) fprintf(stderr, "cooperative launch failed: %s (grid %d)\n", hipGetErrorString(e), grid);
#else
    for (int ph = 0; ph < 13; ++ph) {
        p.ph_lo = ph; p.ph_hi = ph + 1;
        hipLaunchKernelGGL(fwd_kernel, dim3(grid), dim3(NTHREADS), LDS_BYTES, stream, p);
    }
#endif
}
```

```cpp
#include <hip/hip_runtime.h>
#include <cstdio>
#include <cstdint>

#define LAS __attribute__((address_space(3)))
typedef _Float16 h16;
typedef _Float16 h16x8 __attribute__((ext_vector_type(8)));
typedef _Float16 h16x4 __attribute__((ext_vector_type(4)));
typedef _Float16 h16x2 __attribute__((ext_vector_type(2)));
typedef float f32x4 __attribute__((ext_vector_type(4)));
typedef float f32x2 __attribute__((ext_vector_type(2)));
typedef unsigned u32x4 __attribute__((ext_vector_type(4)));
typedef unsigned u32x2 __attribute__((ext_vector_type(2)));
typedef int i32x4 __attribute__((ext_vector_type(4)));

constexpr int D_MODEL = 2048, BATCH = 4, SEQ = 4096, T = BATCH * SEQ;
constexpr int ATTN_HEADS = 8, HEAD_DIM = 128, Q_LORA = 512, KV_LORA = 256, IDX_HEADS = 16, IDX_DIM = 64, TOPK = 256;
constexpr int CONV_WIDTH = 1024, D_FF = 8192, IN_COLS = 3920;
constexpr float EPS = 1e-6f;
constexpr int NTHREADS = 512, NWAVES = 8;
constexpr int N_IN = 4096;
constexpr int N_Q = 3072;

constexpr size_t MiB = (size_t)1 << 20;
constexpr size_t WS_CTL = 0;
constexpr size_t WS_MOD = 64 * 1024;
constexpr size_t WS_BT_IN = 1 * MiB;
constexpr size_t WS_BT_Q = WS_BT_IN + 16 * MiB;
constexpr size_t WS_BT_OUT = WS_BT_Q + 3 * MiB;
constexpr size_t WS_BT_1 = WS_BT_OUT + 8 * MiB;
constexpr size_t WS_BT_2 = WS_BT_1 + 32 * MiB;
constexpr size_t WS_WUVT = WS_BT_2 + 32 * MiB;
constexpr size_t WS_R2 = 93 * MiB;
constexpr size_t WS_R3 = WS_R2 + 64 * MiB;
constexpr size_t WS_PROJA = WS_R3;
constexpr size_t WS_PROJB = WS_R3 + 64 * MiB;
constexpr size_t WS_OLAT = WS_R3 + 64 * MiB;
constexpr size_t WS_QABS = WS_R3 + 160 * MiB;
constexpr size_t WS_IQ = WS_R3 + 224 * MiB;
constexpr size_t WS_R4 = WS_R3 + 256 * MiB;
constexpr size_t WS_CQ = WS_R4;
constexpr size_t WS_CKV = WS_CQ + 16 * MiB;
constexpr size_t WS_KIDX = WS_CKV + 8 * MiB;
constexpr size_t WS_WIDX = WS_KIDX + 2 * MiB;
constexpr size_t WS_SEL = WS_WIDX + 1 * MiB;
constexpr size_t WS_Y6 = WS_SEL + 8 * MiB;
constexpr size_t WS_END = WS_Y6 + 64 * MiB;

struct Params {
    const float *x, *c, *w_ada, *b_ada, *norm1_g, *norm2_g, *w_in, *cq_norm_g, *w_uq, *w_uk, *kv_norm_g, *q_abs_norm_g, *w_uv, *w_iq,
        *idx_k_norm_g, *idx_k_norm_b, *rel_bias, *conv_w, *conv_b, *attn_out_norm_g, *conv_out_norm_g, *w_out, *w_mlp1, *b_mlp1, *w_mlp2, *b_mlp2;
    float* out;
    unsigned char* ws;
    int ph_lo, ph_hi;
};

__device__ __forceinline__ float wave_sum(float v) {
#pragma unroll
    for (int o = 1; o < 64; o <<= 1) v += __shfl_xor(v, o);
    return v;
}
__device__ __forceinline__ float wave_max(float v) {
#pragma unroll
    for (int o = 1; o < 64; o <<= 1) v = fmaxf(v, __shfl_xor(v, o));
    return v;
}
#define LDS_WAIT() asm volatile("s_waitcnt lgkmcnt(0)" ::: "memory")

namespace pg8 {
constexpr int BM = 256, BK = 64, HALF = 128, HTB = HALF * BK * 2, STAGE_BYTES = 8 * HTB, NXCD = 8;
__host__ __device__ __forceinline__ int lds_byte(int r, int c) { const int st = (r >> 4) * 2 + (c >> 5), rr = r & 15, cc = c & 31, ob = rr * 64 + cc * 2; return st * 1024 + (ob ^ (((ob >> 9) & 1) << 5)); }
__host__ __device__ __forceinline__ int perm32(int rho) { const int n = rho >> 4, i = rho & 15; return 8 * (i >> 2) + 4 * n + (i & 3); }
__host__ __device__ __forceinline__ void stage_rc(int b, int& R, int& C) { const int st = b / 1024, sb = b % 1024, swz = sb ^ (((sb >> 9) & 1) << 5); R = (st >> 1) * 16 + swz / 64; C = (st & 1) * 32 + (swz % 64) / 2; }
struct Unit { int pm, pn; };
struct Gemm { const h16* A; const h16* Bt; int M, N, K; };
struct StaticOrder {
    int nM, nN, nwg, G, c, WGM;
    __host__ __device__ void init(int M, int N, int G_, int c_, int wgm) { nM = M / BM; nN = N / BM; nwg = nM * nN; G = G_; c = c_; WGM = wgm; }
    __host__ __device__ bool next(int i, Unit& u) const {
        const long L = (long)i * G + c; if (L >= nwg) return false;
        int wgid = (int)L; { const int q = nwg / NXCD, r = nwg % NXCD, xcd = wgid % NXCD, off = wgid / NXCD; wgid = (xcd < r ? xcd * (q + 1) : r * (q + 1) + (xcd - r) * q) + off; }
        const int nig = WGM * nN, gid = wgid / nig, fm = gid * WGM, gsz = (nM - fm) < WGM ? (nM - fm) : WGM;
        u.pm = fm + ((wgid % nig) % gsz); u.pn = (wgid % nig) / gsz; return true;
    }
};

#ifndef PG8_SP2
#define PG8_SP2 true
#endif
#ifndef PG8_ALIGN
#define PG8_ALIGN true
#endif
template <class Epi, bool ALIGN_EPI = PG8_ALIGN, bool SP2 = PG8_SP2>
__device__ __forceinline__ void gemm_phase(LAS unsigned char* lds, const Gemm g, const StaticOrder& S, const Epi& E) {
    const int tid = threadIdx.x, wid = __builtin_amdgcn_readfirstlane(tid >> 6), lane = tid & 63, wr = wid >> 2, wc = wid & 3, fr = lane & 15, fq = lane >> 4;
    const int K = g.K, nt = K / BK;
    unsigned voffA[2], voffB[2];
#pragma unroll
    for (int i = 0; i < 2; ++i) { int R, C; stage_rc(tid * 16 + i * 8192, R, C); const int Rb = Epi::PERM ? ((R & ~31) + perm32(R & 31)) : R; voffA[i] = (unsigned)(R * K + C) * 2u; voffB[i] = (unsigned)(Rb * K + C) * 2u; }
    const size_t kstep = (size_t)(BK * 2);
    const size_t hstep = (size_t)HALF * K * 2;
    const size_t tstep = 2 * hstep;
    const unsigned ldsw = (unsigned)wid * 1024u;
    const int aoff = lds_byte(wr * 64 + fr, fq * 8), boff = lds_byte(wc * 32 + fr, fq * 8);
#define PG8_SA(b, h) (((b) * 2 + (h)) * HTB)
#define PG8_SB(b, h) ((4 + (b) * 2 + (h)) * HTB)
#define PG8_STAGE(bufoff, gbase, voff) do { _Pragma("unroll") for (int _i = 0; _i < 2; ++_i) \
        __builtin_amdgcn_global_load_lds((const unsigned*)((const char*)(gbase) + (voff)[_i]), (LAS unsigned*)(lds + (bufoff) + ldsw + _i * 8192), 16, 0, 0); } while (0)
#define PG8_LDA(dst, b, h) do { _Pragma("unroll") for (int m = 0; m < 4; ++m) _Pragma("unroll") for (int k = 0; k < 2; ++k) dst[m][k] = *(const LAS h16x8*)(lds + PG8_SA(b, h) + aoff + m * 2048 + k * 1024); } while (0)
#define PG8_LDB(dst, b, h) do { _Pragma("unroll") for (int n = 0; n < 2; ++n) _Pragma("unroll") for (int k = 0; k < 2; ++k) dst[n][k] = *(const LAS h16x8*)(lds + PG8_SB(b, h) + boff + n * 2048 + k * 1024); } while (0)
#define PG8_MMA(ai, bj, At, Bt) do { __builtin_amdgcn_s_setprio(1); _Pragma("unroll") for (int m = 0; m < 4; ++m) _Pragma("unroll") for (int n = 0; n < 2; ++n) _Pragma("unroll") for (int k = 0; k < 2; ++k) \
        acc[ai][bj][m][n] = __builtin_amdgcn_mfma_f32_16x16x32_f16(Bt[n][k], At[m][k], acc[ai][bj][m][n], 0, 0, 0); __builtin_amdgcn_s_setprio(0); } while (0)
#define PG8_WAIT_V(n) asm volatile("s_waitcnt vmcnt(" #n ")" ::: "memory")
#define PG8_WAIT_L(n) asm volatile("s_waitcnt lgkmcnt(" #n ")" ::: "memory")
#define PG8_BAR __builtin_amdgcn_s_barrier()
#define PG8_SCHED __builtin_amdgcn_sched_barrier(0)
    Unit cur, nxt; int ui = 0;
    if (!S.next(0, cur)) return;
    f32x4 acc[2][2][4][2];
#pragma unroll
    for (int a = 0; a < 2; ++a)
#pragma unroll
        for (int b = 0; b < 2; ++b)
#pragma unroll
            for (int m = 0; m < 4; ++m)
#pragma unroll
                for (int n = 0; n < 2; ++n) acc[a][b][m][n] = (f32x4){0.f, 0.f, 0.f, 0.f};
    h16x8 At[4][2], B0[2][2], B1[2][2];
    const char* cA = (const char*)g.A + (size_t)cur.pm * tstep; const char* cB = (const char*)g.Bt + (size_t)cur.pn * tstep;
    if constexpr (SP2) {
        PG8_STAGE(PG8_SB(0, 0), cB, voffB); PG8_STAGE(PG8_SB(0, 1), cB + hstep, voffB); PG8_STAGE(PG8_SA(0, 0), cA, voffA); PG8_STAGE(PG8_SA(0, 1), cA + hstep, voffA);
        if (wr == 1) PG8_BAR;
        PG8_WAIT_V(2); PG8_BAR;
        PG8_STAGE(PG8_SB(1, 0), cB + kstep, voffB); PG8_STAGE(PG8_SA(1, 0), cA + kstep, voffA); PG8_STAGE(PG8_SB(1, 1), cB + hstep + kstep, voffB);
        PG8_WAIT_V(6); PG8_BAR;
    } else {
        PG8_STAGE(PG8_SB(0, 0), cB, voffB); PG8_STAGE(PG8_SA(0, 0), cA, voffA); PG8_STAGE(PG8_SB(0, 1), cB + hstep, voffB); PG8_STAGE(PG8_SA(0, 1), cA + hstep, voffA);
        if (wr == 1) PG8_BAR;
        PG8_WAIT_V(4); PG8_BAR;
        PG8_STAGE(PG8_SB(1, 0), cB + kstep, voffB); PG8_STAGE(PG8_SA(1, 0), cA + kstep, voffA); PG8_STAGE(PG8_SB(1, 1), cB + hstep + kstep, voffB);
        PG8_WAIT_V(6); PG8_BAR;
    }
    for (;;) {
        const bool has_next = S.next(ui + 1, nxt);
        const char* nA = has_next ? (const char*)g.A + (size_t)nxt.pm * tstep : cA; const char* nB = has_next ? (const char*)g.Bt + (size_t)nxt.pn * tstep : cB;
        for (int t = 0; t < nt; t += 2) {
            const bool last = (t == nt - 2);
            const char* a1 = cA + (size_t)(t + 1) * kstep;
            const char* a2 = last ? nA : cA + (size_t)(t + 2) * kstep; const char* b2 = last ? nB : cB + (size_t)(t + 2) * kstep;
            const char* a3 = a2 + kstep; const char* b3 = b2 + kstep;
            if constexpr (SP2) {
            PG8_LDB(B0, 0, 0); PG8_LDB(B1, 0, 1); PG8_SCHED; PG8_LDA(At, 0, 0); PG8_STAGE(PG8_SA(1, 1), a1 + hstep, voffA);
            PG8_WAIT_V(8); PG8_WAIT_L(0); PG8_BAR; PG8_MMA(0, 0, At, B0); PG8_MMA(0, 1, At, B1); PG8_BAR; PG8_SCHED;
            PG8_LDA(At, 0, 1); PG8_STAGE(PG8_SB(0, 0), b2, voffB); PG8_STAGE(PG8_SB(0, 1), b2 + hstep, voffB); PG8_STAGE(PG8_SA(0, 0), a2, voffA);
            PG8_WAIT_V(8); PG8_WAIT_L(0); PG8_BAR; PG8_MMA(1, 0, At, B0); PG8_MMA(1, 1, At, B1); PG8_BAR; PG8_SCHED;
            PG8_LDB(B0, 1, 0); PG8_LDB(B1, 1, 1); PG8_SCHED; PG8_LDA(At, 1, 0); PG8_STAGE(PG8_SA(0, 1), a2 + hstep, voffA);
            PG8_WAIT_V(8); PG8_WAIT_L(0); PG8_BAR; PG8_MMA(0, 0, At, B0); PG8_MMA(0, 1, At, B1); PG8_BAR; PG8_SCHED;
            PG8_LDA(At, 1, 1); PG8_STAGE(PG8_SB(1, 0), b3, voffB); PG8_STAGE(PG8_SB(1, 1), b3 + hstep, voffB); PG8_STAGE(PG8_SA(1, 0), a3, voffA);
            PG8_WAIT_V(8); PG8_WAIT_L(0); PG8_BAR; PG8_MMA(1, 0, At, B0); PG8_MMA(1, 1, At, B1); PG8_BAR; PG8_SCHED;
            } else {
            PG8_LDB(B0, 0, 0); PG8_SCHED; PG8_LDA(At, 0, 0); PG8_STAGE(PG8_SA(1, 1), a1 + hstep, voffA);
            PG8_WAIT_L(8); PG8_BAR; PG8_WAIT_L(0); PG8_MMA(0, 0, At, B0); PG8_BAR; PG8_SCHED;
            PG8_LDB(B1, 0, 1); PG8_STAGE(PG8_SB(0, 0), b2, voffB);
            PG8_BAR; PG8_WAIT_L(0); PG8_MMA(0, 1, At, B1); PG8_BAR;
            PG8_LDA(At, 0, 1); PG8_STAGE(PG8_SA(0, 0), a2, voffA);
            PG8_BAR; PG8_WAIT_L(0); PG8_MMA(1, 0, At, B0); PG8_BAR; PG8_SCHED;
            PG8_STAGE(PG8_SB(0, 1), b2 + hstep, voffB);
            PG8_WAIT_V(6); PG8_BAR; PG8_MMA(1, 1, At, B1); PG8_BAR;
            PG8_LDB(B0, 1, 0); PG8_SCHED; PG8_LDA(At, 1, 0); PG8_STAGE(PG8_SA(0, 1), a2 + hstep, voffA);
            PG8_WAIT_L(8); PG8_BAR; PG8_WAIT_L(0); PG8_MMA(0, 0, At, B0); PG8_BAR; PG8_SCHED;
            PG8_LDB(B1, 1, 1); PG8_STAGE(PG8_SB(1, 0), b3, voffB);
            PG8_BAR; PG8_WAIT_L(0); PG8_MMA(0, 1, At, B1); PG8_BAR;
            PG8_LDA(At, 1, 1); PG8_STAGE(PG8_SA(1, 0), a3, voffA);
            PG8_BAR; PG8_WAIT_L(0); PG8_MMA(1, 0, At, B0); PG8_BAR; PG8_SCHED;
            PG8_STAGE(PG8_SB(1, 1), b3 + hstep, voffB);
            PG8_WAIT_V(6); PG8_BAR; PG8_MMA(1, 1, At, B1); PG8_BAR;
            }
        }
        if constexpr (ALIGN_EPI) { if (wr == 0) PG8_BAR; }
        if constexpr (Epi::CUSTOM) { E.run(acc, cur, wr, wc, fr, fq, lds); }
        else if constexpr (Epi::PERM) {
            const int row0 = cur.pm * BM + wr * 64 + fr, col0 = cur.pn * BM + wc * 32 + 8 * fq;
            E.begin_unit(cur.pn, col0);
#pragma unroll
            for (int ai = 0; ai < 2; ++ai)
#pragma unroll
                for (int m = 0; m < 4; ++m)
#pragma unroll
                    for (int bj = 0; bj < 2; ++bj) E.store8(row0 + ai * HALF + m * 16, col0 + bj * HALF, acc[ai][bj][m][0], acc[ai][bj][m][1]);
        } else {
            const int row0 = cur.pm * BM + wr * 64 + fr, col0 = cur.pn * BM + wc * 32 + 4 * fq;
#pragma unroll
            for (int ai = 0; ai < 2; ++ai)
#pragma unroll
                for (int m = 0; m < 4; ++m)
#pragma unroll
                    for (int bj = 0; bj < 2; ++bj)
#pragma unroll
                        for (int n = 0; n < 2; ++n) E.store4(row0 + ai * HALF + m * 16, col0 + bj * HALF + n * 16, acc[ai][bj][m][n]);
        }
        if (!has_next) break;
#pragma unroll
        for (int a = 0; a < 2; ++a)
#pragma unroll
            for (int b = 0; b < 2; ++b)
#pragma unroll
                for (int m = 0; m < 4; ++m)
#pragma unroll
                    for (int n = 0; n < 2; ++n) acc[a][b][m][n] = (f32x4){0.f, 0.f, 0.f, 0.f};
        cur = nxt; cA = nA; cB = nB; ++ui;
        if constexpr (ALIGN_EPI) { if (wr == 1) PG8_BAR; }
    }
    PG8_WAIT_V(0);
    if constexpr (!ALIGN_EPI) { if (wr == 0) PG8_BAR; }
    PG8_BAR;
#undef PG8_SA
#undef PG8_SB
#undef PG8_STAGE
#undef PG8_LDA
#undef PG8_LDB
#undef PG8_MMA
#undef PG8_WAIT_V
#undef PG8_WAIT_L
#undef PG8_BAR
#undef PG8_SCHED
}

}

template <class Epi>
__device__ __forceinline__ void run_gemm(LAS unsigned char* lds, const h16* A, const h16* Bt, int M, int N, int K, int bid, int nb, const Epi& E, int wgm) {
    pg8::Gemm g{A, Bt, M, N, K};
    pg8::StaticOrder S; S.init(M, N, nb, bid, wgm);
    pg8::gemm_phase(lds, g, S, E);
}

__device__ __forceinline__ u32x2 pack_h4(f32x4 v) {
    h16x2 a = {(h16)v[0], (h16)v[1]}, b = {(h16)v[2], (h16)v[3]};
    u32x2 r; r.x = __builtin_bit_cast(unsigned, a); r.y = __builtin_bit_cast(unsigned, b); return r;
}

__device__ __forceinline__ u32x4 pack_h8(f32x4 a, f32x4 b) { const u32x2 x = pack_h4(a), y = pack_h4(b); return (u32x4){x.x, x.y, y.x, y.y}; }
struct EpiProj {
    static constexpr bool PERM = true, CUSTOM = true;
    h16* cq; float* ssq; h16* ckv; h16* kidx; float* widx; h16* projB; const float* gkv; const float* gk; const float* bk;
    __device__ __forceinline__ void run(const f32x4 (&acc)[2][2][4][2], const pg8::Unit& u, int wr, int wc, int fr, int fq, LAS unsigned char* lds) const {
        const int row0 = u.pm * 256 + wr * 64 + fr, cin = wc * 32 + 8 * fq;
        if (u.pn >= 4) {
            h16* base = projB + (size_t)row0 * 3072 + (u.pn - 4) * 256 + cin;
#pragma unroll
            for (int ai = 0; ai < 2; ++ai)
#pragma unroll
                for (int m = 0; m < 4; ++m)
#pragma unroll
                    for (int bj = 0; bj < 2; ++bj) *(u32x4*)(base + (size_t)(ai * 128 + m * 16) * 3072 + bj * 128) = pack_h8(acc[ai][bj][m][0], acc[ai][bj][m][1]);
            return;
        }
        LAS float* P = (LAS float*)(lds + 131072);
        if (u.pn == 3) {
            if (wc < 2) {
#pragma unroll
                for (int ai = 0; ai < 2; ++ai)
#pragma unroll
                    for (int m = 0; m < 4; ++m) {
                        const f32x4 a = acc[ai][0][m][0], b = acc[ai][0][m][1];
                        float sm = (a[0] + a[1]) + (a[2] + a[3]) + (b[0] + b[1]) + (b[2] + b[3]);
                        float sq = (a[0] * a[0] + a[1] * a[1]) + (a[2] * a[2] + a[3] * a[3]) + (b[0] * b[0] + b[1] * b[1]) + (b[2] * b[2] + b[3] * b[3]);
                        sm += __shfl_xor(sm, 16); sm += __shfl_xor(sm, 32); sq += __shfl_xor(sq, 16); sq += __shfl_xor(sq, 32);
                        if (fq == 0) *(LAS f32x2*)(P + ((ai * 128 + wr * 64 + m * 16 + fr) * 2 + wc) * 2) = (f32x2){sm, sq};
                    }
            }
            asm volatile("s_waitcnt lgkmcnt(0)" ::: "memory"); __builtin_amdgcn_s_barrier(); asm volatile("" ::: "memory");
            if (wc < 2) {
                const f32x4 g0 = *(const f32x4*)(gk + cin), g1 = *(const f32x4*)(gk + cin + 4), b0 = *(const f32x4*)(bk + cin), b1 = *(const f32x4*)(bk + cin + 4);
#pragma unroll
                for (int ai = 0; ai < 2; ++ai)
#pragma unroll
                    for (int m = 0; m < 4; ++m) {
                        const f32x4 pp = *(const LAS f32x4*)(P + (ai * 128 + wr * 64 + m * 16 + fr) * 4);
                        const float mean = (pp[0] + pp[2]) * (1.f / 64.f);
                        const f32x4 xa = acc[ai][0][m][0] - mean, xb = acc[ai][0][m][1] - mean;
                        const float var = fmaxf((pp[1] + pp[3]) * (1.f / 64.f) - mean * mean, 0.f);
                        const float rstd = rsqrtf(var + EPS);
                        *(u32x4*)(kidx + (size_t)(row0 + ai * 128 + m * 16) * 64 + cin) = pack_h8(xa * rstd * g0 + b0, xb * rstd * g1 + b1);
                    }
            } else if (wc == 2 && fq < 2) {
#pragma unroll
                for (int ai = 0; ai < 2; ++ai)
#pragma unroll
                    for (int m = 0; m < 4; ++m) {
                        float* o = widx + (size_t)(row0 + ai * 128 + m * 16) * 16 + 8 * fq;
                        *(f32x4*)o = acc[ai][0][m][0] * (1.f / 32.f); *(f32x4*)(o + 4) = acc[ai][0][m][1] * (1.f / 32.f);
                    }
            }
            return;
        }
#pragma unroll
        for (int ai = 0; ai < 2; ++ai)
#pragma unroll
            for (int m = 0; m < 4; ++m) {
                float ss = 0.f;
#pragma unroll
                for (int bj = 0; bj < 2; ++bj)
#pragma unroll
                    for (int n = 0; n < 2; ++n) { const f32x4 v = acc[ai][bj][m][n]; ss += (v[0] * v[0] + v[1] * v[1]) + (v[2] * v[2] + v[3] * v[3]); }
                ss += __shfl_xor(ss, 16); ss += __shfl_xor(ss, 32);
                if (fq == 0) P[(ai * 128 + wr * 64 + m * 16 + fr) * 4 + wc] = ss;
            }
        asm volatile("s_waitcnt lgkmcnt(0)" ::: "memory"); __builtin_amdgcn_s_barrier(); asm volatile("" ::: "memory");
        if (u.pn < 2) {
            h16* base = cq + (size_t)row0 * 512 + u.pn * 256 + cin;
#pragma unroll
            for (int ai = 0; ai < 2; ++ai)
#pragma unroll
                for (int m = 0; m < 4; ++m) {
#pragma unroll
                    for (int bj = 0; bj < 2; ++bj) *(u32x4*)(base + (size_t)(ai * 128 + m * 16) * 512 + bj * 128) = pack_h8(acc[ai][bj][m][0], acc[ai][bj][m][1]);
                    if (wc == 0 && fq == 0) { const f32x4 pp = *(const LAS f32x4*)(P + (ai * 128 + wr * 64 + m * 16 + fr) * 4); ssq[(size_t)(row0 + ai * 128 + m * 16) * 2 + u.pn] = (pp[0] + pp[1]) + (pp[2] + pp[3]); }
                }
        } else {
            h16* base = ckv + (size_t)row0 * 256 + cin;
            f32x4 g[2][2];
#pragma unroll
            for (int bj = 0; bj < 2; ++bj)
#pragma unroll
                for (int n = 0; n < 2; ++n) g[bj][n] = *(const f32x4*)(gkv + cin + bj * 128 + 4 * n);
#pragma unroll
            for (int ai = 0; ai < 2; ++ai)
#pragma unroll
                for (int m = 0; m < 4; ++m) {
                    const f32x4 pp = *(const LAS f32x4*)(P + (ai * 128 + wr * 64 + m * 16 + fr) * 4);
                    const float rstd = rsqrtf(((pp[0] + pp[1]) + (pp[2] + pp[3])) * (1.f / 256.f) + EPS);
#pragma unroll
                    for (int bj = 0; bj < 2; ++bj) *(u32x4*)(base + (size_t)(ai * 128 + m * 16) * 256 + bj * 128) = pack_h8(acc[ai][bj][m][0] * rstd * g[bj][0], acc[ai][bj][m][1] * rstd * g[bj][1]);
                }
        }
    }
};
struct EpiQ {
    static constexpr bool PERM = true, CUSTOM = true;
    h16* qabs; h16* iq; const float* gq; const float* ssq;
    __device__ __forceinline__ void run(const f32x4 (&acc)[2][2][4][2], const pg8::Unit& u, int wr, int wc, int fr, int fq, LAS unsigned char* lds) const {
        const int row0 = u.pm * 256 + wr * 64 + fr, cin = wc * 32 + 8 * fq;
        float rr[2][4];
#pragma unroll
        for (int ai = 0; ai < 2; ++ai)
#pragma unroll
            for (int m = 0; m < 4; ++m) { const f32x2 s2 = *(const f32x2*)(ssq + (size_t)(row0 + ai * 128 + m * 16) * 2); rr[ai][m] = rsqrtf((s2[0] + s2[1]) * (1.f / 512.f) + EPS); }
        if (u.pn >= 8) {
            h16* base = iq + (size_t)row0 * 1024 + (u.pn - 8) * 256 + cin;
#pragma unroll
            for (int ai = 0; ai < 2; ++ai)
#pragma unroll
                for (int m = 0; m < 4; ++m)
#pragma unroll
                    for (int bj = 0; bj < 2; ++bj) *(u32x4*)(base + (size_t)(ai * 128 + m * 16) * 1024 + bj * 128) = pack_h8(acc[ai][bj][m][0] * rr[ai][m], acc[ai][bj][m][1] * rr[ai][m]);
            return;
        }
        LAS float* P = (LAS float*)(lds + 131072);
#pragma unroll
        for (int ai = 0; ai < 2; ++ai)
#pragma unroll
            for (int m = 0; m < 4; ++m) {
                float ss = 0.f;
#pragma unroll
                for (int bj = 0; bj < 2; ++bj)
#pragma unroll
                    for (int n = 0; n < 2; ++n) { const f32x4 v = acc[ai][bj][m][n]; ss += (v[0] * v[0] + v[1] * v[1]) + (v[2] * v[2] + v[3] * v[3]); }
                ss += __shfl_xor(ss, 16); ss += __shfl_xor(ss, 32);
                if (fq == 0) P[(ai * 128 + wr * 64 + m * 16 + fr) * 4 + wc] = ss * (rr[ai][m] * rr[ai][m]);
            }
        asm volatile("s_waitcnt lgkmcnt(0)" ::: "memory"); __builtin_amdgcn_s_barrier(); asm volatile("" ::: "memory");
        h16* base = qabs + (size_t)row0 * 2048 + u.pn * 256 + cin;
        f32x4 g[2][2];
#pragma unroll
        for (int bj = 0; bj < 2; ++bj)
#pragma unroll
            for (int n = 0; n < 2; ++n) g[bj][n] = *(const f32x4*)(gq + cin + bj * 128 + 4 * n) * 0.0625f;
#pragma unroll
        for (int ai = 0; ai < 2; ++ai)
#pragma unroll
            for (int m = 0; m < 4; ++m) {
                const f32x4 pp = *(const LAS f32x4*)(P + (ai * 128 + wr * 64 + m * 16 + fr) * 4);
                const float rstd = rsqrtf(((pp[0] + pp[1]) + (pp[2] + pp[3])) * (1.f / 256.f) + EPS) * rr[ai][m];
#pragma unroll
                for (int bj = 0; bj < 2; ++bj) *(u32x4*)(base + (size_t)(ai * 128 + m * 16) * 2048 + bj * 128) = pack_h8(acc[ai][bj][m][0] * rstd * g[bj][0], acc[ai][bj][m][1] * rstd * g[bj][1]);
            }
    }
};
struct EpiF16 {
    static constexpr bool PERM = true, CUSTOM = false;
    h16* o; const float* bias; mutable f32x4 bz[2][2]; mutable int cbase;
    __device__ __forceinline__ void begin_unit(int, int col0) const {
        cbase = col0;
#pragma unroll
        for (int bj = 0; bj < 2; ++bj)
#pragma unroll
            for (int n = 0; n < 2; ++n) bz[bj][n] = bias ? *(const f32x4*)(bias + col0 + bj * 128 + 4 * n) : (f32x4){0.f, 0.f, 0.f, 0.f};
    }
    __device__ __forceinline__ void store8(int row, int col, f32x4 v0, f32x4 v1) const {
        const int bj = (col - cbase) >> 7;
        *(u32x4*)(o + (size_t)row * 2048 + col) = pack_h8(v0 + (bj ? bz[1][0] : bz[0][0]), v1 + (bj ? bz[1][1] : bz[0][1]));
    }
};
struct EpiMlp1 {
    static constexpr bool PERM = true, CUSTOM = false;
    LAS const h16* b1l; h16* a; mutable f32x4 bz[2][2]; mutable int cbase;
    __device__ __forceinline__ void begin_unit(int, int col0) const {
        cbase = col0;
#pragma unroll
        for (int bj = 0; bj < 2; ++bj)
#pragma unroll
            for (int n = 0; n < 2; ++n) { const h16x4 hb = *(LAS const h16x4*)(b1l + col0 + bj * 128 + 4 * n); bz[bj][n] = (f32x4){(float)hb[0], (float)hb[1], (float)hb[2], (float)hb[3]}; }
    }
    __device__ __forceinline__ f32x4 actb(f32x4 v, f32x4 b) const {
        f32x4 z = v + b;
#pragma unroll
        for (int j = 0; j < 4; ++j) { const float r = fmaxf(z[j], 0.f); z[j] = r * r; }
        return z;
    }
    __device__ __forceinline__ void store8(int row, int col, f32x4 v0, f32x4 v1) const {
        const int bj = (col - cbase) >> 7;
        *(u32x4*)(a + (size_t)row * D_FF + col) = pack_h8(actb(v0, bj ? bz[1][0] : bz[0][0]), actb(v1, bj ? bz[1][1] : bz[0][1]));
    }
};
template <bool SCALE>
__device__ __forceinline__ void transpose_item(const float* __restrict__ src, int ld, int k0, int n0, int nvalid, const float* __restrict__ kscale,
                                               h16* __restrict__ dst, int dst_ld, int dst_row0, int dst_k0, LAS float* scr, int lane) {
    const int n = lane & 31, nn = n < nvalid ? n : nvalid - 1;
    const float msk = n < nvalid ? 1.f : 0.f;
    const float* sp = src + (size_t)(k0 + (lane >> 5)) * ld + n0 + nn;
    float v[32];
#pragma unroll
    for (int i = 0; i < 32; ++i) v[i] = sp[(size_t)(2 * i) * ld];
    if (SCALE) {
        float sc[32];
#pragma unroll
        for (int i = 0; i < 32; ++i) sc[i] = kscale[k0 + 2 * i + (lane >> 5)];
#pragma unroll
        for (int i = 0; i < 32; ++i) v[i] *= sc[i];
    }
#pragma unroll
    for (int i = 0; i < 32; ++i) scr[(2 * i + (lane >> 5)) * 33 + n] = v[i] * msk;
    LDS_WAIT(); asm volatile("" ::: "memory");
    const int c = lane & 7;
#pragma unroll
    for (int j = 0; j < 4; ++j) {
        const int nr = (lane >> 3) + 8 * j; const LAS float* s = scr + (8 * c) * 33 + nr;
        h16x8 o;
#pragma unroll
        for (int q = 0; q < 8; ++q) o[q] = (h16)s[q * 33];
        *(h16x8*)(dst + (size_t)(dst_row0 + nr) * dst_ld + dst_k0 + 8 * c) = o;
    }
    LDS_WAIT(); asm volatile("" ::: "memory");
}

__device__ __forceinline__ void phase_prep(const Params& p, LAS unsigned char* lds, int bid, int nb) {
    const int tid = threadIdx.x, lane = tid & 63, wave = tid >> 6;
    unsigned char* ws = p.ws;
    __syncthreads();
    {
        LAS f32x4* cact = (LAS f32x4*)lds;
        LAS float* red = (LAS float*)(lds + 32768);
        for (int i = tid; i < 4 * 2048; i += NTHREADS) { const int b = i >> 11, k = i & 2047; const float v = p.c[b * 2048 + k]; ((LAS float*)cact)[k * 4 + b] = v / (1.f + __expf(-v)); }
        __syncthreads();
        float* mod = (float*)(ws + WS_MOD);
        for (int cgp = bid; cgp < 192; cgp += nb) {
            const int col = cgp * 64 + lane;
            float a0 = 0.f, a1 = 0.f, a2 = 0.f, a3 = 0.f;
            const float* wp = p.w_ada + (size_t)(wave * 256) * 12288 + col;
            for (int kb = 0; kb < 256; kb += 32) {
                float wv[32];
#pragma unroll
                for (int j = 0; j < 32; ++j) wv[j] = wp[(size_t)(kb + j) * 12288];
#pragma unroll
                for (int j = 0; j < 32; ++j) { const f32x4 cv = cact[wave * 256 + kb + j]; a0 += cv[0] * wv[j]; a1 += cv[1] * wv[j]; a2 += cv[2] * wv[j]; a3 += cv[3] * wv[j]; }
            }
            red[(wave * 4 + 0) * 64 + lane] = a0; red[(wave * 4 + 1) * 64 + lane] = a1; red[(wave * 4 + 2) * 64 + lane] = a2; red[(wave * 4 + 3) * 64 + lane] = a3;
            __syncthreads();
            if (tid < 256) {
                const int b = tid >> 6, l = tid & 63; float s = 0.f;
#pragma unroll
                for (int w = 0; w < 8; ++w) s += red[(w * 4 + b) * 64 + l];
                const int cc = cgp * 64 + l;
                mod[b * 12288 + cc] = s + p.b_ada[cc];
            }
            __syncthreads();
        }
    }
    LAS float* scr = (LAS float*)(lds + wave * 16384);
    const int gw = bid * NWAVES + wave, NGW = nb * NWAVES;
    constexpr int I_IN = 32 * 128, I_1 = 32 * 256, I_2 = 128 * 64, I_OUT = 32 * 64, I_IQ = 8 * 32, I_UV = 8 * 4 * 4, I_QA = 8 * 8 * 8;
    constexpr int NITEMS = I_IN + I_1 + I_2 + I_OUT + I_IQ + I_UV + I_QA;
    const bool bal = (nb == 256);
    const int nextra = bal ? 6 : 0, base_it = bal ? 3072 : 0;
    const int nstr = (NITEMS - I_QA - base_it - gw + NGW - 1) / NGW;
    for (int kk = 0; kk < nextra + nstr; ++kk) {
        int it;
        if (kk < nextra) { if (bid < 192) continue; it = ((bid - 192) * NWAVES + wave) + 512 * kk; }
        else it = base_it + gw + (kk - nextra) * NGW;
        int r = it;
        const float* src; int ld, k0, n0, nvalid = 32, dld, drow0; const float* ksc = nullptr; h16* dst;
        if (r < I_IN) {
            const int kb = r / 128, nbk = r % 128, n0d = nbk * 32;
            if (n0d >= 864 && n0d < 1024) continue;
            src = p.w_in; ld = IN_COLS; k0 = kb * 64; n0 = n0d < 1024 ? n0d : n0d - 176; nvalid = (n0d == 832) ? 16 : 32; dst = (h16*)(ws + WS_BT_IN); dld = 2048; drow0 = n0d;
        } else if ((r -= I_IN) < I_1) { const int kb = r / 256, nbk = r % 256; src = p.w_mlp1; ld = D_FF; k0 = kb * 64; n0 = nbk * 32; dst = (h16*)(ws + WS_BT_1); dld = 2048; drow0 = n0; }
        else if ((r -= I_1) < I_2) { const int kb = r / 64, nbk = r % 64; src = p.w_mlp2; ld = 2048; k0 = kb * 64; n0 = nbk * 32; dst = (h16*)(ws + WS_BT_2); dld = 8192; drow0 = n0; }
        else if ((r -= I_2) < I_OUT) { const int kb = r / 64, nbk = r % 64; src = p.w_out; ld = 2048; k0 = kb * 64; n0 = nbk * 32; dst = (h16*)(ws + WS_BT_OUT); dld = 2048; drow0 = n0; }
        else if ((r -= I_OUT) < I_IQ) { const int kb = r / 32, nbk = r % 32; src = p.w_iq; ld = 1024; k0 = kb * 64; n0 = nbk * 32; ksc = p.cq_norm_g; dst = (h16*)(ws + WS_BT_Q); dld = 512; drow0 = 2048 + n0; }
        else { r -= I_IQ; const int h = r / 16, kb = (r % 16) / 4, nbk = r % 4; src = p.w_uv + (size_t)h * 256 * 128; ld = 128; k0 = kb * 64; n0 = nbk * 32; dst = (h16*)(ws + WS_WUVT) + (size_t)h * 128 * 256; dld = 256; drow0 = n0; }
        if (ksc) transpose_item<true>(src, ld, k0, n0, nvalid, ksc, dst, dld, drow0, k0, scr, lane);
        else transpose_item<false>(src, ld, k0, n0, nvalid, ksc, dst, dld, drow0, k0, scr, lane);
    }
    for (int r = gw; r < I_QA; r += NGW) {
        {
            const int h = r / 64, kb = (r % 64) / 8, cb = r % 8, k0 = kb * 64, c0 = cb * 32;
#pragma unroll 8
            for (int e = lane; e < 128 * 32; e += 64) { const int d = e >> 5, c = e & 31; scr[e] = p.w_uk[((size_t)h * 128 + d) * 256 + c0 + c]; }
            LDS_WAIT(); asm volatile("" ::: "memory");
            float acc[32];
#pragma unroll
            for (int c = 0; c < 32; ++c) acc[c] = 0.f;
            const float* uq = p.w_uq + (size_t)(k0 + lane) * 1024 + h * 128;
#pragma unroll 1
            for (int d0 = 0; d0 < 128; d0 += 4) {
                const f32x4 a = *(const f32x4*)(uq + d0);
#pragma unroll
                for (int dd = 0; dd < 4; ++dd) {
#pragma unroll
                    for (int c4 = 0; c4 < 8; ++c4) { const f32x4 w = *(const LAS f32x4*)(scr + (d0 + dd) * 32 + c4 * 4);
                        acc[c4 * 4 + 0] += a[dd] * w[0]; acc[c4 * 4 + 1] += a[dd] * w[1]; acc[c4 * 4 + 2] += a[dd] * w[2]; acc[c4 * 4 + 3] += a[dd] * w[3]; }
                    asm volatile("" ::: "memory");
                }
            }
            const float gk = p.cq_norm_g[k0 + lane];
            h16* dst = (h16*)(ws + WS_BT_Q);
            h16* dp = dst + (size_t)(h * 256 + c0) * 512 + k0 + lane;
#pragma unroll
            for (int c = 0; c < 32; ++c) { dp[(size_t)c * 512] = (h16)(acc[c] * gk); if ((c & 3) == 3) asm volatile("" ::: "memory"); }
            LDS_WAIT(); asm volatile("" ::: "memory");
        }
    }
    {
        u32x4* z = (u32x4*)((h16*)(ws + WS_BT_IN) + (size_t)848 * 2048);
        const int n16 = 176 * 2048 * 2 / 16;
        for (int i = bid * NTHREADS + tid; i < n16; i += nb * NTHREADS) z[i] = (u32x4){0u, 0u, 0u, 0u};
    }
}

__device__ __forceinline__ void phase_normmod(const float* __restrict__ xin, const float* __restrict__ g, const float* __restrict__ mod, int sh_off, int sc_off, h16* __restrict__ hout, int bid, int nb) {
    const int tid = threadIdx.x, lane = tid & 63, wave = tid >> 6;
    for (int t = bid * NWAVES + wave; t < T; t += nb * NWAVES) {
        const int b = t >> 12;
        const f32x4* xr = (const f32x4*)(xin + (size_t)t * 2048) + lane;
        f32x4 v[8]; float ss = 0.f;
#pragma unroll
        for (int j = 0; j < 8; ++j) { v[j] = xr[64 * j]; ss += (v[j][0] * v[j][0] + v[j][1] * v[j][1]) + (v[j][2] * v[j][2] + v[j][3] * v[j][3]); }
        const float rstd = rsqrtf(wave_sum(ss) * (1.f / 2048.f) + EPS);
        const float* mb = mod + b * 12288;
        u32x2* o = (u32x2*)(hout + (size_t)t * 2048) + lane;
#pragma unroll
        for (int j = 0; j < 8; ++j) {
            const int d = (lane + 64 * j) * 4;
            const f32x4 gg = *(const f32x4*)(g + d), sc = *(const f32x4*)(mb + sc_off + d), sh = *(const f32x4*)(mb + sh_off + d);
            f32x4 y = (v[j] * rstd) * gg;
            y = y * (sc + 1.f) + sh;
            o[64 * j] = pack_h4(y);
        }
    }
}

__device__ __forceinline__ void phase_normmod2(const Params& p, int bid, int nb) {
    const int tid = threadIdx.x, lane = tid & 63, wave = tid >> 6;
    const float* mod = (const float*)(p.ws + WS_MOD); const h16* y6 = (const h16*)(p.ws + WS_Y6); h16* hout = (h16*)(p.ws + WS_R2);
    for (int t = bid * NWAVES + wave; t < T; t += nb * NWAVES) {
        const int b = t >> 12; const float* mb = mod + b * 12288;
        const f32x4* xr = (const f32x4*)(p.x + (size_t)t * 2048) + lane;
        const u32x2* yr = (const u32x2*)(y6 + (size_t)t * 2048) + lane;
        f32x4 v[8]; float ss = 0.f;
#pragma unroll
        for (int j = 0; j < 8; ++j) {
            const int d = (lane + 64 * j) * 4;
            const f32x4 xv = xr[64 * j]; const h16x4 yh = __builtin_bit_cast(h16x4, yr[64 * j]); const f32x4 g1 = *(const f32x4*)(mb + 2 * 2048 + d);
            const f32x4 yv = {(float)yh[0], (float)yh[1], (float)yh[2], (float)yh[3]};
            v[j] = xv + g1 * yv;
            ss += (v[j][0] * v[j][0] + v[j][1] * v[j][1]) + (v[j][2] * v[j][2] + v[j][3] * v[j][3]);
        }
        const float rstd = rsqrtf(wave_sum(ss) * (1.f / 2048.f) + EPS);
        u32x2* o = (u32x2*)(hout + (size_t)t * 2048) + lane;
#pragma unroll
        for (int j = 0; j < 8; ++j) {
            const int d = (lane + 64 * j) * 4;
            const f32x4 gg = *(const f32x4*)(p.norm2_g + d), sc = *(const f32x4*)(mb + 4 * 2048 + d), sh = *(const f32x4*)(mb + 3 * 2048 + d);
            f32x4 y = (v[j] * rstd) * gg;
            y = y * (sc + 1.f) + sh;
            o[64 * j] = pack_h4(y);
        }
    }
}
__device__ __forceinline__ void phase_final(const Params& p, int bid, int nb) {
    const int tid = threadIdx.x, lane = tid & 63, wave = tid >> 6;
    const float* mod = (const float*)(p.ws + WS_MOD); const h16* y6 = (const h16*)(p.ws + WS_Y6); const h16* m16 = (const h16*)(p.ws + WS_R2);
    for (int t = bid * NWAVES + wave; t < T; t += nb * NWAVES) {
        const int b = t >> 12; const float* mb = mod + b * 12288;
        const f32x4* xr = (const f32x4*)(p.x + (size_t)t * 2048) + lane;
        const u32x2* yr = (const u32x2*)(y6 + (size_t)t * 2048) + lane;
        const u32x2* mr = (const u32x2*)(m16 + (size_t)t * 2048) + lane;
        f32x4* orow = (f32x4*)(p.out + (size_t)t * 2048) + lane;
#pragma unroll
        for (int j = 0; j < 8; ++j) {
            const int d = (lane + 64 * j) * 4;
            const f32x4 xv = xr[64 * j]; const h16x4 yh = __builtin_bit_cast(h16x4, yr[64 * j]), mh = __builtin_bit_cast(h16x4, mr[64 * j]);
            const f32x4 g1 = *(const f32x4*)(mb + 2 * 2048 + d), g2 = *(const f32x4*)(mb + 5 * 2048 + d);
            const f32x4 yv = {(float)yh[0], (float)yh[1], (float)yh[2], (float)yh[3]}, mv = {(float)mh[0], (float)mh[1], (float)mh[2], (float)mh[3]};
            orow[64 * j] = (xv + g1 * yv) + g2 * mv;
        }
    }
}

__device__ __forceinline__ void phase_rows3(const Params& p, int bid, int nb) {
    const int tid = threadIdx.x, lane = tid & 63, wave = tid >> 6;
    unsigned char* ws = p.ws;
    const h16* projB = (const h16*)(ws + WS_PROJB);
    h16* ymix = (h16*)(ws + WS_R2);
    f32x4 w0[4], w1[4], w2[4], bb[4], gn[4];
#pragma unroll
    for (int q4 = 0; q4 < 4; ++q4) {
        const int c = lane * 16 + q4 * 4;
        w0[q4] = *(const f32x4*)(p.conv_w + c); w1[q4] = *(const f32x4*)(p.conv_w + 1024 + c); w2[q4] = *(const f32x4*)(p.conv_w + 2048 + c);
        bb[q4] = *(const f32x4*)(p.conv_b + c); gn[q4] = *(const f32x4*)(p.conv_out_norm_g + c);
    }
    for (int t = bid * NWAVES + wave; t < T; t += nb * NWAVES) {
        const int tl = t & (SEQ - 1);
        const h16* pb = projB + (size_t)t * 3072 + lane * 16;
        const int d1 = tl >= 1 ? 1 : 0, d2 = tl >= 2 ? 2 : 0;
        const float m1 = tl >= 1 ? 1.f : 0.f, m2 = tl >= 2 ? 1.f : 0.f;
        h16x8 gbv[2], cv[3][2], hv[3][2];
#pragma unroll
        for (int hh = 0; hh < 2; ++hh) {
            gbv[hh] = *(const h16x8*)(pb + hh * 8);
            cv[2][hh] = *(const h16x8*)(pb + 1024 + hh * 8); hv[2][hh] = *(const h16x8*)(pb + 2048 + hh * 8);
            cv[1][hh] = *(const h16x8*)(pb - (size_t)d1 * 3072 + 1024 + hh * 8); hv[1][hh] = *(const h16x8*)(pb - (size_t)d1 * 3072 + 2048 + hh * 8);
            cv[0][hh] = *(const h16x8*)(pb - (size_t)d2 * 3072 + 1024 + hh * 8); hv[0][hh] = *(const h16x8*)(pb - (size_t)d2 * 3072 + 2048 + hh * 8);
        }
        float y[16], ss = 0.f;
#pragma unroll
        for (int i = 0; i < 16; ++i) {
            const int hh = i >> 3, q = i & 7, q4 = i >> 2, qq = i & 3;
            const float u0 = (float)cv[0][hh][q] * (float)hv[0][hh][q] * m2, u1 = (float)cv[1][hh][q] * (float)hv[1][hh][q] * m1, u2 = (float)cv[2][hh][q] * (float)hv[2][hh][q];
            float sacc = bb[q4][qq] + w0[q4][qq] * u0; sacc = sacc + w1[q4][qq] * u1; sacc = sacc + w2[q4][qq] * u2;
            y[i] = (float)gbv[hh][q] * sacc; ss += y[i] * y[i];
        }
        ss += __shfl_xor(ss, 1); ss += __shfl_xor(ss, 2); ss += __shfl_xor(ss, 4);
        const float rstd = rsqrtf(ss * (1.f / 128.f) + EPS);
        h16x8 o0, o1;
#pragma unroll
        for (int q = 0; q < 8; ++q) { o0[q] = (h16)(y[q] * rstd * gn[q >> 2][q & 3]); o1[q] = (h16)(y[8 + q] * rstd * gn[2 + (q >> 2)][q & 3]); }
        *(h16x8*)(ymix + (size_t)t * 2048 + 1024 + lane * 16) = o0;
        *(h16x8*)(ymix + (size_t)t * 2048 + 1024 + lane * 16 + 8) = o1;
    }
}

__constant__ unsigned char c_bucket_thr[15] = {19, 21, 24, 27, 31, 35, 40, 46, 52, 59, 67, 77, 87, 99, 113};
__device__ __forceinline__ int t5_bucket(int n) {
    if (n < 16) return n;
    int bkt = 16;
#pragma unroll
    for (int i = 0; i < 15; ++i) bkt += (n >= (int)c_bucket_thr[i]) ? 1 : 0;
    return bkt;
}
typedef float f32x16 __attribute__((ext_vector_type(16)));
__device__ __forceinline__ float next_up(float x) {
    const unsigned u = __float_as_uint(x);
    if ((u << 1) == 0u) return __uint_as_float(1u);
    return __uint_as_float((u >> 31) ? u - 1u : u + 1u);
}
__device__ __forceinline__ int wave_sum_dpp(int x) {
    x += __builtin_amdgcn_update_dpp(0, x, 0xB1, 0xf, 0xf, false);
    x += __builtin_amdgcn_update_dpp(0, x, 0x4E, 0xf, 0xf, false);
    x += __builtin_amdgcn_update_dpp(0, x, 0x124, 0xf, 0xf, false);
    x += __builtin_amdgcn_update_dpp(0, x, 0x128, 0xf, 0xf, false);
    return (__builtin_amdgcn_readlane(x, 0) + __builtin_amdgcn_readlane(x, 16)) + (__builtin_amdgcn_readlane(x, 32) + __builtin_amdgcn_readlane(x, 48));
}
__device__ __forceinline__ float dpp_f(float v, const int ctrl_sel) {
    const int i = __float_as_int(v);
    int r;
    if (ctrl_sel == 0) r = __builtin_amdgcn_update_dpp(i, i, 0xB1, 0xf, 0xf, false);
    else if (ctrl_sel == 1) r = __builtin_amdgcn_update_dpp(i, i, 0x4E, 0xf, 0xf, false);
    else if (ctrl_sel == 2) r = __builtin_amdgcn_update_dpp(i, i, 0x124, 0xf, 0xf, false);
    else r = __builtin_amdgcn_update_dpp(i, i, 0x128, 0xf, 0xf, false);
    return __int_as_float(r);
}
__device__ __forceinline__ float wave_min_dpp(float v) {
    v = fminf(v, dpp_f(v, 0)); v = fminf(v, dpp_f(v, 1)); v = fminf(v, dpp_f(v, 2)); v = fminf(v, dpp_f(v, 3));
    const float a = __int_as_float(__builtin_amdgcn_readlane(__float_as_int(v), 0)), b = __int_as_float(__builtin_amdgcn_readlane(__float_as_int(v), 16));
    const float c = __int_as_float(__builtin_amdgcn_readlane(__float_as_int(v), 32)), d = __int_as_float(__builtin_amdgcn_readlane(__float_as_int(v), 48));
    return fminf(fminf(a, b), fminf(c, d));
}
__device__ __forceinline__ float wave_max_dpp(float v) {
    v = fmaxf(v, dpp_f(v, 0)); v = fmaxf(v, dpp_f(v, 1)); v = fmaxf(v, dpp_f(v, 2)); v = fmaxf(v, dpp_f(v, 3));
    const float a = __int_as_float(__builtin_amdgcn_readlane(__float_as_int(v), 0)), b = __int_as_float(__builtin_amdgcn_readlane(__float_as_int(v), 16));
    const float c = __int_as_float(__builtin_amdgcn_readlane(__float_as_int(v), 32)), d = __int_as_float(__builtin_amdgcn_readlane(__float_as_int(v), 48));
    return fmaxf(fmaxf(a, b), fmaxf(c, d));
}
typedef short s16x2 __attribute__((ext_vector_type(2)));
__device__ __forceinline__ h16x2 relu_pk(h16x2 x) { const s16x2 z = {0, 0}; return __builtin_bit_cast(h16x2, __builtin_elementwise_max(__builtin_bit_cast(s16x2, x), z)); }
__device__ __forceinline__ float relu_asm(float x) { const int i = __builtin_bit_cast(int, x); return __builtin_bit_cast(float, i > 0 ? i : 0); }
constexpr int IDX_CHUNK = 512;
constexpr int IDX_NG = IDX_CHUNK / 64;
constexpr int IDX_CHB = IDX_CHUNK * 128;
__device__ __forceinline__ void phase_index(const Params& p, LAS unsigned char* lds, int bid, int nb) {
    const int tid = threadIdx.x, lane = tid & 63, wave = __builtin_amdgcn_readfirstlane(tid >> 6), k16 = lane & 15, g = lane >> 4;
    unsigned char* ws = p.ws;
    const h16* iq = (const h16*)(ws + WS_IQ); const h16* kidx = (const h16*)(ws + WS_KIDX); const float* widx = (const float*)(ws + WS_WIDX);
    unsigned short* sel = (unsigned short*)(ws + WS_SEL);
    const int ksw = (k16 >> 1) & 7;
    const int sp0 = tid & 7;
    unsigned soff[IDX_NG];
#pragma unroll
    for (int q = 0; q < IDX_NG; ++q) { const int sk = (tid >> 3) + 64 * q; soff[q] = (unsigned)(sk * 128 + ((sp0 ^ ((sk >> 1) & 7)) << 4)); }
    const int nitems = (nb == 256) ? 8 : (2048 + nb - 1) / nb;
    for (int ii = 0; ii < nitems; ++ii) {
        int b, i;
        if (nb == 256) { b = (bid & 7) >> 1; const int idx = ((bid >> 3) << 1) | (bid & 1); const int pr = ii >> 1; i = (ii & 1) ? (128 * pr + idx) : (128 * pr + 127 - idx); }
        else { const int item = bid + ii * nb; if (item >= 2048) break; b = item >> 9; i = item & 511; }
        if (i < 32) continue;
        const int t0 = i * 8;
        const int nchunk = (t0 + 7) / IDX_CHUNK + 1;
        const int tq = t0 + wave;
        const size_t tg = (size_t)b * SEQ + tq;
        const h16* kb = kidx + (size_t)b * SEQ * 64;
        h16x8 Af[2];
        {
            const h16* ap = iq + tg * 1024 + k16 * 64 + g * 8;
            Af[0] = *(const h16x8*)ap; Af[1] = *(const h16x8*)(ap + 32);
        }
        h16x8 A2[2];
        {
            const f32x4 wv = *(const f32x4*)(widx + tg * 16 + 4 * g);
            h16x4 whi, wlo;
#pragma unroll
            for (int r = 0; r < 4; ++r) { whi[r] = (h16)wv[r]; wlo[r] = (h16)(wv[r] - (float)whi[r]); }
#pragma unroll
            for (int pp = 0; pp < 2; ++pp) {
#pragma unroll
                for (int r = 0; r < 4; ++r) {
                    A2[pp][r] = (k16 == 8 * pp) ? whi[r] : ((k16 == 8 * pp + 1) ? wlo[r] : (h16)0.f);
                    A2[pp][4 + r] = (k16 == 8 * pp + 4) ? whi[r] : ((k16 == 8 * pp + 5) ? wlo[r] : (h16)0.f);
                }
            }
        }
        float sc[64];
#pragma unroll
        for (int j = 0; j < 64; ++j) sc[j] = -INFINITY;
        {
            u32x4 a[IDX_NG];
#pragma unroll
            for (int q = 0; q < IDX_NG; ++q) a[q] = *(const u32x4*)(kb + (size_t)((tid >> 3) + 64 * q) * 64 + sp0 * 8);
#pragma unroll
            for (int q = 0; q < IDX_NG; ++q) *(LAS u32x4*)(lds + soff[q]) = a[q];
        }
        __builtin_amdgcn_s_waitcnt(0x0F70);
        __syncthreads();
#pragma unroll 1
        for (int c = 0; c < nchunk; ++c) {
            {
                const int cn1 = (c + 1 < nchunk) ? c + 1 : c;
                u32x4 st[IDX_NG];
#pragma unroll
                for (int q = 0; q < IDX_NG; ++q) st[q] = *(const u32x4*)(kb + (size_t)(IDX_CHUNK * cn1 + (tid >> 3) + 64 * q) * 64 + sp0 * 8);
                const LAS unsigned char* buf = lds + (c & 1) * IDX_CHB;
                float vy[IDX_CHUNK / 64];
                h16x8 Bc[8];
                {
                    const LAS unsigned char* rp = buf + k16 * 128;
#pragma unroll
                    for (int x = 0; x < 4; ++x)
#pragma unroll
                        for (int ks = 0; ks < 2; ++ks) Bc[2 * x + ks] = *(const LAS h16x8*)(rp + x * 2048 + (((4 * ks + g) ^ ksw) << 4));
                }
#pragma unroll
                for (int yy = 0; yy < IDX_CHUNK / 64; ++yy) {
                    h16x8 Bn[8];
                    if (yy + 1 < IDX_CHUNK / 64) {
                        const LAS unsigned char* rp = buf + ((yy + 1) * 64 + k16) * 128;
#pragma unroll
                        for (int x = 0; x < 4; ++x)
#pragma unroll
                            for (int ks = 0; ks < 2; ++ks) Bn[2 * x + ks] = *(const LAS h16x8*)(rp + x * 2048 + (((4 * ks + g) ^ ksw) << 4));
                    }
                    f32x4 acc[4];
#pragma unroll
                    for (int x = 0; x < 4; ++x) acc[x] = __builtin_amdgcn_mfma_f32_16x16x32_f16(Af[0], Bc[2 * x], (f32x4){0.f, 0.f, 0.f, 0.f}, 0, 0, 0);
#pragma unroll
                    for (int x = 0; x < 4; ++x) acc[x] = __builtin_amdgcn_mfma_f32_16x16x32_f16(Af[1], Bc[2 * x + 1], acc[x], 0, 0, 0);
                    f32x4 D2 = {0.f, 0.f, 0.f, 0.f};
#pragma unroll
                    for (int pp = 0; pp < 2; ++pp) {
                        h16x2 q[4];
#pragma unroll
                        for (int e = 0; e < 2; ++e) {
                            const f32x2 r01 = {acc[2 * pp + e][0], acc[2 * pp + e][1]}, r23 = {acc[2 * pp + e][2], acc[2 * pp + e][3]};
                            q[2 * e] = relu_pk(__builtin_convertvector(r01, h16x2)); q[2 * e + 1] = relu_pk(__builtin_convertvector(r23, h16x2));
                        }
                        h16x8 B2; B2[0] = q[0][0]; B2[1] = q[0][1]; B2[2] = q[1][0]; B2[3] = q[1][1]; B2[4] = q[2][0]; B2[5] = q[2][1]; B2[6] = q[3][0]; B2[7] = q[3][1];
                        D2 = __builtin_amdgcn_mfma_f32_16x16x32_f16(A2[pp], B2, D2, 0, 0, 0);
                    }
                    const int k = (c * (IDX_CHUNK / 64) + yy) * 64 + lane;
                    vy[yy] = (k <= tq) ? D2[0] + D2[1] : -INFINITY;
                    if (yy + 1 < IDX_CHUNK / 64) {
#pragma unroll
                        for (int q = 0; q < 8; ++q) Bc[q] = Bn[q];
                    }
                }
                switch (c) {
#define IDX_CASE(C) case C: _Pragma("unroll") for (int j = 0; j < IDX_NG; ++j) sc[IDX_NG * C + j] = vy[j]; break;
                    IDX_CASE(0) IDX_CASE(1) IDX_CASE(2) IDX_CASE(3) IDX_CASE(4) IDX_CASE(5) IDX_CASE(6) IDX_CASE(7)
#undef IDX_CASE
                    default: break;
                }
                {
                    LAS unsigned char* nbuf = lds + ((c + 1) & 1) * IDX_CHB;
#pragma unroll
                    for (int q = 0; q < IDX_NG; ++q) *(LAS u32x4*)(nbuf + soff[q]) = st[q];
                    __syncthreads();
                }
            }
        }
        const int nq = (tq >> 10) + 1;
        float vmin = INFINITY, vmax = -INFINITY;
#pragma unroll
        for (int q = 0; q < 4; ++q) if (q < nq) {
#pragma unroll
            for (int j = 16 * q; j < 16 * q + 16; ++j) { const float v = sc[j]; vmax = fmaxf(vmax, v); vmin = fminf(vmin, (v == -INFINITY) ? INFINITY : v); }
        }
        float lo = wave_min_dpp(vmin), hi = next_up(wave_max_dpp(vmax));
        int clo = tq + 1, chi = 0;
        float Tsel = lo; bool exact = false, finished = false;
        unsigned short* so = sel + tg * TOPK;
        int it = 0;
        for (; it < 200; ++it) {
            if (clo <= 512) break;
            float mid = 0.5f * lo + 0.5f * hi;
            if (!(it & 1)) { const float frac = ((float)(clo - TOPK) - 0.5f) / (float)(clo - chi); const float sm = lo + (hi - lo) * frac; if (sm > lo && sm < hi) mid = sm; }
            if (!(mid > lo && mid < hi)) { Tsel = lo; finished = true; break; }
            int cn = 0;
#pragma unroll
            for (int q = 0; q < 4; ++q) if (q < nq) {
#pragma unroll
                for (int j = 16 * q; j < 16 * q + 16; ++j) cn += (sc[j] >= mid) ? 1 : 0;
            }
            cn = wave_sum_dpp(cn);
            if (cn == TOPK) { Tsel = mid; exact = true; finished = true; break; }
            if (cn > TOPK) { lo = mid; clo = cn; } else { hi = mid; chi = cn; }
            Tsel = lo;
        }
        if (clo <= 512 && !finished) {
            LAS float* cl = (LAS float*)(lds + 131072 + wave * 3072);
            LAS unsigned short* ckl = (LAS unsigned short*)(lds + 131072 + wave * 3072 + 2048);
            int nc = 0;
#pragma unroll
            for (int q = 0; q < 4; ++q) if (q < nq) {
#pragma unroll
                for (int j = 16 * q; j < 16 * q + 16; ++j) {
                    const float v = sc[j];
                    const bool isc = v >= lo;
                    const unsigned long long bc = __ballot(isc);
                    const int pr = __builtin_amdgcn_mbcnt_hi((unsigned)(bc >> 32), __builtin_amdgcn_mbcnt_lo((unsigned)bc, 0u));
                    if (isc) { cl[nc + pr] = v; ckl[nc + pr] = (unsigned short)(j * 64 + lane); }
                    nc += __popcll(bc);
                }
            }
            LDS_WAIT();
            float cv[8]; int ck[8];
#pragma unroll
            for (int j = 0; j < 8; ++j) { const int pos = 64 * j + lane; const bool in = pos < nc; cv[j] = in ? cl[pos] : -INFINITY; ck[j] = in ? (int)ckl[pos] : 0; }
            for (; it < 400; ++it) {
                float mid = 0.5f * lo + 0.5f * hi;
                if (!(it & 1)) { const float frac = ((float)(clo - TOPK) - 0.5f) / (float)(clo - chi); const float sm = lo + (hi - lo) * frac; if (sm > lo && sm < hi) mid = sm; }
                if (!(mid > lo && mid < hi)) { Tsel = lo; break; }
                int cn = 0;
#pragma unroll
                for (int j = 0; j < 8; ++j) cn += (cv[j] >= mid) ? 1 : 0;
                cn = wave_sum_dpp(cn);
                if (cn == TOPK) { Tsel = mid; exact = true; break; }
                if (cn > TOPK) { lo = mid; clo = cn; } else { hi = mid; chi = cn; }
                Tsel = lo;
            }
            int quota = 0;
            if (!exact) { int ngt = 0;
#pragma unroll
                for (int j = 0; j < 8; ++j) ngt += (cv[j] > Tsel) ? 1 : 0;
                quota = TOPK - wave_sum_dpp(ngt); }
            int outb = 0, eqb = 0;
#pragma unroll
            for (int j = 0; j < 8; ++j) {
                const float v = cv[j];
                bool take;
                if (exact) take = v >= Tsel;
                else {
                    const bool eq = v == Tsel;
                    const unsigned long long beq = __ballot(eq);
                    const int eqr = __builtin_amdgcn_mbcnt_hi((unsigned)(beq >> 32), __builtin_amdgcn_mbcnt_lo((unsigned)beq, 0u));
                    take = (v > Tsel) || (eq && (eqb + eqr) < quota);
                    eqb += __popcll(beq);
                }
                const unsigned long long bt = __ballot(take);
                const int tr = __builtin_amdgcn_mbcnt_hi((unsigned)(bt >> 32), __builtin_amdgcn_mbcnt_lo((unsigned)bt, 0u));
                if (take) so[outb + tr] = (unsigned short)ck[j];
                outb += __popcll(bt);
            }
            LDS_WAIT();
        } else if (exact) {
            int outb = 0;
#pragma unroll
            for (int q = 0; q < 4; ++q) if (q < nq) {
#pragma unroll
                for (int j = 16 * q; j < 16 * q + 16; ++j) {
                    const bool take = sc[j] >= Tsel;
                    const unsigned long long bt = __ballot(take);
                    const int tr = __builtin_amdgcn_mbcnt_hi((unsigned)(bt >> 32), __builtin_amdgcn_mbcnt_lo((unsigned)bt, 0u));
                    if (take) so[outb + tr] = (unsigned short)(j * 64 + lane);
                    outb += __popcll(bt);
                }
            }
        } else {
            int ngt = 0;
#pragma unroll
            for (int j = 0; j < 64; ++j) ngt += (sc[j] > Tsel) ? 1 : 0;
            ngt = wave_sum_dpp(ngt);
            const int quota = TOPK - ngt;
            int outb = 0, eqb = 0;
#pragma unroll
            for (int j = 0; j < 64; ++j) {
                const float v = sc[j];
                const bool gt = v > Tsel, eq = v == Tsel;
                const unsigned long long beq = __ballot(eq);
                const int eqr = __builtin_amdgcn_mbcnt_hi((unsigned)(beq >> 32), __builtin_amdgcn_mbcnt_lo((unsigned)beq, 0u));
                const bool take = gt || (eq && (eqb + eqr) < quota);
                const unsigned long long bt = __ballot(take);
                const int tr = __builtin_amdgcn_mbcnt_hi((unsigned)(bt >> 32), __builtin_amdgcn_mbcnt_lo((unsigned)bt, 0u));
                if (take) so[outb + tr] = (unsigned short)(j * 64 + lane);
                outb += __popcll(bt); eqb += __popcll(beq);
            }
        }
    }
    __syncthreads();
}

typedef short s16x4v __attribute__((__vector_size__(4 * sizeof(short))));
__device__ __forceinline__ h16x4 lds_tr_read(const LAS unsigned char* p) {
    return __builtin_bit_cast(h16x4, __builtin_amdgcn_ds_read_tr16_b64_v4i16((LAS s16x4v*)p));
}
__device__ __forceinline__ void phase_attn(const Params& p, LAS unsigned char* lds, int bid, int nb) {
    const int tid = threadIdx.x, lane = tid & 63, wave = __builtin_amdgcn_readfirstlane(tid >> 6), g = lane >> 4, hd = lane & 15;
    unsigned char* ws = p.ws;
    const h16* qabs = (const h16*)(ws + WS_QABS); const h16* ckv = (const h16*)(ws + WS_CKV);
    const unsigned short* sel = (const unsigned short*)(ws + WS_SEL);
    h16* olat = (h16*)(ws + WS_OLAT);
    LAS unsigned char* kv = lds + wave * 16384;
    LAS int* sidx = (LAS int*)(lds + 131072 + wave * 1024);
    LAS float* biasT = (LAS float*)(lds + 131072 + 8192);
    LAS unsigned char* bktT = lds + 131072 + 8192 + 1024;
    __syncthreads();
    if (tid < 256) biasT[tid] = p.rel_bias[tid];
    if (tid < 128) bktT[tid] = (unsigned char)t5_bucket(tid);
    __syncthreads();
    int tstart, tstride, tcount;
    if (nb == 256) { const int b = (bid & 7) >> 1, wq = ((((bid >> 3) << 1) | (bid & 1)) << 3) + wave; tstart = b * SEQ + wq; tstride = 512; tcount = 8; }
    else { tstart = bid * NWAVES + wave; tstride = nb * NWAVES; tcount = (T - tstart + tstride - 1) / tstride; }
    const int rowA = hd;
    const int fswA = ((rowA & 3) << 1) | (((rowA >> 2) & 1) << 3);
    const int q4 = hd >> 2, p4 = hd & 3;
    const int rowT = 4 * g + q4;
    const int fswT = ((rowT & 3) << 1) | (((rowT >> 2) & 1) << 3);
    const LAS unsigned char* trbase = kv + rowT * 512 + 8 * (p4 & 1);
    for (int qi = 0; qi < tcount; ++qi) {
        const int tg = tstart + qi * tstride;
        const int b = tg >> 12, tl = tg & (SEQ - 1);
        const int cnt = tl + 1 < TOPK ? tl + 1 : TOPK, nch = (cnt + 31) >> 5;
        {
            int i0, i1, i2, i3;
            if (tl + 1 > TOPK) { const u32x2 s4 = *(const u32x2*)(sel + (size_t)tg * TOPK + lane * 4); i0 = s4.x & 0xffff; i1 = s4.x >> 16; i2 = s4.y & 0xffff; i3 = s4.y >> 16; }
            else { const int j = lane * 4; i0 = j < cnt ? j : 0; i1 = j + 1 < cnt ? j + 1 : 0; i2 = j + 2 < cnt ? j + 2 : 0; i3 = j + 3 < cnt ? j + 3 : 0; }
            *(LAS i32x4*)(sidx + lane * 4) = (i32x4){i0, i1, i2, i3};
        }
        h16x8 Qf[8];
#pragma unroll
        for (int ks = 0; ks < 8; ++ks) {
            h16x8 z;
#pragma unroll
            for (int e = 0; e < 8; ++e) z[e] = (h16)0.f;
            Qf[ks] = (hd < 8) ? *(const h16x8*)(qabs + (size_t)tg * 2048 + hd * 256 + ks * 32 + g * 8) : z;
        }
        f32x4 O[16];
#pragma unroll
        for (int ct = 0; ct < 16; ++ct) O[ct] = (f32x4){0.f, 0.f, 0.f, 0.f};
        float m = -INFINITY, l = 0.f;
        const unsigned char* ckvb = (const unsigned char*)(ckv + (size_t)b * SEQ * 256);
        LDS_WAIT();
        for (int c = 0; c < nch; ++c) {
            asm volatile("" ::: "memory");
#pragma unroll
            for (int i = 0; i < 16; ++i) {
                const int row = 2 * i + (lane >> 5);
                const int idx = sidx[32 * c + row];
                const int fsw = ((row & 3) << 1) | (((row >> 2) & 1) << 3);
                const unsigned char* src = ckvb + (size_t)idx * 512 + ((((lane & 31) ^ fsw)) << 4);
                __builtin_amdgcn_global_load_lds((const unsigned*)src, (LAS unsigned*)(kv + i * 1024), 16, 0, 0);
            }
            const i32x4 ia = *(const LAS i32x4*)(sidx + 32 * c + 4 * g), ib = *(const LAS i32x4*)(sidx + 32 * c + 16 + 4 * g);
            const int h7 = hd & 7;
            const int kk8[8] = {ia.x, ia.y, ia.z, ia.w, ib.x, ib.y, ib.z, ib.w};
            float bias8[8];
#pragma unroll
            for (int r = 0; r < 8; ++r) {
                const int slot = 32 * c + (r < 4 ? 4 * g + r : 16 + 4 * g + (r - 4));
                int dist = tl - kk8[r]; dist = dist < 0 ? 0 : (dist > 127 ? 127 : dist);
                bias8[r] = (slot < cnt) ? biasT[(int)bktT[dist] * 8 + h7] : -INFINITY;
            }
            asm volatile("s_waitcnt vmcnt(0)" ::: "memory");
            __builtin_amdgcn_sched_barrier(0);
            f32x4 S0 = {0.f, 0.f, 0.f, 0.f}, S1 = {0.f, 0.f, 0.f, 0.f};
#pragma unroll
            for (int ks = 0; ks < 8; ++ks) {
                const h16x8 A0 = *(const LAS h16x8*)(kv + rowA * 512 + (((4 * ks + g) ^ fswA) << 4));
                const h16x8 A1 = *(const LAS h16x8*)(kv + (rowA + 16) * 512 + (((4 * ks + g) ^ fswA) << 4));
                S0 = __builtin_amdgcn_mfma_f32_16x16x32_f16(A0, Qf[ks], S0, 0, 0, 0);
                S1 = __builtin_amdgcn_mfma_f32_16x16x32_f16(A1, Qf[ks], S1, 0, 0, 0);
            }
            float sv[8]; float cmax = -INFINITY;
#pragma unroll
            for (int r = 0; r < 8; ++r) { sv[r] = ((r < 4) ? S0[r] : S1[r - 4]) + bias8[r]; cmax = fmaxf(cmax, sv[r]); }
            if (__any(cmax > m + 8.f)) {
                cmax = fmaxf(cmax, __shfl_xor(cmax, 16)); cmax = fmaxf(cmax, __shfl_xor(cmax, 32));
                const float mnew = fmaxf(m, cmax);
                const float alpha = __expf(m - mnew);
                l *= alpha; m = mnew;
#pragma unroll
                for (int ct = 0; ct < 16; ++ct) O[ct] *= alpha;
            }
            h16x8 Pf;
#pragma unroll
            for (int r = 0; r < 8; ++r) { const float pv = __expf(sv[r] - m); l += pv; Pf[r] = (h16)pv; }
#pragma unroll
            for (int ct = 0; ct < 16; ++ct) {
                const int choff = ((((2 * (ct & 7)) ^ fswT) + (p4 >> 1)) << 4) + (ct >> 3) * 256;
                const h16x4 a0 = lds_tr_read(trbase + choff);
                const h16x4 a1 = lds_tr_read(trbase + 16 * 512 + choff);
                h16x8 Av; Av[0] = a0[0]; Av[1] = a0[1]; Av[2] = a0[2]; Av[3] = a0[3]; Av[4] = a1[0]; Av[5] = a1[1]; Av[6] = a1[2]; Av[7] = a1[3];
                O[ct] = __builtin_amdgcn_mfma_f32_16x16x32_f16(Av, Pf, O[ct], 0, 0, 0);
            }
            asm volatile("" ::: "memory");
        }
        l += __shfl_xor(l, 16); l += __shfl_xor(l, 32);
        if (hd < 8) {
            const float inv = 1.f / l;
            h16* op = olat + (size_t)tg * 2048 + hd * 256 + 4 * g;
#pragma unroll
            for (int ct = 0; ct < 16; ++ct) *(u32x2*)(op + 16 * ct) = pack_h4(O[ct] * inv);
        }
    }
    __syncthreads();
}

__device__ __forceinline__ void phase_uv(const Params& p, LAS unsigned char* lds, int bid, int nb) {
    const int tid = threadIdx.x, lane = tid & 63, wave = tid >> 6, r31 = lane & 31, hh = lane >> 5;
    unsigned char* ws = p.ws;
    const h16* olat = (const h16*)(ws + WS_OLAT); const h16* wuvT = (const h16*)(ws + WS_WUVT);
    h16* ymix = (h16*)(ws + WS_R2);
    for (int u = bid; u < 256; u += nb) {
        const int h = u & 7, rb = u >> 3;
        __syncthreads();
        for (int e = tid; e < 128 * 32; e += NTHREADS) { const int v = e >> 5, ch = e & 31; *(LAS u32x4*)(lds + v * 528 + ch * 16) = *(const u32x4*)(wuvT + ((size_t)h * 128 + v) * 256 + ch * 8); }
        __syncthreads();
        for (int tile = wave; tile < 16; tile += NWAVES) {
            const int row0 = rb * 512 + tile * 32;
            f32x16 acc[4];
#pragma unroll
            for (int vt = 0; vt < 4; ++vt)
#pragma unroll
                for (int r = 0; r < 16; ++r) acc[vt][r] = 0.f;
            const h16* bp = olat + (size_t)(row0 + r31) * 2048 + h * 256 + hh * 8;
#pragma unroll 4
            for (int ks = 0; ks < 16; ++ks) {
                const h16x8 Bf = *(const h16x8*)(bp + ks * 16);
#pragma unroll
                for (int vt = 0; vt < 4; ++vt) {
                    const h16x8 Af = *(const LAS h16x8*)(lds + (vt * 32 + r31) * 528 + ks * 32 + hh * 16);
                    acc[vt] = __builtin_amdgcn_mfma_f32_32x32x16_f16(Af, Bf, acc[vt], 0, 0, 0);
                }
            }
            float ss = 0.f;
#pragma unroll
            for (int vt = 0; vt < 4; ++vt)
#pragma unroll
                for (int r = 0; r < 16; ++r) ss += acc[vt][r] * acc[vt][r];
            ss += __shfl_xor(ss, 32);
            const float rstd = rsqrtf(ss * (1.f / 128.f) + EPS);
            h16* yp = ymix + (size_t)(row0 + r31) * 2048 + h * 128 + 4 * hh;
            const float* gp = p.attn_out_norm_g + h * 128 + 4 * hh;
#pragma unroll
            for (int vt = 0; vt < 4; ++vt)
#pragma unroll
                for (int rq = 0; rq < 4; ++rq) {
                    const f32x4 gg = *(const f32x4*)(gp + vt * 32 + 8 * rq);
                    const f32x4 y = {acc[vt][4 * rq + 0] * rstd * gg[0], acc[vt][4 * rq + 1] * rstd * gg[1], acc[vt][4 * rq + 2] * rstd * gg[2], acc[vt][4 * rq + 3] * rstd * gg[3]};
                    *(u32x2*)(yp + vt * 32 + 8 * rq) = pack_h4(y);
                }
        }
    }
    __syncthreads();
}

#define XB_TMO      128
#define XB_XCNT(j)  (256  + 64 * (j))
#define XB_XSUB(j)  (1280 + 64 * (j))
#define XB_XGEN(j)  (2304 + 64 * (j))
#define XB_TOP      3328
#define XB_TOPGEN   3392
#define XCD_BAR_WORDS 3456
#define XB_SPIN_CAP (1u << 22)
__device__ __forceinline__ unsigned xb_ld(unsigned* p)              { return __hip_atomic_load(p, __ATOMIC_RELAXED, __HIP_MEMORY_SCOPE_AGENT); }
__device__ __forceinline__ unsigned xb_add(unsigned* p, unsigned v) { return __hip_atomic_fetch_add(p, v, __ATOMIC_RELAXED, __HIP_MEMORY_SCOPE_AGENT); }
__device__ __forceinline__ unsigned xb_xcc_id() { return (unsigned)__builtin_amdgcn_s_getreg((3 << 11) | 20) & 0xFu; }
#define XB_SPIN(cond, bar) do { unsigned _sp = 0; while (cond) { __builtin_amdgcn_s_sleep(1); \
    if ((++_sp & 255u) == 0u) { if (xb_ld(&(bar)[XB_TMO])) break; if (_sp > XB_SPIN_CAP) { atomicAdd(&(bar)[XB_TMO], 1u); break; } } } } while (0)
struct XcdBarrier { unsigned* bar; unsigned x; volatile LAS unsigned* st; };
__device__ __forceinline__ XcdBarrier xcd_barrier_post(unsigned* bar, volatile LAS unsigned* st) {
    XcdBarrier b; b.bar = bar; b.x = xb_xcc_id(); b.st = st;
    if (threadIdx.x == 0) (void)xb_add(&bar[XB_XCNT(b.x)], 1u);
    return b;
}
__device__ __forceinline__ void xcd_barrier_complete(unsigned* bar, unsigned x, unsigned& nloc, unsigned& nx) {
    const unsigned G = gridDim.x * gridDim.y * gridDim.z;
    unsigned sum, cnt, mine, sp = 0u;
    for (;;) {
        sum = 0u; cnt = 0u; mine = 0u;
#pragma unroll
        for (unsigned j = 0; j < 16; ++j) { const unsigned c = xb_ld(&bar[XB_XCNT(j)]); sum += c; cnt += (c > 0u) ? 1u : 0u; mine = (j == x) ? c : mine; }
        if (sum == G) break;
        __builtin_amdgcn_s_sleep(1);
        if ((++sp & 255u) == 0u) { if (xb_ld(&bar[XB_TMO])) break; if (sp > XB_SPIN_CAP) { atomicAdd(&bar[XB_TMO], 1u); break; } }
    }
    nloc = mine > 0u ? mine : 1u; nx = cnt > 0u ? cnt : 1u;
}
__device__ __forceinline__ void xcd_barrier(const XcdBarrier& b) {
    asm volatile("s_waitcnt vmcnt(0)" ::: "memory");
    __syncthreads();
    if (threadIdx.x == 0) {
        unsigned* bar = b.bar;
        __builtin_amdgcn_s_waitcnt(0);
        unsigned nloc = b.st[0], nx = b.st[1];
        if (nloc == 0u) { xcd_barrier_complete(bar, b.x, nloc, nx); b.st[0] = nloc; b.st[1] = nx; }
        const unsigned old = xb_add(&bar[XB_XSUB(b.x)], 1u);
        const unsigned gen = old / nloc;
        if (old + 1u == (gen + 1u) * nloc) {
            __builtin_amdgcn_fence(__ATOMIC_RELEASE, "agent");
            asm volatile("s_waitcnt vmcnt(0)" ::: "memory");
            const unsigned og = xb_add(&bar[XB_TOP], 1u);
            const unsigned tg = og / nx;
            if (og + 1u == (tg + 1u) * nx) xb_add(&bar[XB_TOPGEN], 1u);
            else XB_SPIN(xb_ld(&bar[XB_TOPGEN]) == tg, bar);
            __builtin_amdgcn_fence(__ATOMIC_ACQUIRE, "agent");
            xb_add(&bar[XB_XGEN(b.x)], 1u);
            asm volatile("s_waitcnt vmcnt(0)" ::: "memory");
        } else {
            XB_SPIN(xb_ld(&bar[XB_XGEN(b.x)]) == gen, bar);
            __builtin_amdgcn_fence(__ATOMIC_ACQUIRE, "agent");
            asm volatile("s_waitcnt vmcnt(0)" ::: "memory");
        }
    }
    __syncthreads();
}

constexpr int LDS_BYTES = 160 * 1024;
constexpr int WGM_G1 = 2, WGM_G2 = 2, WGM_G6 = 2, WGM_G7 = 8, WGM_G8 = 2;
constexpr int NPHASES = 13;
__global__ void __launch_bounds__(NTHREADS, 2) fwd_kernel(Params p) {
    extern __shared__ __attribute__((aligned(16))) unsigned char lds_raw[];
    LAS unsigned char* lds = (LAS unsigned char*)lds_raw;
    const int bid = blockIdx.x, nb = gridDim.x;
    unsigned char* ws = p.ws;
    float* mod = (float*)(ws + WS_MOD);
    volatile LAS unsigned* bst = (volatile LAS unsigned*)(lds + LDS_BYTES - 64);
    if (threadIdx.x < 2) bst[threadIdx.x] = 0u;
    __syncthreads();
    XcdBarrier xbar = xcd_barrier_post((unsigned*)(ws + WS_CTL), bst);
#define IN(k) (p.ph_lo <= (k) && (k) < p.ph_hi)
#define SEAM(k) do { if (IN(k) && IN((k) + 1)) xcd_barrier(xbar); } while (0)
    if (IN(0)) { phase_prep(p, lds, bid, nb); } SEAM(0);
    if (IN(1)) { phase_normmod(p.x, p.norm1_g, mod, 0, 2048, (h16*)(ws + WS_R2), bid, nb); } SEAM(1);
    if (IN(2)) { EpiProj E{(h16*)(ws + WS_CQ), (float*)(ws + WS_PROJA), (h16*)(ws + WS_CKV), (h16*)(ws + WS_KIDX), (float*)(ws + WS_WIDX), (h16*)(ws + WS_PROJB), p.kv_norm_g, p.idx_k_norm_g, p.idx_k_norm_b};
                 run_gemm(lds, (const h16*)(ws + WS_R2), (const h16*)(ws + WS_BT_IN), T, N_IN, 2048, bid, nb, E, WGM_G1); } SEAM(2);
    if (IN(3)) { phase_rows3(p, bid, nb); } SEAM(3);
    if (IN(4)) { EpiQ E{(h16*)(ws + WS_QABS), (h16*)(ws + WS_IQ), p.q_abs_norm_g, (const float*)(ws + WS_PROJA)}; run_gemm(lds, (const h16*)(ws + WS_CQ), (const h16*)(ws + WS_BT_Q), T, N_Q, 512, bid, nb, E, WGM_G2); } SEAM(4);
    if (IN(5)) { phase_index(p, lds, bid, nb); } SEAM(5);
    if (IN(6)) { phase_attn(p, lds, bid, nb); } SEAM(6);
    if (IN(7)) { phase_uv(p, lds, bid, nb); } SEAM(7);
    if (IN(8)) { EpiF16 E{(h16*)(ws + WS_Y6), nullptr}; run_gemm(lds, (const h16*)(ws + WS_R2), (const h16*)(ws + WS_BT_OUT), T, 2048, 2048, bid, nb, E, WGM_G6); } SEAM(8);
    if (IN(9)) { phase_normmod2(p, bid, nb); } SEAM(9);
    if (IN(10)) {
        LAS h16* bl = (LAS h16*)(lds + 131072 + 8192);
        __syncthreads();
        for (int i = threadIdx.x; i < D_FF / 4; i += NTHREADS) { const f32x4 b4 = *(const f32x4*)(p.b_mlp1 + 4 * i); *(LAS u32x2*)(bl + 4 * i) = pack_h4(b4); }
        __syncthreads();
        EpiMlp1 E{bl, (h16*)(ws + WS_R3)}; run_gemm(lds, (const h16*)(ws + WS_R2), (const h16*)(ws + WS_BT_1), T, D_FF, 2048, bid, nb, E, WGM_G7); } SEAM(10);
    if (IN(11)) { EpiF16 E{(h16*)(ws + WS_R2), p.b_mlp2}; run_gemm(lds, (const h16*)(ws + WS_R3), (const h16*)(ws + WS_BT_2), T, 2048, D_FF, bid, nb, E, WGM_G8); } SEAM(11);
    if (IN(12)) { phase_final(p, bid, nb); }
#undef IN
#undef SEAM
}

#ifndef N_LAUNCH_MODE
#define N_LAUNCH_MODE 1
#endif
extern "C" void kernel_launch(void* const* d_in, const int* in_sizes, int n_in, void* d_out, int out_size, void* d_ws, size_t ws_size, hipStream_t stream) {
    static int grid = 0;
    if (grid == 0) {
        if (ws_size < WS_END) { fprintf(stderr, "kernel_launch: workspace too small (%zu < %zu)\n", ws_size, (size_t)WS_END); grid = -1; return; }
        int dev = 0, cus = 0, per_cu = 0;
        hipGetDevice(&dev);
        hipDeviceGetAttribute(&cus, hipDeviceAttributeMultiprocessorCount, dev);
        if (hipFuncSetAttribute((const void*)fwd_kernel, hipFuncAttributeMaxDynamicSharedMemorySize, LDS_BYTES) != hipSuccess) { fprintf(stderr, "kernel_launch: hipFuncSetAttribute failed\n"); grid = -1; return; }
        hipOccupancyMaxActiveBlocksPerMultiprocessor(&per_cu, (const void*)fwd_kernel, NTHREADS, LDS_BYTES);
        if (per_cu < 1) { fprintf(stderr, "kernel_launch: occupancy query says %d\n", per_cu); per_cu = 1; }
        grid = cus;
        if (grid > 256) grid = 256;
    }
    if (grid < 0) return;
    Params p{};
    const float** f = (const float**)&p;
    for (int i = 0; i < 26; ++i) f[i] = (const float*)d_in[i];
    p.out = (float*)d_out; p.ws = (unsigned char*)d_ws;
#if N_LAUNCH_MODE == 1
    if (hipMemsetAsync((char*)d_ws + WS_CTL, 0, XCD_BAR_WORDS * 4, stream) != hipSuccess) { fprintf(stderr, "kernel_launch: memset failed\n"); return; }
    p.ph_lo = 0; p.ph_hi = NPHASES;
    void* args[] = {&p};
    hipError_t e = hipLaunchCooperativeKernel((const void*)fwd_kernel, dim3(grid), dim3(NTHREADS), args, LDS_BYTES, stream);
    if (e != hipSuccess) fprintf(stderr, "cooperative launch failed: %s (grid %d)\n", hipGetErrorString(e), grid);
#else
    for (int ph = 0; ph < 13; ++ph) {
        p.ph_lo = ph; p.ph_hi = ph + 1;
        hipLaunchKernelGGL(fwd_kernel, dim3(grid), dim3(NTHREADS), LDS_BYTES, stream, p);
    }
#endif
}
```

```cpp
#include <hip/hip_runtime.h>
#include <cstdio>
#include <cstdint>

#define LAS __attribute__((address_space(3)))
typedef _Float16 h16;
typedef _Float16 h16x8 __attribute__((ext_vector_type(8)));
typedef _Float16 h16x4 __attribute__((ext_vector_type(4)));
typedef _Float16 h16x2 __attribute__((ext_vector_type(2)));
typedef float f32x4 __attribute__((ext_vector_type(4)));
typedef float f32x2 __attribute__((ext_vector_type(2)));
typedef unsigned u32x4 __attribute__((ext_vector_type(4)));
typedef unsigned u32x2 __attribute__((ext_vector_type(2)));
typedef int i32x4 __attribute__((ext_vector_type(4)));

constexpr int D_MODEL = 2048, BATCH = 4, SEQ = 4096, T = BATCH * SEQ;
constexpr int ATTN_HEADS = 8, HEAD_DIM = 128, Q_LORA = 512, KV_LORA = 256, IDX_HEADS = 16, IDX_DIM = 64, TOPK = 256;
constexpr int CONV_WIDTH = 1024, D_FF = 8192, IN_COLS = 3920;
constexpr float EPS = 1e-6f;
constexpr int NTHREADS = 512, NWAVES = 8;
constexpr int N_IN = 4096;
constexpr int N_Q = 3072;

constexpr size_t MiB = (size_t)1 << 20;
constexpr size_t WS_CTL = 0;
constexpr size_t WS_MOD = 64 * 1024;
constexpr size_t WS_BT_IN = 1 * MiB;
constexpr size_t WS_BT_Q = WS_BT_IN + 16 * MiB;
constexpr size_t WS_BT_OUT = WS_BT_Q + 3 * MiB;
constexpr size_t WS_BT_1 = WS_BT_OUT + 8 * MiB;
constexpr size_t WS_BT_2 = WS_BT_1 + 32 * MiB;
constexpr size_t WS_WUVT = WS_BT_2 + 32 * MiB;
constexpr size_t WS_R2 = 93 * MiB;
constexpr size_t WS_R3 = WS_R2 + 64 * MiB;
constexpr size_t WS_PROJA = WS_R3;
constexpr size_t WS_PROJB = WS_R3 + 64 * MiB;
constexpr size_t WS_OLAT = WS_R3 + 64 * MiB;
constexpr size_t WS_QABS = WS_R3 + 160 * MiB;
constexpr size_t WS_IQ = WS_R3 + 224 * MiB;
constexpr size_t WS_R4 = WS_R3 + 256 * MiB;
constexpr size_t WS_CQ = WS_R4;
constexpr size_t WS_CKV = WS_CQ + 16 * MiB;
constexpr size_t WS_KIDX = WS_CKV + 8 * MiB;
constexpr size_t WS_WIDX = WS_KIDX + 2 * MiB;
constexpr size_t WS_SEL = WS_WIDX + 1 * MiB;
constexpr size_t WS_Y6 = WS_SEL + 8 * MiB;
constexpr size_t WS_END = WS_Y6 + 64 * MiB;

struct Params {
    const float *x, *c, *w_ada, *b_ada, *norm1_g, *norm2_g, *w_in, *cq_norm_g, *w_uq, *w_uk, *kv_norm_g, *q_abs_norm_g, *w_uv, *w_iq,
        *idx_k_norm_g, *idx_k_norm_b, *rel_bias, *conv_w, *conv_b, *attn_out_norm_g, *conv_out_norm_g, *w_out, *w_mlp1, *b_mlp1, *w_mlp2, *b_mlp2;
    float* out;
    unsigned char* ws;
    int ph_lo, ph_hi;
};

__device__ __forceinline__ float wave_sum(float v) {
#pragma unroll
    for (int o = 1; o < 64; o <<= 1) v += __shfl_xor(v, o);
    return v;
}
__device__ __forceinline__ float wave_max(float v) {
#pragma unroll
    for (int o = 1; o < 64; o <<= 1) v = fmaxf(v, __shfl_xor(v, o));
    return v;
}
#define LDS_WAIT() asm volatile("s_waitcnt lgkmcnt(0)" ::: "memory")

namespace pg8 {
constexpr int BM = 256, BK = 64, HALF = 128, HTB = HALF * BK * 2, STAGE_BYTES = 8 * HTB, NXCD = 8;
__host__ __device__ __forceinline__ int lds_byte(int r, int c) { const int st = (r >> 4) * 2 + (c >> 5), rr = r & 15, cc = c & 31, ob = rr * 64 + cc * 2; return st * 1024 + (ob ^ (((ob >> 9) & 1) << 5)); }
__host__ __device__ __forceinline__ int perm32(int rho) { const int n = rho >> 4, i = rho & 15; return 8 * (i >> 2) + 4 * n + (i & 3); }
__host__ __device__ __forceinline__ void stage_rc(int b, int& R, int& C) { const int st = b / 1024, sb = b % 1024, swz = sb ^ (((sb >> 9) & 1) << 5); R = (st >> 1) * 16 + swz / 64; C = (st & 1) * 32 + (swz % 64) / 2; }
struct Unit { int pm, pn; };
struct Gemm { const h16* A; const h16* Bt; int M, N, K; };
struct StaticOrder {
    int nM, nN, nwg, G, c, WGM;
    __host__ __device__ void init(int M, int N, int G_, int c_, int wgm) { nM = M / BM; nN = N / BM; nwg = nM * nN; G = G_; c = c_; WGM = wgm; }
    __host__ __device__ bool next(int i, Unit& u) const {
        const long L = (long)i * G + c; if (L >= nwg) return false;
        int wgid = (int)L; { const int q = nwg / NXCD, r = nwg % NXCD, xcd = wgid % NXCD, off = wgid / NXCD; wgid = (xcd < r ? xcd * (q + 1) : r * (q + 1) + (xcd - r) * q) + off; }
        const int nig = WGM * nN, gid = wgid / nig, fm = gid * WGM, gsz = (nM - fm) < WGM ? (nM - fm) : WGM;
        u.pm = fm + ((wgid % nig) % gsz); u.pn = (wgid % nig) / gsz; return true;
    }
};

#ifndef PG8_SP2
#define PG8_SP2 true
#endif
#ifndef PG8_ALIGN
#define PG8_ALIGN true
#endif
template <class Epi, bool ALIGN_EPI = PG8_ALIGN, bool SP2 = PG8_SP2>
__device__ __forceinline__ void gemm_phase(LAS unsigned char* lds, const Gemm g, const StaticOrder& S, const Epi& E) {
    const int tid = threadIdx.x, wid = __builtin_amdgcn_readfirstlane(tid >> 6), lane = tid & 63, wr = wid >> 2, wc = wid & 3, fr = lane & 15, fq = lane >> 4;
    const int K = g.K, nt = K / BK;
    unsigned voffA[2], voffB[2];
#pragma unroll
    for (int i = 0; i < 2; ++i) { int R, C; stage_rc(tid * 16 + i * 8192, R, C); const int Rb = Epi::PERM ? ((R & ~31) + perm32(R & 31)) : R; voffA[i] = (unsigned)(R * K + C) * 2u; voffB[i] = (unsigned)(Rb * K + C) * 2u; }
    const size_t kstep = (size_t)(BK * 2);
    const size_t hstep = (size_t)HALF * K * 2;
    const size_t tstep = 2 * hstep;
    const unsigned ldsw = (unsigned)wid * 1024u;
    const int aoff = lds_byte(wr * 64 + fr, fq * 8), boff = lds_byte(wc * 32 + fr, fq * 8);
#define PG8_SA(b, h) (((b) * 2 + (h)) * HTB)
#define PG8_SB(b, h) ((4 + (b) * 2 + (h)) * HTB)
#define PG8_STAGE(bufoff, gbase, voff) do { _Pragma("unroll") for (int _i = 0; _i < 2; ++_i) \
        __builtin_amdgcn_global_load_lds((const unsigned*)((const char*)(gbase) + (voff)[_i]), (LAS unsigned*)(lds + (bufoff) + ldsw + _i * 8192), 16, 0, 0); } while (0)
#define PG8_LDA(dst, b, h) do { _Pragma("unroll") for (int m = 0; m < 4; ++m) _Pragma("unroll") for (int k = 0; k < 2; ++k) dst[m][k] = *(const LAS h16x8*)(lds + PG8_SA(b, h) + aoff + m * 2048 + k * 1024); } while (0)
#define PG8_LDB(dst, b, h) do { _Pragma("unroll") for (int n = 0; n < 2; ++n) _Pragma("unroll") for (int k = 0; k < 2; ++k) dst[n][k] = *(const LAS h16x8*)(lds + PG8_SB(b, h) + boff + n * 2048 + k * 1024); } while (0)
#define PG8_MMA(ai, bj, At, Bt) do { __builtin_amdgcn_s_setprio(1); _Pragma("unroll") for (int m = 0; m < 4; ++m) _Pragma("unroll") for (int n = 0; n < 2; ++n) _Pragma("unroll") for (int k = 0; k < 2; ++k) \
        acc[ai][bj][m][n] = __builtin_amdgcn_mfma_f32_16x16x32_f16(Bt[n][k], At[m][k], acc[ai][bj][m][n], 0, 0, 0); __builtin_amdgcn_s_setprio(0); } while (0)
#define PG8_WAIT_V(n) asm volatile("s_waitcnt vmcnt(" #n ")" ::: "memory")
#define PG8_WAIT_L(n) asm volatile("s_waitcnt lgkmcnt(" #n ")" ::: "memory")
#define PG8_BAR __builtin_amdgcn_s_barrier()
#define PG8_SCHED __builtin_amdgcn_sched_barrier(0)
    Unit cur, nxt; int ui = 0;
    if (!S.next(0, cur)) return;
    f32x4 acc[2][2][4][2];
#pragma unroll
    for (int a = 0; a < 2; ++a)
#pragma unroll
        for (int b = 0; b < 2; ++b)
#pragma unroll
            for (int m = 0; m < 4; ++m)
#pragma unroll
                for (int n = 0; n < 2; ++n) acc[a][b][m][n] = (f32x4){0.f, 0.f, 0.f, 0.f};
    h16x8 At[4][2], B0[2][2], B1[2][2];
    const char* cA = (const char*)g.A + (size_t)cur.pm * tstep; const char* cB = (const char*)g.Bt + (size_t)cur.pn * tstep;
    if constexpr (SP2) {
        PG8_STAGE(PG8_SB(0, 0), cB, voffB); PG8_STAGE(PG8_SB(0, 1), cB + hstep, voffB); PG8_STAGE(PG8_SA(0, 0), cA, voffA); PG8_STAGE(PG8_SA(0, 1), cA + hstep, voffA);
        if (wr == 1) PG8_BAR;
        PG8_WAIT_V(2); PG8_BAR;
        PG8_STAGE(PG8_SB(1, 0), cB + kstep, voffB); PG8_STAGE(PG8_SA(1, 0), cA + kstep, voffA); PG8_STAGE(PG8_SB(1, 1), cB + hstep + kstep, voffB);
        PG8_WAIT_V(6); PG8_BAR;
    } else {
        PG8_STAGE(PG8_SB(0, 0), cB, voffB); PG8_STAGE(PG8_SA(0, 0), cA, voffA); PG8_STAGE(PG8_SB(0, 1), cB + hstep, voffB); PG8_STAGE(PG8_SA(0, 1), cA + hstep, voffA);
        if (wr == 1) PG8_BAR;
        PG8_WAIT_V(4); PG8_BAR;
        PG8_STAGE(PG8_SB(1, 0), cB + kstep, voffB); PG8_STAGE(PG8_SA(1, 0), cA + kstep, voffA); PG8_STAGE(PG8_SB(1, 1), cB + hstep + kstep, voffB);
        PG8_WAIT_V(6); PG8_BAR;
    }
    for (;;) {
        const bool has_next = S.next(ui + 1, nxt);
        const char* nA = has_next ? (const char*)g.A + (size_t)nxt.pm * tstep : cA; const char* nB = has_next ? (const char*)g.Bt + (size_t)nxt.pn * tstep : cB;
        for (int t = 0; t < nt; t += 2) {
            const bool last = (t == nt - 2);
            const char* a1 = cA + (size_t)(t + 1) * kstep;
            const char* a2 = last ? nA : cA + (size_t)(t + 2) * kstep; const char* b2 = last ? nB : cB + (size_t)(t + 2) * kstep;
            const char* a3 = a2 + kstep; const char* b3 = b2 + kstep;
            if constexpr (SP2) {
            PG8_LDB(B0, 0, 0); PG8_LDB(B1, 0, 1); PG8_SCHED; PG8_LDA(At, 0, 0); PG8_STAGE(PG8_SA(1, 1), a1 + hstep, voffA);
            PG8_WAIT_V(8); PG8_WAIT_L(0); PG8_BAR; PG8_MMA(0, 0, At, B0); PG8_MMA(0, 1, At, B1); PG8_BAR; PG8_SCHED;
            PG8_LDA(At, 0, 1); PG8_STAGE(PG8_SB(0, 0), b2, voffB); PG8_STAGE(PG8_SB(0, 1), b2 + hstep, voffB); PG8_STAGE(PG8_SA(0, 0), a2, voffA);
            PG8_WAIT_V(8); PG8_WAIT_L(0); PG8_BAR; PG8_MMA(1, 0, At, B0); PG8_MMA(1, 1, At, B1); PG8_BAR; PG8_SCHED;
            PG8_LDB(B0, 1, 0); PG8_LDB(B1, 1, 1); PG8_SCHED; PG8_LDA(At, 1, 0); PG8_STAGE(PG8_SA(0, 1), a2 + hstep, voffA);
            PG8_WAIT_V(8); PG8_WAIT_L(0); PG8_BAR; PG8_MMA(0, 0, At, B0); PG8_MMA(0, 1, At, B1); PG8_BAR; PG8_SCHED;
            PG8_LDA(At, 1, 1); PG8_STAGE(PG8_SB(1, 0), b3, voffB); PG8_STAGE(PG8_SB(1, 1), b3 + hstep, voffB); PG8_STAGE(PG8_SA(1, 0), a3, voffA);
            PG8_WAIT_V(8); PG8_WAIT_L(0); PG8_BAR; PG8_MMA(1, 0, At, B0); PG8_MMA(1, 1, At, B1); PG8_BAR; PG8_SCHED;
            } else {
            PG8_LDB(B0, 0, 0); PG8_SCHED; PG8_LDA(At, 0, 0); PG8_STAGE(PG8_SA(1, 1), a1 + hstep, voffA);
            PG8_WAIT_L(8); PG8_BAR; PG8_WAIT_L(0); PG8_MMA(0, 0, At, B0); PG8_BAR; PG8_SCHED;
            PG8_LDB(B1, 0, 1); PG8_STAGE(PG8_SB(0, 0), b2, voffB);
            PG8_BAR; PG8_WAIT_L(0); PG8_MMA(0, 1, At, B1); PG8_BAR;
            PG8_LDA(At, 0, 1); PG8_STAGE(PG8_SA(0, 0), a2, voffA);
            PG8_BAR; PG8_WAIT_L(0); PG8_MMA(1, 0, At, B0); PG8_BAR; PG8_SCHED;
            PG8_STAGE(PG8_SB(0, 1), b2 + hstep, voffB);
            PG8_WAIT_V(6); PG8_BAR; PG8_MMA(1, 1, At, B1); PG8_BAR;
            PG8_LDB(B0, 1, 0); PG8_SCHED; PG8_LDA(At, 1, 0); PG8_STAGE(PG8_SA(0, 1), a2 + hstep, voffA);
            PG8_WAIT_L(8); PG8_BAR; PG8_WAIT_L(0); PG8_MMA(0, 0, At, B0); PG8_BAR; PG8_SCHED;
            PG8_LDB(B1, 1, 1); PG8_STAGE(PG8_SB(1, 0), b3, voffB);
            PG8_BAR; PG8_WAIT_L(0); PG8_MMA(0, 1, At, B1); PG8_BAR;
            PG8_LDA(At, 1, 1); PG8_STAGE(PG8_SA(1, 0), a3, voffA);
            PG8_BAR; PG8_WAIT_L(0); PG8_MMA(1, 0, At, B0); PG8_BAR; PG8_SCHED;
            PG8_STAGE(PG8_SB(1, 1), b3 + hstep, voffB);
            PG8_WAIT_V(6); PG8_BAR; PG8_MMA(1, 1, At, B1); PG8_BAR;
            }
        }
        if constexpr (ALIGN_EPI) { if (wr == 0) PG8_BAR; }
        if constexpr (Epi::CUSTOM) { E.run(acc, cur, wr, wc, fr, fq, lds); }
        else if constexpr (Epi::PERM) {
            const int row0 = cur.pm * BM + wr * 64 + fr, col0 = cur.pn * BM + wc * 32 + 8 * fq;
            E.begin_unit(cur.pn, col0);
#pragma unroll
            for (int ai = 0; ai < 2; ++ai)
#pragma unroll
                for (int m = 0; m < 4; ++m)
#pragma unroll
                    for (int bj = 0; bj < 2; ++bj) E.store8(row0 + ai * HALF + m * 16, col0 + bj * HALF, acc[ai][bj][m][0], acc[ai][bj][m][1]);
        } else {
            const int row0 = cur.pm * BM + wr * 64 + fr, col0 = cur.pn * BM + wc * 32 + 4 * fq;
#pragma unroll
            for (int ai = 0; ai < 2; ++ai)
#pragma unroll
                for (int m = 0; m < 4; ++m)
#pragma unroll
                    for (int bj = 0; bj < 2; ++bj)
#pragma unroll
                        for (int n = 0; n < 2; ++n) E.store4(row0 + ai * HALF + m * 16, col0 + bj * HALF + n * 16, acc[ai][bj][m][n]);
        }
        if (!has_next) break;
#pragma unroll
        for (int a = 0; a < 2; ++a)
#pragma unroll
            for (int b = 0; b < 2; ++b)
#pragma unroll
                for (int m = 0; m < 4; ++m)
#pragma unroll
                    for (int n = 0; n < 2; ++n) acc[a][b][m][n] = (f32x4){0.f, 0.f, 0.f, 0.f};
        cur = nxt; cA = nA; cB = nB; ++ui;
        if constexpr (ALIGN_EPI) { if (wr == 1) PG8_BAR; }
    }
    PG8_WAIT_V(0);
    if constexpr (!ALIGN_EPI) { if (wr == 0) PG8_BAR; }
    PG8_BAR;
#undef PG8_SA
#undef PG8_SB
#undef PG8_STAGE
#undef PG8_LDA
#undef PG8_LDB
#undef PG8_MMA
#undef PG8_WAIT_V
#undef PG8_WAIT_L
#undef PG8_BAR
#undef PG8_SCHED
}

}

template <class Epi>
__device__ __forceinline__ void run_gemm(LAS unsigned char* lds, const h16* A, const h16* Bt, int M, int N, int K, int bid, int nb, const Epi& E, int wgm) {
    pg8::Gemm g{A, Bt, M, N, K};
    pg8::StaticOrder S; S.init(M, N, nb, bid, wgm);
    pg8::gemm_phase(lds, g, S, E);
}

__device__ __forceinline__ u32x2 pack_h4(f32x4 v) {
    h16x2 a = {(h16)v[0], (h16)v[1]}, b = {(h16)v[2], (h16)v[3]};
    u32x2 r; r.x = __builtin_bit_cast(unsigned, a); r.y = __builtin_bit_cast(unsigned, b); return r;
}

__device__ __forceinline__ u32x4 pack_h8(f32x4 a, f32x4 b) { const u32x2 x = pack_h4(a), y = pack_h4(b); return (u32x4){x.x, x.y, y.x, y.y}; }
struct EpiProj {
    static constexpr bool PERM = true, CUSTOM = true;
    h16* cq; float* ssq; h16* ckv; h16* kidx; float* widx; h16* projB; const float* gkv; const float* gk; const float* bk;
    __device__ __forceinline__ void run(const f32x4 (&acc)[2][2][4][2], const pg8::Unit& u, int wr, int wc, int fr, int fq, LAS unsigned char* lds) const {
        const int row0 = u.pm * 256 + wr * 64 + fr, cin = wc * 32 + 8 * fq;
        if (u.pn >= 4) {
            h16* base = projB + (size_t)row0 * 3072 + (u.pn - 4) * 256 + cin;
#pragma unroll
            for (int ai = 0; ai < 2; ++ai)
#pragma unroll
                for (int m = 0; m < 4; ++m)
#pragma unroll
                    for (int bj = 0; bj < 2; ++bj) *(u32x4*)(base + (size_t)(ai * 128 + m * 16) * 3072 + bj * 128) = pack_h8(acc[ai][bj][m][0], acc[ai][bj][m][1]);
            return;
        }
        LAS float* P = (LAS float*)(lds + 131072);
        if (u.pn == 3) {
            if (wc < 2) {
#pragma unroll
                for (int ai = 0; ai < 2; ++ai)
#pragma unroll
                    for (int m = 0; m < 4; ++m) {
                        const f32x4 a = acc[ai][0][m][0], b = acc[ai][0][m][1];
                        float sm = (a[0] + a[1]) + (a[2] + a[3]) + (b[0] + b[1]) + (b[2] + b[3]);
                        float sq = (a[0] * a[0] + a[1] * a[1]) + (a[2] * a[2] + a[3] * a[3]) + (b[0] * b[0] + b[1] * b[1]) + (b[2] * b[2] + b[3] * b[3]);
                        sm += __shfl_xor(sm, 16); sm += __shfl_xor(sm, 32); sq += __shfl_xor(sq, 16); sq += __shfl_xor(sq, 32);
                        if (fq == 0) *(LAS f32x2*)(P + ((ai * 128 + wr * 64 + m * 16 + fr) * 2 + wc) * 2) = (f32x2){sm, sq};
                    }
            }
            asm volatile("s_waitcnt lgkmcnt(0)" ::: "memory"); __builtin_amdgcn_s_barrier(); asm volatile("" ::: "memory");
            if (wc < 2) {
                const f32x4 g0 = *(const f32x4*)(gk + cin), g1 = *(const f32x4*)(gk + cin + 4), b0 = *(const f32x4*)(bk + cin), b1 = *(const f32x4*)(bk + cin + 4);
#pragma unroll
                for (int ai = 0; ai < 2; ++ai)
#pragma unroll
                    for (int m = 0; m < 4; ++m) {
                        const f32x4 pp = *(const LAS f32x4*)(P + (ai * 128 + wr * 64 + m * 16 + fr) * 4);
                        const float mean = (pp[0] + pp[2]) * (1.f / 64.f);
                        const f32x4 xa = acc[ai][0][m][0] - mean, xb = acc[ai][0][m][1] - mean;
                        const float var = fmaxf((pp[1] + pp[3]) * (1.f / 64.f) - mean * mean, 0.f);
                        const float rstd = rsqrtf(var + EPS);
                        *(u32x4*)(kidx + (size_t)(row0 + ai * 128 + m * 16) * 64 + cin) = pack_h8(xa * rstd * g0 + b0, xb * rstd * g1 + b1);
                    }
            } else if (wc == 2 && fq < 2) {
#pragma unroll
                for (int ai = 0; ai < 2; ++ai)
#pragma unroll
                    for (int m = 0; m < 4; ++m) {
                        float* o = widx + (size_t)(row0 + ai * 128 + m * 16) * 16 + 8 * fq;
                        *(f32x4*)o = acc[ai][0][m][0] * (1.f / 32.f); *(f32x4*)(o + 4) = acc[ai][0][m][1] * (1.f / 32.f);
                    }
            }
            return;
        }
#pragma unroll
        for (int ai = 0; ai < 2; ++ai)
#pragma unroll
            for (int m = 0; m < 4; ++m) {
                float ss = 0.f;
#pragma unroll
                for (int bj = 0; bj < 2; ++bj)
#pragma unroll
                    for (int n = 0; n < 2; ++n) { const f32x4 v = acc[ai][bj][m][n]; ss += (v[0] * v[0] + v[1] * v[1]) + (v[2] * v[2] + v[3] * v[3]); }
                ss += __shfl_xor(ss, 16); ss += __shfl_xor(ss, 32);
                if (fq == 0) P[(ai * 128 + wr * 64 + m * 16 + fr) * 4 + wc] = ss;
            }
        asm volatile("s_waitcnt lgkmcnt(0)" ::: "memory"); __builtin_amdgcn_s_barrier(); asm volatile("" ::: "memory");
        if (u.pn < 2) {
            h16* base = cq + (size_t)row0 * 512 + u.pn * 256 + cin;
#pragma unroll
            for (int ai = 0; ai < 2; ++ai)
#pragma unroll
                for (int m = 0; m < 4; ++m) {
#pragma unroll
                    for (int bj = 0; bj < 2; ++bj) *(u32x4*)(base + (size_t)(ai * 128 + m * 16) * 512 + bj * 128) = pack_h8(acc[ai][bj][m][0], acc[ai][bj][m][1]);
                    if (wc == 0 && fq == 0) { const f32x4 pp = *(const LAS f32x4*)(P + (ai * 128 + wr * 64 + m * 16 + fr) * 4); ssq[(size_t)(row0 + ai * 128 + m * 16) * 2 + u.pn] = (pp[0] + pp[1]) + (pp[2] + pp[3]); }
                }
        } else {
            h16* base = ckv + (size_t)row0 * 256 + cin;
            f32x4 g[2][2];
#pragma unroll
            for (int bj = 0; bj < 2; ++bj)
#pragma unroll
                for (int n = 0; n < 2; ++n) g[bj][n] = *(const f32x4*)(gkv + cin + bj * 128 + 4 * n);
#pragma unroll
            for (int ai = 0; ai < 2; ++ai)
#pragma unroll
                for (int m = 0; m < 4; ++m) {
                    const f32x4 pp = *(const LAS f32x4*)(P + (ai * 128 + wr * 64 + m * 16 + fr) * 4);
                    const float rstd = rsqrtf(((pp[0] + pp[1]) + (pp[2] + pp[3])) * (1.f / 256.f) + EPS);
#pragma unroll
                    for (int bj = 0; bj < 2; ++bj) *(u32x4*)(base + (size_t)(ai * 128 + m * 16) * 256 + bj * 128) = pack_h8(acc[ai][bj][m][0] * rstd * g[bj][0], acc[ai][bj][m][1] * rstd * g[bj][1]);
                }
        }
    }
};
struct EpiQ {
    static constexpr bool PERM = true, CUSTOM = true;
    h16* qabs; h16* iq; const float* gq; const float* ssq;
    __device__ __forceinline__ void run(const f32x4 (&acc)[2][2][4][2], const pg8::Unit& u, int wr, int wc, int fr, int fq, LAS unsigned char* lds) const {
        const int row0 = u.pm * 256 + wr * 64 + fr, cin = wc * 32 + 8 * fq;
        float rr[2][4];
#pragma unroll
        for (int ai = 0; ai < 2; ++ai)
#pragma unroll
            for (int m = 0; m < 4; ++m) { const f32x2 s2 = *(const f32x2*)(ssq + (size_t)(row0 + ai * 128 + m * 16) * 2); rr[ai][m] = rsqrtf((s2[0] + s2[1]) * (1.f / 512.f) + EPS); }
        if (u.pn >= 8) {
            h16* base = iq + (size_t)row0 * 1024 + (u.pn - 8) * 256 + cin;
#pragma unroll
            for (int ai = 0; ai < 2; ++ai)
#pragma unroll
                for (int m = 0; m < 4; ++m)
#pragma unroll
                    for (int bj = 0; bj < 2; ++bj) *(u32x4*)(base + (size_t)(ai * 128 + m * 16) * 1024 + bj * 128) = pack_h8(acc[ai][bj][m][0] * rr[ai][m], acc[ai][bj][m][1] * rr[ai][m]);
            return;
        }
        LAS float* P = (LAS float*)(lds + 131072);
#pragma unroll
        for (int ai = 0; ai < 2; ++ai)
#pragma unroll
            for (int m = 0; m < 4; ++m) {
                float ss = 0.f;
#pragma unroll
                for (int bj = 0; bj < 2; ++bj)
#pragma unroll
                    for (int n = 0; n < 2; ++n) { const f32x4 v = acc[ai][bj][m][n]; ss += (v[0] * v[0] + v[1] * v[1]) + (v[2] * v[2] + v[3] * v[3]); }
                ss += __shfl_xor(ss, 16); ss += __shfl_xor(ss, 32);
                if (fq == 0) P[(ai * 128 + wr * 64 + m * 16 + fr) * 4 + wc] = ss * (rr[ai][m] * rr[ai][m]);
            }
        asm volatile("s_waitcnt lgkmcnt(0)" ::: "memory"); __builtin_amdgcn_s_barrier(); asm volatile("" ::: "memory");
        h16* base = qabs + (size_t)row0 * 2048 + u.pn * 256 + cin;
        f32x4 g[2][2];
#pragma unroll
        for (int bj = 0; bj < 2; ++bj)
#pragma unroll
            for (int n = 0; n < 2; ++n) g[bj][n] = *(const f32x4*)(gq + cin + bj * 128 + 4 * n) * 0.0625f;
#pragma unroll
        for (int ai = 0; ai < 2; ++ai)
#pragma unroll
            for (int m = 0; m < 4; ++m) {
                const f32x4 pp = *(const LAS f32x4*)(P + (ai * 128 + wr * 64 + m * 16 + fr) * 4);
                const float rstd = rsqrtf(((pp[0] + pp[1]) + (pp[2] + pp[3])) * (1.f / 256.f) + EPS) * rr[ai][m];
#pragma unroll
                for (int bj = 0; bj < 2; ++bj) *(u32x4*)(base + (size_t)(ai * 128 + m * 16) * 2048 + bj * 128) = pack_h8(acc[ai][bj][m][0] * rstd * g[bj][0], acc[ai][bj][m][1] * rstd * g[bj][1]);
            }
    }
};
struct EpiF16 {
    static constexpr bool PERM = true, CUSTOM = false;
    h16* o; const float* bias; mutable f32x4 bz[2][2]; mutable int cbase;
    __device__ __forceinline__ void begin_unit(int, int col0) const {
        cbase = col0;
#pragma unroll
        for (int bj = 0; bj < 2; ++bj)
#pragma unroll
            for (int n = 0; n < 2; ++n) bz[bj][n] = bias ? *(const f32x4*)(bias + col0 + bj * 128 + 4 * n) : (f32x4){0.f, 0.f, 0.f, 0.f};
    }
    __device__ __forceinline__ void store8(int row, int col, f32x4 v0, f32x4 v1) const {
        const int bj = (col - cbase) >> 7;
        *(u32x4*)(o + (size_t)row * 2048 + col) = pack_h8(v0 + (bj ? bz[1][0] : bz[0][0]), v1 + (bj ? bz[1][1] : bz[0][1]));
    }
};
struct EpiMlp1 {
    static constexpr bool PERM = true, CUSTOM = false;
    LAS const h16* b1l; h16* a; mutable f32x4 bz[2][2]; mutable int cbase;
    __device__ __forceinline__ void begin_unit(int, int col0) const {
        cbase = col0;
#pragma unroll
        for (int bj = 0; bj < 2; ++bj)
#pragma unroll
            for (int n = 0; n < 2; ++n) { const h16x4 hb = *(LAS const h16x4*)(b1l + col0 + bj * 128 + 4 * n); bz[bj][n] = (f32x4){(float)hb[0], (float)hb[1], (float)hb[2], (float)hb[3]}; }
    }
    __device__ __forceinline__ f32x4 actb(f32x4 v, f32x4 b) const {
        f32x4 z = v + b;
#pragma unroll
        for (int j = 0; j < 4; ++j) { const float r = fmaxf(z[j], 0.f); z[j] = r * r; }
        return z;
    }
    __device__ __forceinline__ void store8(int row, int col, f32x4 v0, f32x4 v1) const {
        const int bj = (col - cbase) >> 7;
        *(u32x4*)(a + (size_t)row * D_FF + col) = pack_h8(actb(v0, bj ? bz[1][0] : bz[0][0]), actb(v1, bj ? bz[1][1] : bz[0][1]));
    }
};
template <bool SCALE>
__device__ __forceinline__ void transpose_item(const float* __restrict__ src, int ld, int k0, int n0, int nvalid, const float* __restrict__ kscale,
                                               h16* __restrict__ dst, int dst_ld, int dst_row0, int dst_k0, LAS float* scr, int lane) {
    const int n = lane & 31, nn = n < nvalid ? n : nvalid - 1;
    const float msk = n < nvalid ? 1.f : 0.f;
    const float* sp = src + (size_t)(k0 + (lane >> 5)) * ld + n0 + nn;
    float v[32];
#pragma unroll
    for (int i = 0; i < 32; ++i) v[i] = sp[(size_t)(2 * i) * ld];
    if (SCALE) {
        float sc[32];
#pragma unroll
        for (int i = 0; i < 32; ++i) sc[i] = kscale[k0 + 2 * i + (lane >> 5)];
#pragma unroll
        for (int i = 0; i < 32; ++i) v[i] *= sc[i];
    }
#pragma unroll
    for (int i = 0; i < 32; ++i) scr[(2 * i + (lane >> 5)) * 33 + n] = v[i] * msk;
    LDS_WAIT(); asm volatile("" ::: "memory");
    const int c = lane & 7;
#pragma unroll
    for (int j = 0; j < 4; ++j) {
        const int nr = (lane >> 3) + 8 * j; const LAS float* s = scr + (8 * c) * 33 + nr;
        h16x8 o;
#pragma unroll
        for (int q = 0; q < 8; ++q) o[q] = (h16)s[q * 33];
        *(h16x8*)(dst + (size_t)(dst_row0 + nr) * dst_ld + dst_k0 + 8 * c) = o;
    }
    LDS_WAIT(); asm volatile("" ::: "memory");
}

__device__ __forceinline__ void phase_prep(const Params& p, LAS unsigned char* lds, int bid, int nb) {
    const int tid = threadIdx.x, lane = tid & 63, wave = tid >> 6;
    unsigned char* ws = p.ws;
    __syncthreads();
    {
        LAS f32x4* cact = (LAS f32x4*)lds;
        LAS float* red = (LAS float*)(lds + 32768);
        for (int i = tid; i < 4 * 2048; i += NTHREADS) { const int b = i >> 11, k = i & 2047; const float v = p.c[b * 2048 + k]; ((LAS float*)cact)[k * 4 + b] = v / (1.f + __expf(-v)); }
        __syncthreads();
        float* mod = (float*)(ws + WS_MOD);
        for (int cgp = bid; cgp < 192; cgp += nb) {
            const int col = cgp * 64 + lane;
            float a0 = 0.f, a1 = 0.f, a2 = 0.f, a3 = 0.f;
            const float* wp = p.w_ada + (size_t)(wave * 256) * 12288 + col;
            for (int kb = 0; kb < 256; kb += 32) {
                float wv[32];
#pragma unroll
                for (int j = 0; j < 32; ++j) wv[j] = wp[(size_t)(kb + j) * 12288];
#pragma unroll
                for (int j = 0; j < 32; ++j) { const f32x4 cv = cact[wave * 256 + kb + j]; a0 += cv[0] * wv[j]; a1 += cv[1] * wv[j]; a2 += cv[2] * wv[j]; a3 += cv[3] * wv[j]; }
            }
            red[(wave * 4 + 0) * 64 + lane] = a0; red[(wave * 4 + 1) * 64 + lane] = a1; red[(wave * 4 + 2) * 64 + lane] = a2; red[(wave * 4 + 3) * 64 + lane] = a3;
            __syncthreads();
            if (tid < 256) {
                const int b = tid >> 6, l = tid & 63; float s = 0.f;
#pragma unroll
                for (int w = 0; w < 8; ++w) s += red[(w * 4 + b) * 64 + l];
                const int cc = cgp * 64 + l;
                mod[b * 12288 + cc] = s + p.b_ada[cc];
            }
            __syncthreads();
        }
    }
    LAS float* scr = (LAS float*)(lds + wave * 16384);
    const int gw = bid * NWAVES + wave, NGW = nb * NWAVES;
    constexpr int I_IN = 32 * 128, I_1 = 32 * 256, I_2 = 128 * 64, I_OUT = 32 * 64, I_IQ = 8 * 32, I_UV = 8 * 4 * 4, I_QA = 8 * 8 * 8;
    constexpr int NITEMS = I_IN + I_1 + I_2 + I_OUT + I_IQ + I_UV + I_QA;
    const bool bal = (nb == 256);
    const int nextra = bal ? 6 : 0, base_it = bal ? 3072 : 0;
    const int nstr = (NITEMS - I_QA - base_it - gw + NGW - 1) / NGW;
    for (int kk = 0; kk < nextra + nstr; ++kk) {
        int it;
        if (kk < nextra) { if (bid < 192) continue; it = ((bid - 192) * NWAVES + wave) + 512 * kk; }
        else it = base_it + gw + (kk - nextra) * NGW;
        int r = it;
        const float* src; int ld, k0, n0, nvalid = 32, dld, drow0; const float* ksc = nullptr; h16* dst;
        if (r < I_IN) {
            const int kb = r / 128, nbk = r % 128, n0d = nbk * 32;
            if (n0d >= 864 && n0d < 1024) continue;
            src = p.w_in; ld = IN_COLS; k0 = kb * 64; n0 = n0d < 1024 ? n0d : n0d - 176; nvalid = (n0d == 832) ? 16 : 32; dst = (h16*)(ws + WS_BT_IN); dld = 2048; drow0 = n0d;
        } else if ((r -= I_IN) < I_1) { const int kb = r / 256, nbk = r % 256; src = p.w_mlp1; ld = D_FF; k0 = kb * 64; n0 = nbk * 32; dst = (h16*)(ws + WS_BT_1); dld = 2048; drow0 = n0; }
        else if ((r -= I_1) < I_2) { const int kb = r / 64, nbk = r % 64; src = p.w_mlp2; ld = 2048; k0 = kb * 64; n0 = nbk * 32; dst = (h16*)(ws + WS_BT_2); dld = 8192; drow0 = n0; }
        else if ((r -= I_2) < I_OUT) { const int kb = r / 64, nbk = r % 64; src = p.w_out; ld = 2048; k0 = kb * 64; n0 = nbk * 32; dst = (h16*)(ws + WS_BT_OUT); dld = 2048; drow0 = n0; }
        else if ((r -= I_OUT) < I_IQ) { const int kb = r / 32, nbk = r % 32; src = p.w_iq; ld = 1024; k0 = kb * 64; n0 = nbk * 32; ksc = p.cq_norm_g; dst = (h16*)(ws + WS_BT_Q); dld = 512; drow0 = 2048 + n0; }
        else { r -= I_IQ; const int h = r / 16, kb = (r % 16) / 4, nbk = r % 4; src = p.w_uv + (size_t)h * 256 * 128; ld = 128; k0 = kb * 64; n0 = nbk * 32; dst = (h16*)(ws + WS_WUVT) + (size_t)h * 128 * 256; dld = 256; drow0 = n0; }
        if (ksc) transpose_item<true>(src, ld, k0, n0, nvalid, ksc, dst, dld, drow0, k0, scr, lane);
        else transpose_item<false>(src, ld, k0, n0, nvalid, ksc, dst, dld, drow0, k0, scr, lane);
    }
    for (int r = gw; r < I_QA; r += NGW) {
        {
            const int h = r / 64, kb = (r % 64) / 8, cb = r % 8, k0 = kb * 64, c0 = cb * 32;
#pragma unroll 8
            for (int e = lane; e < 128 * 32; e += 64) { const int d = e >> 5, c = e & 31; scr[e] = p.w_uk[((size_t)h * 128 + d) * 256 + c0 + c]; }
            LDS_WAIT(); asm volatile("" ::: "memory");
            float acc[32];
#pragma unroll
            for (int c = 0; c < 32; ++c) acc[c] = 0.f;
            const float* uq = p.w_uq + (size_t)(k0 + lane) * 1024 + h * 128;
#pragma unroll 1
            for (int d0 = 0; d0 < 128; d0 += 4) {
                const f32x4 a = *(const f32x4*)(uq + d0);
#pragma unroll
                for (int dd = 0; dd < 4; ++dd) {
#pragma unroll
                    for (int c4 = 0; c4 < 8; ++c4) { const f32x4 w = *(const LAS f32x4*)(scr + (d0 + dd) * 32 + c4 * 4);
                        acc[c4 * 4 + 0] += a[dd] * w[0]; acc[c4 * 4 + 1] += a[dd] * w[1]; acc[c4 * 4 + 2] += a[dd] * w[2]; acc[c4 * 4 + 3] += a[dd] * w[3]; }
                    asm volatile("" ::: "memory");
                }
            }
            const float gk = p.cq_norm_g[k0 + lane];
            h16* dst = (h16*)(ws + WS_BT_Q);
            h16* dp = dst + (size_t)(h * 256 + c0) * 512 + k0 + lane;
#pragma unroll
            for (int c = 0; c < 32; ++c) { dp[(size_t)c * 512] = (h16)(acc[c] * gk); if ((c & 3) == 3) asm volatile("" ::: "memory"); }
            LDS_WAIT(); asm volatile("" ::: "memory");
        }
    }
    {
        u32x4* z = (u32x4*)((h16*)(ws + WS_BT_IN) + (size_t)848 * 2048);
        const int n16 = 176 * 2048 * 2 / 16;
        for (int i = bid * NTHREADS + tid; i < n16; i += nb * NTHREADS) z[i] = (u32x4){0u, 0u, 0u, 0u};
    }
}

__device__ __forceinline__ void phase_normmod(const float* __restrict__ xin, const float* __restrict__ g, const float* __restrict__ mod, int sh_off, int sc_off, h16* __restrict__ hout, int bid, int nb) {
    const int tid = threadIdx.x, lane = tid & 63, wave = tid >> 6;
    for (int t = bid * NWAVES + wave; t < T; t += nb * NWAVES) {
        const int b = t >> 12;
        const f32x4* xr = (const f32x4*)(xin + (size_t)t * 2048) + lane;
        f32x4 v[8]; float ss = 0.f;
#pragma unroll
        for (int j = 0; j < 8; ++j) { v[j] = xr[64 * j]; ss += (v[j][0] * v[j][0] + v[j][1] * v[j][1]) + (v[j][2] * v[j][2] + v[j][3] * v[j][3]); }
        const float rstd = rsqrtf(wave_sum(ss) * (1.f / 2048.f) + EPS);
        const float* mb = mod + b * 12288;
        u32x2* o = (u32x2*)(hout + (size_t)t * 2048) + lane;
#pragma unroll
        for (int j = 0; j < 8; ++j) {
            const int d = (lane + 64 * j) * 4;
            const f32x4 gg = *(const f32x4*)(g + d), sc = *(const f32x4*)(mb + sc_off + d), sh = *(const f32x4*)(mb + sh_off + d);
            f32x4 y = (v[j] * rstd) * gg;
            y = y * (sc + 1.f) + sh;
            o[64 * j] = pack_h4(y);
        }
    }
}

__device__ __forceinline__ void phase_normmod2(const Params& p, int bid, int nb) {
    const int tid = threadIdx.x, lane = tid & 63, wave = tid >> 6;
    const float* mod = (const float*)(p.ws + WS_MOD); const h16* y6 = (const h16*)(p.ws + WS_Y6); h16* hout = (h16*)(p.ws + WS_R2);
    for (int t = bid * NWAVES + wave; t < T; t += nb * NWAVES) {
        const int b = t >> 12; const float* mb = mod + b * 12288;
        const f32x4* xr = (const f32x4*)(p.x + (size_t)t * 2048) + lane;
        const u32x2* yr = (const u32x2*)(y6 + (size_t)t * 2048) + lane;
        f32x4 v[8]; float ss = 0.f;
#pragma unroll
        for (int j = 0; j < 8; ++j) {
            const int d = (lane + 64 * j) * 4;
            const f32x4 xv = xr[64 * j]; const h16x4 yh = __builtin_bit_cast(h16x4, yr[64 * j]); const f32x4 g1 = *(const f32x4*)(mb + 2 * 2048 + d);
            const f32x4 yv = {(float)yh[0], (float)yh[1], (float)yh[2], (float)yh[3]};
            v[j] = xv + g1 * yv;
            ss += (v[j][0] * v[j][0] + v[j][1] * v[j][1]) + (v[j][2] * v[j][2] + v[j][3] * v[j][3]);
        }
        const float rstd = rsqrtf(wave_sum(ss) * (1.f / 2048.f) + EPS);
        u32x2* o = (u32x2*)(hout + (size_t)t * 2048) + lane;
#pragma unroll
        for (int j = 0; j < 8; ++j) {
            const int d = (lane + 64 * j) * 4;
            const f32x4 gg = *(const f32x4*)(p.norm2_g + d), sc = *(const f32x4*)(mb + 4 * 2048 + d), sh = *(const f32x4*)(mb + 3 * 2048 + d);
            f32x4 y = (v[j] * rstd) * gg;
            y = y * (sc + 1.f) + sh;
            o[64 * j] = pack_h4(y);
        }
    }
}
__device__ __forceinline__ void phase_final(const Params& p, int bid, int nb) {
    const int tid = threadIdx.x, lane = tid & 63, wave = tid >> 6;
    const float* mod = (const float*)(p.ws + WS_MOD); const h16* y6 = (const h16*)(p.ws + WS_Y6); const h16* m16 = (const h16*)(p.ws + WS_R2);
    for (int t = bid * NWAVES + wave; t < T; t += nb * NWAVES) {
        const int b = t >> 12; const float* mb = mod + b * 12288;
        const f32x4* xr = (const f32x4*)(p.x + (size_t)t * 2048) + lane;
        const u32x2* yr = (const u32x2*)(y6 + (size_t)t * 2048) + lane;
        const u32x2* mr = (const u32x2*)(m16 + (size_t)t * 2048) + lane;
        f32x4* orow = (f32x4*)(p.out + (size_t)t * 2048) + lane;
#pragma unroll
        for (int j = 0; j < 8; ++j) {
            const int d = (lane + 64 * j) * 4;
            const f32x4 xv = xr[64 * j]; const h16x4 yh = __builtin_bit_cast(h16x4, yr[64 * j]), mh = __builtin_bit_cast(h16x4, mr[64 * j]);
            const f32x4 g1 = *(const f32x4*)(mb + 2 * 2048 + d), g2 = *(const f32x4*)(mb + 5 * 2048 + d);
            const f32x4 yv = {(float)yh[0], (float)yh[1], (float)yh[2], (float)yh[3]}, mv = {(float)mh[0], (float)mh[1], (float)mh[2], (float)mh[3]};
            orow[64 * j] = (xv + g1 * yv) + g2 * mv;
        }
    }
}

__device__ __forceinline__ void phase_rows3(const Params& p, int bid, int nb) {
    const int tid = threadIdx.x, lane = tid & 63, wave = tid >> 6;
    unsigned char* ws = p.ws;
    const h16* projB = (const h16*)(ws + WS_PROJB);
    h16* ymix = (h16*)(ws + WS_R2);
    f32x4 w0[4], w1[4], w2[4], bb[4], gn[4];
#pragma unroll
    for (int q4 = 0; q4 < 4; ++q4) {
        const int c = lane * 16 + q4 * 4;
        w0[q4] = *(const f32x4*)(p.conv_w + c); w1[q4] = *(const f32x4*)(p.conv_w + 1024 + c); w2[q4] = *(const f32x4*)(p.conv_w + 2048 + c);
        bb[q4] = *(const f32x4*)(p.conv_b + c); gn[q4] = *(const f32x4*)(p.conv_out_norm_g + c);
    }
    for (int t = bid * NWAVES + wave; t < T; t += nb * NWAVES) {
        const int tl = t & (SEQ - 1);
        const h16* pb = projB + (size_t)t * 3072 + lane * 16;
        const int d1 = tl >= 1 ? 1 : 0, d2 = tl >= 2 ? 2 : 0;
        const float m1 = tl >= 1 ? 1.f : 0.f, m2 = tl >= 2 ? 1.f : 0.f;
        h16x8 gbv[2], cv[3][2], hv[3][2];
#pragma unroll
        for (int hh = 0; hh < 2; ++hh) {
            gbv[hh] = *(const h16x8*)(pb + hh * 8);
            cv[2][hh] = *(const h16x8*)(pb + 1024 + hh * 8); hv[2][hh] = *(const h16x8*)(pb + 2048 + hh * 8);
            cv[1][hh] = *(const h16x8*)(pb - (size_t)d1 * 3072 + 1024 + hh * 8); hv[1][hh] = *(const h16x8*)(pb - (size_t)d1 * 3072 + 2048 + hh * 8);
            cv[0][hh] = *(const h16x8*)(pb - (size_t)d2 * 3072 + 1024 + hh * 8); hv[0][hh] = *(const h16x8*)(pb - (size_t)d2 * 3072 + 2048 + hh * 8);
        }
        float y[16], ss = 0.f;
#pragma unroll
        for (int i = 0; i < 16; ++i) {
            const int hh = i >> 3, q = i & 7, q4 = i >> 2, qq = i & 3;
            const float u0 = (float)cv[0][hh][q] * (float)hv[0][hh][q] * m2, u1 = (float)cv[1][hh][q] * (float)hv[1][hh][q] * m1, u2 = (float)cv[2][hh][q] * (float)hv[2][hh][q];
            float sacc = bb[q4][qq] + w0[q4][qq] * u0; sacc = sacc + w1[q4][qq] * u1; sacc = sacc + w2[q4][qq] * u2;
            y[i] = (float)gbv[hh][q] * sacc; ss += y[i] * y[i];
        }
        ss += __shfl_xor(ss, 1); ss += __shfl_xor(ss, 2); ss += __shfl_xor(ss, 4);
        const float rstd = rsqrtf(ss * (1.f / 128.f) + EPS);
        h16x8 o0, o1;
#pragma unroll
        for (int q = 0; q < 8; ++q) { o0[q] = (h16)(y[q] * rstd * gn[q >> 2][q & 3]); o1[q] = (h16)(y[8 + q] * rstd * gn[2 + (q >> 2)][q & 3]); }
        *(h16x8*)(ymix + (size_t)t * 2048 + 1024 + lane * 16) = o0;
        *(h16x8*)(ymix + (size_t)t * 2048 + 1024 + lane * 16 + 8) = o1;
    }
}

__constant__ unsigned char c_bucket_thr[15] = {19, 21, 24, 27, 31, 35, 40, 46, 52, 59, 67, 77, 87, 99, 113};
__device__ __forceinline__ int t5_bucket(int n) {
    if (n < 16) return n;
    int bkt = 16;
#pragma unroll
    for (int i = 0; i < 15; ++i) bkt += (n >= (int)c_bucket_thr[i]) ? 1 : 0;
    return bkt;
}
typedef float f32x16 __attribute__((ext_vector_type(16)));
__device__ __forceinline__ float next_up(float x) {
    const unsigned u = __float_as_uint(x);
    if ((u << 1) == 0u) return __uint_as_float(1u);
    return __uint_as_float((u >> 31) ? u - 1u : u + 1u);
}
__device__ __forceinline__ float qinv_upper(float p) {
    const float pt = p < 0.5f ? p : 1.f - p;
    const float tt = sqrtf(-2.f * __logf(fmaxf(pt, 1e-7f)));
    const float z = tt - (2.515517f + tt * (0.802853f + tt * 0.010328f)) / (1.f + tt * (1.432788f + tt * (0.189269f + tt * 0.001308f)));
    return p < 0.5f ? z : -z;
}
__device__ __forceinline__ int wave_sum_dpp(int x) {
    x += __builtin_amdgcn_update_dpp(0, x, 0xB1, 0xf, 0xf, false);
    x += __builtin_amdgcn_update_dpp(0, x, 0x4E, 0xf, 0xf, false);
    x += __builtin_amdgcn_update_dpp(0, x, 0x124, 0xf, 0xf, false);
    x += __builtin_amdgcn_update_dpp(0, x, 0x128, 0xf, 0xf, false);
    return (__builtin_amdgcn_readlane(x, 0) + __builtin_amdgcn_readlane(x, 16)) + (__builtin_amdgcn_readlane(x, 32) + __builtin_amdgcn_readlane(x, 48));
}
__device__ __forceinline__ float dpp_f(float v, const int ctrl_sel) {
    const int i = __float_as_int(v);
    int r;
    if (ctrl_sel == 0) r = __builtin_amdgcn_update_dpp(i, i, 0xB1, 0xf, 0xf, false);
    else if (ctrl_sel == 1) r = __builtin_amdgcn_update_dpp(i, i, 0x4E, 0xf, 0xf, false);
    else if (ctrl_sel == 2) r = __builtin_amdgcn_update_dpp(i, i, 0x124, 0xf, 0xf, false);
    else r = __builtin_amdgcn_update_dpp(i, i, 0x128, 0xf, 0xf, false);
    return __int_as_float(r);
}
__device__ __forceinline__ float wave_sum_f_dpp(float v) {
    v += dpp_f(v, 0); v += dpp_f(v, 1); v += dpp_f(v, 2); v += dpp_f(v, 3);
    const float a = __int_as_float(__builtin_amdgcn_readlane(__float_as_int(v), 0)), b = __int_as_float(__builtin_amdgcn_readlane(__float_as_int(v), 16));
    const float c = __int_as_float(__builtin_amdgcn_readlane(__float_as_int(v), 32)), d = __int_as_float(__builtin_amdgcn_readlane(__float_as_int(v), 48));
    return (a + b) + (c + d);
}
__device__ __forceinline__ float wave_min_dpp(float v) {
    v = fminf(v, dpp_f(v, 0)); v = fminf(v, dpp_f(v, 1)); v = fminf(v, dpp_f(v, 2)); v = fminf(v, dpp_f(v, 3));
    const float a = __int_as_float(__builtin_amdgcn_readlane(__float_as_int(v), 0)), b = __int_as_float(__builtin_amdgcn_readlane(__float_as_int(v), 16));
    const float c = __int_as_float(__builtin_amdgcn_readlane(__float_as_int(v), 32)), d = __int_as_float(__builtin_amdgcn_readlane(__float_as_int(v), 48));
    return fminf(fminf(a, b), fminf(c, d));
}
__device__ __forceinline__ float wave_max_dpp(float v) {
    v = fmaxf(v, dpp_f(v, 0)); v = fmaxf(v, dpp_f(v, 1)); v = fmaxf(v, dpp_f(v, 2)); v = fmaxf(v, dpp_f(v, 3));
    const float a = __int_as_float(__builtin_amdgcn_readlane(__float_as_int(v), 0)), b = __int_as_float(__builtin_amdgcn_readlane(__float_as_int(v), 16));
    const float c = __int_as_float(__builtin_amdgcn_readlane(__float_as_int(v), 32)), d = __int_as_float(__builtin_amdgcn_readlane(__float_as_int(v), 48));
    return fmaxf(fmaxf(a, b), fmaxf(c, d));
}
typedef short s16x2 __attribute__((ext_vector_type(2)));
__device__ __forceinline__ h16x2 relu_pk(h16x2 x) { const s16x2 z = {0, 0}; return __builtin_bit_cast(h16x2, __builtin_elementwise_max(__builtin_bit_cast(s16x2, x), z)); }
__device__ __forceinline__ float relu_asm(float x) { const int i = __builtin_bit_cast(int, x); return __builtin_bit_cast(float, i > 0 ? i : 0); }
constexpr int IDX_CHUNK = 512;
constexpr int IDX_NG = IDX_CHUNK / 64;
constexpr int IDX_CHB = IDX_CHUNK * 128;
__device__ __forceinline__ void phase_index(const Params& p, LAS unsigned char* lds, int bid, int nb) {
    const int tid = threadIdx.x, lane = tid & 63, wave = __builtin_amdgcn_readfirstlane(tid >> 6), k16 = lane & 15, g = lane >> 4;
    unsigned char* ws = p.ws;
    const h16* iq = (const h16*)(ws + WS_IQ); const h16* kidx = (const h16*)(ws + WS_KIDX); const float* widx = (const float*)(ws + WS_WIDX);
    unsigned short* sel = (unsigned short*)(ws + WS_SEL);
    const int ksw = (k16 >> 1) & 7;
    const int sp0 = tid & 7;
    unsigned soff[IDX_NG];
#pragma unroll
    for (int q = 0; q < IDX_NG; ++q) { const int sk = (tid >> 3) + 64 * q; soff[q] = (unsigned)(sk * 128 + ((sp0 ^ ((sk >> 1) & 7)) << 4)); }
    const int nitems = (nb == 256) ? 8 : (2048 + nb - 1) / nb;
    for (int ii = 0; ii < nitems; ++ii) {
        int b, i;
        if (nb == 256) { b = (bid & 7) >> 1; const int idx = ((bid >> 3) << 1) | (bid & 1); const int pr = ii >> 1; i = (ii & 1) ? (128 * pr + idx) : (128 * pr + 127 - idx); }
        else { const int item = bid + ii * nb; if (item >= 2048) break; b = item >> 9; i = item & 511; }
        if (i < 32) continue;
        const int t0 = i * 8;
        const int nchunk = (t0 + 7) / IDX_CHUNK + 1;
        const int tq = t0 + wave;
        const size_t tg = (size_t)b * SEQ + tq;
        const h16* kb = kidx + (size_t)b * SEQ * 64;
        h16x8 Af[2];
        {
            const h16* ap = iq + tg * 1024 + k16 * 64 + g * 8;
            Af[0] = *(const h16x8*)ap; Af[1] = *(const h16x8*)(ap + 32);
        }
        h16x8 A2[2];
        {
            const f32x4 wv = *(const f32x4*)(widx + tg * 16 + 4 * g);
            h16x4 whi, wlo;
#pragma unroll
            for (int r = 0; r < 4; ++r) { whi[r] = (h16)wv[r]; wlo[r] = (h16)(wv[r] - (float)whi[r]); }
#pragma unroll
            for (int pp = 0; pp < 2; ++pp) {
#pragma unroll
                for (int r = 0; r < 4; ++r) {
                    A2[pp][r] = (k16 == 8 * pp) ? whi[r] : ((k16 == 8 * pp + 1) ? wlo[r] : (h16)0.f);
                    A2[pp][4 + r] = (k16 == 8 * pp + 4) ? whi[r] : ((k16 == 8 * pp + 5) ? wlo[r] : (h16)0.f);
                }
            }
        }
        float sc[64];
#pragma unroll
        for (int j = 0; j < 64; ++j) sc[j] = -INFINITY;
        {
            u32x4 a[IDX_NG];
#pragma unroll
            for (int q = 0; q < IDX_NG; ++q) a[q] = *(const u32x4*)(kb + (size_t)((tid >> 3) + 64 * q) * 64 + sp0 * 8);
#pragma unroll
            for (int q = 0; q < IDX_NG; ++q) *(LAS u32x4*)(lds + soff[q]) = a[q];
        }
        __builtin_amdgcn_s_waitcnt(0x0F70);
        __syncthreads();
#pragma unroll 1
        for (int c = 0; c < nchunk; ++c) {
            {
                const int cn1 = (c + 1 < nchunk) ? c + 1 : c;
                u32x4 st[IDX_NG];
#pragma unroll
                for (int q = 0; q < IDX_NG; ++q) st[q] = *(const u32x4*)(kb + (size_t)(IDX_CHUNK * cn1 + (tid >> 3) + 64 * q) * 64 + sp0 * 8);
                const LAS unsigned char* buf = lds + (c & 1) * IDX_CHB;
                float vy[IDX_CHUNK / 64];
                h16x8 Bc[8];
                {
                    const LAS unsigned char* rp = buf + k16 * 128;
#pragma unroll
                    for (int x = 0; x < 4; ++x)
#pragma unroll
                        for (int ks = 0; ks < 2; ++ks) Bc[2 * x + ks] = *(const LAS h16x8*)(rp + x * 2048 + (((4 * ks + g) ^ ksw) << 4));
                }
#pragma unroll
                for (int yy = 0; yy < IDX_CHUNK / 64; ++yy) {
                    h16x8 Bn[8];
                    if (yy + 1 < IDX_CHUNK / 64) {
                        const LAS unsigned char* rp = buf + ((yy + 1) * 64 + k16) * 128;
#pragma unroll
                        for (int x = 0; x < 4; ++x)
#pragma unroll
                            for (int ks = 0; ks < 2; ++ks) Bn[2 * x + ks] = *(const LAS h16x8*)(rp + x * 2048 + (((4 * ks + g) ^ ksw) << 4));
                    }
                    f32x4 acc[4];
#pragma unroll
                    for (int x = 0; x < 4; ++x) acc[x] = __builtin_amdgcn_mfma_f32_16x16x32_f16(Af[0], Bc[2 * x], (f32x4){0.f, 0.f, 0.f, 0.f}, 0, 0, 0);
#pragma unroll
                    for (int x = 0; x < 4; ++x) acc[x] = __builtin_amdgcn_mfma_f32_16x16x32_f16(Af[1], Bc[2 * x + 1], acc[x], 0, 0, 0);
                    f32x4 D2 = {0.f, 0.f, 0.f, 0.f};
#pragma unroll
                    for (int pp = 0; pp < 2; ++pp) {
                        h16x2 q[4];
#pragma unroll
                        for (int e = 0; e < 2; ++e) {
                            const f32x2 r01 = {acc[2 * pp + e][0], acc[2 * pp + e][1]}, r23 = {acc[2 * pp + e][2], acc[2 * pp + e][3]};
                            q[2 * e] = relu_pk(__builtin_convertvector(r01, h16x2)); q[2 * e + 1] = relu_pk(__builtin_convertvector(r23, h16x2));
                        }
                        h16x8 B2; B2[0] = q[0][0]; B2[1] = q[0][1]; B2[2] = q[1][0]; B2[3] = q[1][1]; B2[4] = q[2][0]; B2[5] = q[2][1]; B2[6] = q[3][0]; B2[7] = q[3][1];
                        D2 = __builtin_amdgcn_mfma_f32_16x16x32_f16(A2[pp], B2, D2, 0, 0, 0);
                    }
                    const int k = (c * (IDX_CHUNK / 64) + yy) * 64 + lane;
                    vy[yy] = (k <= tq) ? D2[0] + D2[1] : -INFINITY;
                    if (yy + 1 < IDX_CHUNK / 64) {
#pragma unroll
                        for (int q = 0; q < 8; ++q) Bc[q] = Bn[q];
                    }
                }
                switch (c) {
#define IDX_CASE(C) case C: _Pragma("unroll") for (int j = 0; j < IDX_NG; ++j) sc[IDX_NG * C + j] = vy[j]; break;
                    IDX_CASE(0) IDX_CASE(1) IDX_CASE(2) IDX_CASE(3) IDX_CASE(4) IDX_CASE(5) IDX_CASE(6) IDX_CASE(7)
#undef IDX_CASE
                    default: break;
                }
                {
                    LAS unsigned char* nbuf = lds + ((c + 1) & 1) * IDX_CHB;
#pragma unroll
                    for (int q = 0; q < IDX_NG; ++q) *(LAS u32x4*)(nbuf + soff[q]) = st[q];
                    __syncthreads();
                }
            }
        }
        const int nq = (tq >> 10) + 1;
        float vmin = INFINITY, vmax = -INFINITY, s1 = 0.f, s2 = 0.f;
#pragma unroll
        for (int q = 0; q < 4; ++q) if (q < nq) {
#pragma unroll
            for (int j = 16 * q; j < 16 * q + 16; ++j) { const float v = sc[j]; const bool ok = !(v == -INFINITY); vmax = fmaxf(vmax, v); vmin = fminf(vmin, ok ? v : INFINITY); const float vz = ok ? v : 0.f; s1 += vz; s2 += vz * vz; }
        }
        float lo = wave_min_dpp(vmin), hi = next_up(wave_max_dpp(vmax));
        int clo = tq + 1, chi = 0;
        float Tsel = lo; bool exact = false, finished = false;
        unsigned short* so = sel + tg * TOPK;
        int it = 0;
        if (clo > 512) {
            const float nn = (float)(tq + 1);
            const float mu = wave_sum_f_dpp(s1) / nn;
            float sg = sqrtf(fmaxf(wave_sum_f_dpp(s2) / nn - mu * mu, 0.f));
            const float zt = qinv_upper(384.5f / nn);
            for (int pa = 0; pa < 3 && clo > 512 && !finished; ++pa) {
                const float tp = mu + zt * sg;
                if (!(tp > lo && tp < hi)) break;
                int cn = 0;
#pragma unroll
                for (int q = 0; q < 4; ++q) if (q < nq) {
#pragma unroll
                    for (int j = 16 * q; j < 16 * q + 16; ++j) cn += (sc[j] >= tp) ? 1 : 0;
                }
                cn = wave_sum_dpp(cn);
                if (cn == TOPK) { Tsel = tp; exact = true; finished = true; break; }
                if (cn > TOPK) { lo = tp; clo = cn; } else { hi = tp; chi = cn; }
                Tsel = lo;
                const int cc = cn < 1 ? 1 : (cn > tq ? tq : cn);
                const float zm = qinv_upper((float)cc / nn);
                if (fabsf(zm) < 0.05f || (tp - mu) * zm <= 0.f) break;
                sg = (tp - mu) / zm;
            }
        }
        for (; it < 200 && !finished; ++it) {
            if (clo <= 512) break;
            float mid = 0.5f * lo + 0.5f * hi;
            if (!(it & 1)) { const float frac = ((float)(clo - TOPK) - 0.5f) / (float)(clo - chi); const float sm = lo + (hi - lo) * frac; if (sm > lo && sm < hi) mid = sm; }
            if (!(mid > lo && mid < hi)) { Tsel = lo; finished = true; break; }
            int cn = 0;
#pragma unroll
            for (int q = 0; q < 4; ++q) if (q < nq) {
#pragma unroll
                for (int j = 16 * q; j < 16 * q + 16; ++j) cn += (sc[j] >= mid) ? 1 : 0;
            }
            cn = wave_sum_dpp(cn);
            if (cn == TOPK) { Tsel = mid; exact = true; finished = true; break; }
            if (cn > TOPK) { lo = mid; clo = cn; } else { hi = mid; chi = cn; }
            Tsel = lo;
        }
        if (clo <= 512 && !finished) {
            LAS float* cl = (LAS float*)(lds + 131072 + wave * 3072);
            LAS unsigned short* ckl = (LAS unsigned short*)(lds + 131072 + wave * 3072 + 2048);
            int nc = 0;
#pragma unroll
            for (int q = 0; q < 4; ++q) if (q < nq) {
#pragma unroll
                for (int j = 16 * q; j < 16 * q + 16; ++j) {
                    const float v = sc[j];
                    const bool isc = v >= lo;
                    const unsigned long long bc = __ballot(isc);
                    const int pr = __builtin_amdgcn_mbcnt_hi((unsigned)(bc >> 32), __builtin_amdgcn_mbcnt_lo((unsigned)bc, 0u));
                    if (isc) { cl[nc + pr] = v; ckl[nc + pr] = (unsigned short)(j * 64 + lane); }
                    nc += __popcll(bc);
                }
            }
            LDS_WAIT();
            float cv[8]; int ck[8];
#pragma unroll
            for (int j = 0; j < 8; ++j) { const int pos = 64 * j + lane; const bool in = pos < nc; cv[j] = in ? cl[pos] : -INFINITY; ck[j] = in ? (int)ckl[pos] : 0; }
            for (; it < 400; ++it) {
                float mid = 0.5f * lo + 0.5f * hi;
                if (!(it & 1)) { const float frac = ((float)(clo - TOPK) - 0.5f) / (float)(clo - chi); const float sm = lo + (hi - lo) * frac; if (sm > lo && sm < hi) mid = sm; }
                if (!(mid > lo && mid < hi)) { Tsel = lo; break; }
                int cn = 0;
#pragma unroll
                for (int j = 0; j < 8; ++j) cn += (cv[j] >= mid) ? 1 : 0;
                cn = wave_sum_dpp(cn);
                if (cn == TOPK) { Tsel = mid; exact = true; break; }
                if (cn > TOPK) { lo = mid; clo = cn; } else { hi = mid; chi = cn; }
                Tsel = lo;
            }
            int quota = 0;
            if (!exact) { int ngt = 0;
#pragma unroll
                for (int j = 0; j < 8; ++j) ngt += (cv[j] > Tsel) ? 1 : 0;
                quota = TOPK - wave_sum_dpp(ngt); }
            int outb = 0, eqb = 0;
#pragma unroll
            for (int j = 0; j < 8; ++j) {
                const float v = cv[j];
                bool take;
                if (exact) take = v >= Tsel;
                else {
                    const bool eq = v == Tsel;
                    const unsigned long long beq = __ballot(eq);
                    const int eqr = __builtin_amdgcn_mbcnt_hi((unsigned)(beq >> 32), __builtin_amdgcn_mbcnt_lo((unsigned)beq, 0u));
                    take = (v > Tsel) || (eq && (eqb + eqr) < quota);
                    eqb += __popcll(beq);
                }
                const unsigned long long bt = __ballot(take);
                const int tr = __builtin_amdgcn_mbcnt_hi((unsigned)(bt >> 32), __builtin_amdgcn_mbcnt_lo((unsigned)bt, 0u));
                if (take) so[outb + tr] = (unsigned short)ck[j];
                outb += __popcll(bt);
            }
            LDS_WAIT();
        } else if (exact) {
            int outb = 0;
#pragma unroll
            for (int q = 0; q < 4; ++q) if (q < nq) {
#pragma unroll
                for (int j = 16 * q; j < 16 * q + 16; ++j) {
                    const bool take = sc[j] >= Tsel;
                    const unsigned long long bt = __ballot(take);
                    const int tr = __builtin_amdgcn_mbcnt_hi((unsigned)(bt >> 32), __builtin_amdgcn_mbcnt_lo((unsigned)bt, 0u));
                    if (take) so[outb + tr] = (unsigned short)(j * 64 + lane);
                    outb += __popcll(bt);
                }
            }
        } else {
            int ngt = 0;
#pragma unroll
            for (int j = 0; j < 64; ++j) ngt += (sc[j] > Tsel) ? 1 : 0;
            ngt = wave_sum_dpp(ngt);
            const int quota = TOPK - ngt;
            int outb = 0, eqb = 0;
#pragma unroll
            for (int j = 0; j < 64; ++j) {
                const float v = sc[j];
                const bool gt = v > Tsel, eq = v == Tsel;
                const unsigned long long beq = __ballot(eq);
                const int eqr = __builtin_amdgcn_mbcnt_hi((unsigned)(beq >> 32), __builtin_amdgcn_mbcnt_lo((unsigned)beq, 0u));
                const bool take = gt || (eq && (eqb + eqr) < quota);
                const unsigned long long bt = __ballot(take);
                const int tr = __builtin_amdgcn_mbcnt_hi((unsigned)(bt >> 32), __builtin_amdgcn_mbcnt_lo((unsigned)bt, 0u));
                if (take) so[outb + tr] = (unsigned short)(j * 64 + lane);
                outb += __popcll(bt); eqb += __popcll(beq);
            }
        }
    }
    __syncthreads();
}

typedef short s16x4v __attribute__((__vector_size__(4 * sizeof(short))));
__device__ __forceinline__ h16x4 lds_tr_read(const LAS unsigned char* p) {
    return __builtin_bit_cast(h16x4, __builtin_amdgcn_ds_read_tr16_b64_v4i16((LAS s16x4v*)p));
}
__device__ __forceinline__ void phase_attn(const Params& p, LAS unsigned char* lds, int bid, int nb) {
    const int tid = threadIdx.x, lane = tid & 63, wave = __builtin_amdgcn_readfirstlane(tid >> 6), g = lane >> 4, hd = lane & 15;
    unsigned char* ws = p.ws;
    const h16* qabs = (const h16*)(ws + WS_QABS); const h16* ckv = (const h16*)(ws + WS_CKV);
    const unsigned short* sel = (const unsigned short*)(ws + WS_SEL);
    h16* olat = (h16*)(ws + WS_OLAT);
    LAS unsigned char* kv = lds + wave * 16384;
    LAS int* sidx = (LAS int*)(lds + 131072 + wave * 1024);
    LAS float* biasT = (LAS float*)(lds + 131072 + 8192);
    LAS unsigned char* bktT = lds + 131072 + 8192 + 1024;
    __syncthreads();
    if (tid < 256) biasT[tid] = p.rel_bias[tid];
    if (tid < 128) bktT[tid] = (unsigned char)t5_bucket(tid);
    __syncthreads();
    int tstart, tstride, tcount;
    if (nb == 256) { const int b = (bid & 7) >> 1, wq = ((((bid >> 3) << 1) | (bid & 1)) << 3) + wave; tstart = b * SEQ + wq; tstride = 512; tcount = 8; }
    else { tstart = bid * NWAVES + wave; tstride = nb * NWAVES; tcount = (T - tstart + tstride - 1) / tstride; }
    const int rowA = hd;
    const int fswA = ((rowA & 3) << 1) | (((rowA >> 2) & 1) << 3);
    const int q4 = hd >> 2, p4 = hd & 3;
    const int rowT = 4 * g + q4;
    const int fswT = ((rowT & 3) << 1) | (((rowT >> 2) & 1) << 3);
    const LAS unsigned char* trbase = kv + rowT * 512 + 8 * (p4 & 1);
    for (int qi = 0; qi < tcount; ++qi) {
        const int tg = tstart + qi * tstride;
        const int b = tg >> 12, tl = tg & (SEQ - 1);
        const int cnt = tl + 1 < TOPK ? tl + 1 : TOPK, nch = (cnt + 31) >> 5;
        {
            int i0, i1, i2, i3;
            if (tl + 1 > TOPK) { const u32x2 s4 = *(const u32x2*)(sel + (size_t)tg * TOPK + lane * 4); i0 = s4.x & 0xffff; i1 = s4.x >> 16; i2 = s4.y & 0xffff; i3 = s4.y >> 16; }
            else { const int j = lane * 4; i0 = j < cnt ? j : 0; i1 = j + 1 < cnt ? j + 1 : 0; i2 = j + 2 < cnt ? j + 2 : 0; i3 = j + 3 < cnt ? j + 3 : 0; }
            *(LAS i32x4*)(sidx + lane * 4) = (i32x4){i0, i1, i2, i3};
        }
        h16x8 Qf[8];
#pragma unroll
        for (int ks = 0; ks < 8; ++ks) {
            h16x8 z;
#pragma unroll
            for (int e = 0; e < 8; ++e) z[e] = (h16)0.f;
            Qf[ks] = (hd < 8) ? *(const h16x8*)(qabs + (size_t)tg * 2048 + hd * 256 + ks * 32 + g * 8) : z;
        }
        f32x4 O[16];
#pragma unroll
        for (int ct = 0; ct < 16; ++ct) O[ct] = (f32x4){0.f, 0.f, 0.f, 0.f};
        float m = -INFINITY, l = 0.f;
        const unsigned char* ckvb = (const unsigned char*)(ckv + (size_t)b * SEQ * 256);
        LDS_WAIT();
        for (int c = 0; c < nch; ++c) {
            asm volatile("" ::: "memory");
#pragma unroll
            for (int i = 0; i < 16; ++i) {
                const int row = 2 * i + (lane >> 5);
                const int idx = sidx[32 * c + row];
                const int fsw = ((row & 3) << 1) | (((row >> 2) & 1) << 3);
                const unsigned char* src = ckvb + (size_t)idx * 512 + ((((lane & 31) ^ fsw)) << 4);
                __builtin_amdgcn_global_load_lds((const unsigned*)src, (LAS unsigned*)(kv + i * 1024), 16, 0, 0);
            }
            const i32x4 ia = *(const LAS i32x4*)(sidx + 32 * c + 4 * g), ib = *(const LAS i32x4*)(sidx + 32 * c + 16 + 4 * g);
            const int h7 = hd & 7;
            const int kk8[8] = {ia.x, ia.y, ia.z, ia.w, ib.x, ib.y, ib.z, ib.w};
            float bias8[8];
#pragma unroll
            for (int r = 0; r < 8; ++r) {
                const int slot = 32 * c + (r < 4 ? 4 * g + r : 16 + 4 * g + (r - 4));
                int dist = tl - kk8[r]; dist = dist < 0 ? 0 : (dist > 127 ? 127 : dist);
                bias8[r] = (slot < cnt) ? biasT[(int)bktT[dist] * 8 + h7] : -INFINITY;
            }
            asm volatile("s_waitcnt vmcnt(0)" ::: "memory");
            __builtin_amdgcn_sched_barrier(0);
            f32x4 S0 = {0.f, 0.f, 0.f, 0.f}, S1 = {0.f, 0.f, 0.f, 0.f};
#pragma unroll
            for (int ks = 0; ks < 8; ++ks) {
                const h16x8 A0 = *(const LAS h16x8*)(kv + rowA * 512 + (((4 * ks + g) ^ fswA) << 4));
                const h16x8 A1 = *(const LAS h16x8*)(kv + (rowA + 16) * 512 + (((4 * ks + g) ^ fswA) << 4));
                S0 = __builtin_amdgcn_mfma_f32_16x16x32_f16(A0, Qf[ks], S0, 0, 0, 0);
                S1 = __builtin_amdgcn_mfma_f32_16x16x32_f16(A1, Qf[ks], S1, 0, 0, 0);
            }
            float sv[8]; float cmax = -INFINITY;
#pragma unroll
            for (int r = 0; r < 8; ++r) { sv[r] = ((r < 4) ? S0[r] : S1[r - 4]) + bias8[r]; cmax = fmaxf(cmax, sv[r]); }
            if (__any(cmax > m + 8.f)) {
                cmax = fmaxf(cmax, __shfl_xor(cmax, 16)); cmax = fmaxf(cmax, __shfl_xor(cmax, 32));
                const float mnew = fmaxf(m, cmax);
                const float alpha = __expf(m - mnew);
                l *= alpha; m = mnew;
#pragma unroll
                for (int ct = 0; ct < 16; ++ct) O[ct] *= alpha;
            }
            h16x8 Pf;
#pragma unroll
            for (int r = 0; r < 8; ++r) { const float pv = __expf(sv[r] - m); l += pv; Pf[r] = (h16)pv; }
#pragma unroll
            for (int ct = 0; ct < 16; ++ct) {
                const int choff = ((((2 * (ct & 7)) ^ fswT) + (p4 >> 1)) << 4) + (ct >> 3) * 256;
                const h16x4 a0 = lds_tr_read(trbase + choff);
                const h16x4 a1 = lds_tr_read(trbase + 16 * 512 + choff);
                h16x8 Av; Av[0] = a0[0]; Av[1] = a0[1]; Av[2] = a0[2]; Av[3] = a0[3]; Av[4] = a1[0]; Av[5] = a1[1]; Av[6] = a1[2]; Av[7] = a1[3];
                O[ct] = __builtin_amdgcn_mfma_f32_16x16x32_f16(Av, Pf, O[ct], 0, 0, 0);
            }
            asm volatile("" ::: "memory");
        }
        l += __shfl_xor(l, 16); l += __shfl_xor(l, 32);
        if (hd < 8) {
            const float inv = 1.f / l;
            h16* op = olat + (size_t)tg * 2048 + hd * 256 + 4 * g;
#pragma unroll
            for (int ct = 0; ct < 16; ++ct) *(u32x2*)(op + 16 * ct) = pack_h4(O[ct] * inv);
        }
    }
    __syncthreads();
}

__device__ __forceinline__ void phase_uv(const Params& p, LAS unsigned char* lds, int bid, int nb) {
    const int tid = threadIdx.x, lane = tid & 63, wave = tid >> 6, r31 = lane & 31, hh = lane >> 5;
    unsigned char* ws = p.ws;
    const h16* olat = (const h16*)(ws + WS_OLAT); const h16* wuvT = (const h16*)(ws + WS_WUVT);
    h16* ymix = (h16*)(ws + WS_R2);
    for (int u = bid; u < 256; u += nb) {
        const int h = u & 7, rb = u >> 3;
        __syncthreads();
        for (int e = tid; e < 128 * 32; e += NTHREADS) { const int v = e >> 5, ch = e & 31; *(LAS u32x4*)(lds + v * 528 + ch * 16) = *(const u32x4*)(wuvT + ((size_t)h * 128 + v) * 256 + ch * 8); }
        __syncthreads();
        for (int tile = wave; tile < 16; tile += NWAVES) {
            const int row0 = rb * 512 + tile * 32;
            f32x16 acc[4];
#pragma unroll
            for (int vt = 0; vt < 4; ++vt)
#pragma unroll
                for (int r = 0; r < 16; ++r) acc[vt][r] = 0.f;
            const h16* bp = olat + (size_t)(row0 + r31) * 2048 + h * 256 + hh * 8;
#pragma unroll 4
            for (int ks = 0; ks < 16; ++ks) {
                const h16x8 Bf = *(const h16x8*)(bp + ks * 16);
#pragma unroll
                for (int vt = 0; vt < 4; ++vt) {
                    const h16x8 Af = *(const LAS h16x8*)(lds + (vt * 32 + r31) * 528 + ks * 32 + hh * 16);
                    acc[vt] = __builtin_amdgcn_mfma_f32_32x32x16_f16(Af, Bf, acc[vt], 0, 0, 0);
                }
            }
            float ss = 0.f;
#pragma unroll
            for (int vt = 0; vt < 4; ++vt)
#pragma unroll
                for (int r = 0; r < 16; ++r) ss += acc[vt][r] * acc[vt][r];
            ss += __shfl_xor(ss, 32);
            const float rstd = rsqrtf(ss * (1.f / 128.f) + EPS);
            h16* yp = ymix + (size_t)(row0 + r31) * 2048 + h * 128 + 4 * hh;
            const float* gp = p.attn_out_norm_g + h * 128 + 4 * hh;
#pragma unroll
            for (int vt = 0; vt < 4; ++vt)
#pragma unroll
                for (int rq = 0; rq < 4; ++rq) {
                    const f32x4 gg = *(const f32x4*)(gp + vt * 32 + 8 * rq);
                    const f32x4 y = {acc[vt][4 * rq + 0] * rstd * gg[0], acc[vt][4 * rq + 1] * rstd * gg[1], acc[vt][4 * rq + 2] * rstd * gg[2], acc[vt][4 * rq + 3] * rstd * gg[3]};
                    *(u32x2*)(yp + vt * 32 + 8 * rq) = pack_h4(y);
                }
        }
    }
    __syncthreads();
}

#define XB_TMO      128
#define XB_XCNT(j)  (256  + 64 * (j))
#define XB_XSUB(j)  (1280 + 64 * (j))
#define XB_XGEN(j)  (2304 + 64 * (j))
#define XB_TOP      3328
#define XB_TOPGEN   3392
#define XCD_BAR_WORDS 3456
#define XB_SPIN_CAP (1u << 22)
__device__ __forceinline__ unsigned xb_ld(unsigned* p)              { return __hip_atomic_load(p, __ATOMIC_RELAXED, __HIP_MEMORY_SCOPE_AGENT); }
__device__ __forceinline__ unsigned xb_add(unsigned* p, unsigned v) { return __hip_atomic_fetch_add(p, v, __ATOMIC_RELAXED, __HIP_MEMORY_SCOPE_AGENT); }
__device__ __forceinline__ unsigned xb_xcc_id() { return (unsigned)__builtin_amdgcn_s_getreg((3 << 11) | 20) & 0xFu; }
#define XB_SPIN(cond, bar) do { unsigned _sp = 0; while (cond) { __builtin_amdgcn_s_sleep(1); \
    if ((++_sp & 255u) == 0u) { if (xb_ld(&(bar)[XB_TMO])) break; if (_sp > XB_SPIN_CAP) { atomicAdd(&(bar)[XB_TMO], 1u); break; } } } } while (0)
struct XcdBarrier { unsigned* bar; unsigned x; volatile LAS unsigned* st; };
__device__ __forceinline__ XcdBarrier xcd_barrier_post(unsigned* bar, volatile LAS unsigned* st) {
    XcdBarrier b; b.bar = bar; b.x = xb_xcc_id(); b.st = st;
    if (threadIdx.x == 0) (void)xb_add(&bar[XB_XCNT(b.x)], 1u);
    return b;
}
__device__ __forceinline__ void xcd_barrier_complete(unsigned* bar, unsigned x, unsigned& nloc, unsigned& nx) {
    const unsigned G = gridDim.x * gridDim.y * gridDim.z;
    unsigned sum, cnt, mine, sp = 0u;
    for (;;) {
        sum = 0u; cnt = 0u; mine = 0u;
#pragma unroll
        for (unsigned j = 0; j < 16; ++j) { const unsigned c = xb_ld(&bar[XB_XCNT(j)]); sum += c; cnt += (c > 0u) ? 1u : 0u; mine = (j == x) ? c : mine; }
        if (sum == G) break;
        __builtin_amdgcn_s_sleep(1);
        if ((++sp & 255u) == 0u) { if (xb_ld(&bar[XB_TMO])) break; if (sp > XB_SPIN_CAP) { atomicAdd(&bar[XB_TMO], 1u); break; } }
    }
    nloc = mine > 0u ? mine : 1u; nx = cnt > 0u ? cnt : 1u;
}
__device__ __forceinline__ void xcd_barrier(const XcdBarrier& b) {
    asm volatile("s_waitcnt vmcnt(0)" ::: "memory");
    __syncthreads();
    if (threadIdx.x == 0) {
        unsigned* bar = b.bar;
        __builtin_amdgcn_s_waitcnt(0);
        unsigned nloc = b.st[0], nx = b.st[1];
        if (nloc == 0u) { xcd_barrier_complete(bar, b.x, nloc, nx); b.st[0] = nloc; b.st[1] = nx; }
        const unsigned old = xb_add(&bar[XB_XSUB(b.x)], 1u);
        const unsigned gen = old / nloc;
        if (old + 1u == (gen + 1u) * nloc) {
            __builtin_amdgcn_fence(__ATOMIC_RELEASE, "agent");
            asm volatile("s_waitcnt vmcnt(0)" ::: "memory");
            const unsigned og = xb_add(&bar[XB_TOP], 1u);
            const unsigned tg = og / nx;
            if (og + 1u == (tg + 1u) * nx) xb_add(&bar[XB_TOPGEN], 1u);
            else XB_SPIN(xb_ld(&bar[XB_TOPGEN]) == tg, bar);
            __builtin_amdgcn_fence(__ATOMIC_ACQUIRE, "agent");
            xb_add(&bar[XB_XGEN(b.x)], 1u);
            asm volatile("s_waitcnt vmcnt(0)" ::: "memory");
        } else {
            XB_SPIN(xb_ld(&bar[XB_XGEN(b.x)]) == gen, bar);
            __builtin_amdgcn_fence(__ATOMIC_ACQUIRE, "agent");
            asm volatile("s_waitcnt vmcnt(0)" ::: "memory");
        }
    }
    __syncthreads();
}

constexpr int LDS_BYTES = 160 * 1024;
constexpr int WGM_G1 = 2, WGM_G2 = 2, WGM_G6 = 2, WGM_G7 = 8, WGM_G8 = 2;
constexpr int NPHASES = 13;
__global__ void __launch_bounds__(NTHREADS, 2) fwd_kernel(Params p) {
    extern __shared__ __attribute__((aligned(16))) unsigned char lds_raw[];
    LAS unsigned char* lds = (LAS unsigned char*)lds_raw;
    const int bid = blockIdx.x, nb = gridDim.x;
    unsigned char* ws = p.ws;
    float* mod = (float*)(ws + WS_MOD);
    volatile LAS unsigned* bst = (volatile LAS unsigned*)(lds + LDS_BYTES - 64);
    if (threadIdx.x < 2) bst[threadIdx.x] = 0u;
    __syncthreads();
    XcdBarrier xbar = xcd_barrier_post((unsigned*)(ws + WS_CTL), bst);
#define IN(k) (p.ph_lo <= (k) && (k) < p.ph_hi)
#define SEAM(k) do { if (IN(k) && IN((k) + 1)) xcd_barrier(xbar); } while (0)
    if (IN(0)) { phase_prep(p, lds, bid, nb); } SEAM(0);
    if (IN(1)) { phase_normmod(p.x, p.norm1_g, mod, 0, 2048, (h16*)(ws + WS_R2), bid, nb); } SEAM(1);
    if (IN(2)) { EpiProj E{(h16*)(ws + WS_CQ), (float*)(ws + WS_PROJA), (h16*)(ws + WS_CKV), (h16*)(ws + WS_KIDX), (float*)(ws + WS_WIDX), (h16*)(ws + WS_PROJB), p.kv_norm_g, p.idx_k_norm_g, p.idx_k_norm_b};
                 run_gemm(lds, (const h16*)(ws + WS_R2), (const h16*)(ws + WS_BT_IN), T, N_IN, 2048, bid, nb, E, WGM_G1); } SEAM(2);
    if (IN(3)) { phase_rows3(p, bid, nb); } SEAM(3);
    if (IN(4)) { EpiQ E{(h16*)(ws + WS_QABS), (h16*)(ws + WS_IQ), p.q_abs_norm_g, (const float*)(ws + WS_PROJA)}; run_gemm(lds, (const h16*)(ws + WS_CQ), (const h16*)(ws + WS_BT_Q), T, N_Q, 512, bid, nb, E, WGM_G2); } SEAM(4);
    if (IN(5)) { phase_index(p, lds, bid, nb); } SEAM(5);
    if (IN(6)) { phase_attn(p, lds, bid, nb); } SEAM(6);
    if (IN(7)) { phase_uv(p, lds, bid, nb); } SEAM(7);
    if (IN(8)) { EpiF16 E{(h16*)(ws + WS_Y6), nullptr}; run_gemm(lds, (const h16*)(ws + WS_R2), (const h16*)(ws + WS_BT_OUT), T, 2048, 2048, bid, nb, E, WGM_G6); } SEAM(8);
    if (IN(9)) { phase_normmod2(p, bid, nb); } SEAM(9);
    if (IN(10)) {
        LAS h16* bl = (LAS h16*)(lds + 131072 + 8192);
        __syncthreads();
        for (int i = threadIdx.x; i < D_FF / 4; i += NTHREADS) { const f32x4 b4 = *(const f32x4*)(p.b_mlp1 + 4 * i); *(LAS u32x2*)(bl + 4 * i) = pack_h4(b4); }
        __syncthreads();
        EpiMlp1 E{bl, (h16*)(ws + WS_R3)}; run_gemm(lds, (const h16*)(ws + WS_R2), (const h16*)(ws + WS_BT_1), T, D_FF, 2048, bid, nb, E, WGM_G7); } SEAM(10);
    if (IN(11)) { EpiF16 E{(h16*)(ws + WS_R2), p.b_mlp2}; run_gemm(lds, (const h16*)(ws + WS_R3), (const h16*)(ws + WS_BT_2), T, 2048, D_FF, bid, nb, E, WGM_G8); } SEAM(11);
    if (IN(12)) { phase_final(p, bid, nb); }
#undef IN
#undef SEAM
}

#ifndef N_LAUNCH_MODE
#define N_LAUNCH_MODE 1
#endif
extern "C" void kernel_launch(void* const* d_in, const int* in_sizes, int n_in, void* d_out, int out_size, void* d_ws, size_t ws_size, hipStream_t stream) {
    static int grid = 0;
    if (grid == 0) {
        if (ws_size < WS_END) { fprintf(stderr, "kernel_launch: workspace too small (%zu < %zu)\n", ws_size, (size_t)WS_END); grid = -1; return; }
        int dev = 0, cus = 0, per_cu = 0;
        hipGetDevice(&dev);
        hipDeviceGetAttribute(&cus, hipDeviceAttributeMultiprocessorCount, dev);
        if (hipFuncSetAttribute((const void*)fwd_kernel, hipFuncAttributeMaxDynamicSharedMemorySize, LDS_BYTES) != hipSuccess) { fprintf(stderr, "kernel_launch: hipFuncSetAttribute failed\n"); grid = -1; return; }
        hipOccupancyMaxActiveBlocksPerMultiprocessor(&per_cu, (const void*)fwd_kernel, NTHREADS, LDS_BYTES);
        if (per_cu < 1) { fprintf(stderr, "kernel_launch: occupancy query says %d\n", per_cu); per_cu = 1; }
        grid = cus;
        if (grid > 256) grid = 256;
    }
    if (grid < 0) return;
    Params p{};
    const float** f = (const float**)&p;
    for (int i = 0; i < 26; ++i) f[i] = (const float*)d_in[i];
    p.out = (float*)d_out; p.ws = (unsigned char*)d_ws;
#if N_LAUNCH_MODE == 1
    if (hipMemsetAsync((char*)d_ws + WS_CTL, 0, XCD_BAR_WORDS * 4, stream) != hipSuccess) { fprintf(stderr, "kernel_launch: memset failed\n"); return; }
    p.ph_lo = 0; p.ph_hi = NPHASES;
    void* args[] = {&p};
    hipError_t e = hipLaunchCooperativeKernel((const void*)fwd_kernel, dim3(grid), dim3(NTHREADS), args, LDS_BYTES, stream);
    if (e != hipSuccess) fprintf(stderr, "cooperative launch failed: %s (grid %d)\n", hipGetErrorString(e), grid);
#else
    for (int ph = 0; ph < 13; ++ph) {
        p.ph_lo = ph; p.ph_hi = ph + 1;
        hipLaunchKernelGGL(fwd_kernel, dim3(grid), dim3(NTHREADS), LDS_BYTES, stream, p);
    }
#endif
}
```

```cpp
#include <hip/hip_runtime.h>
#include <cstdio>
#include <cstdint>

#define LAS __attribute__((address_space(3)))
typedef _Float16 h16;
typedef _Float16 h16x8 __attribute__((ext_vector_type(8)));
typedef _Float16 h16x4 __attribute__((ext_vector_type(4)));
typedef _Float16 h16x2 __attribute__((ext_vector_type(2)));
typedef float f32x4 __attribute__((ext_vector_type(4)));
typedef float f32x2 __attribute__((ext_vector_type(2)));
typedef unsigned u32x4 __attribute__((ext_vector_type(4)));
typedef unsigned u32x2 __attribute__((ext_vector_type(2)));
typedef int i32x4 __attribute__((ext_vector_type(4)));

constexpr int D_MODEL = 2048, BATCH = 4, SEQ = 4096, T = BATCH * SEQ;
constexpr int ATTN_HEADS = 8, HEAD_DIM = 128, Q_LORA = 512, KV_LORA = 256, IDX_HEADS = 16, IDX_DIM = 64, TOPK = 256;
constexpr int CONV_WIDTH = 1024, D_FF = 8192, IN_COLS = 3920;
constexpr float EPS = 1e-6f;
constexpr int NTHREADS = 512, NWAVES = 8;
constexpr int N_IN = 4096;
constexpr int N_Q = 3072;

constexpr size_t MiB = (size_t)1 << 20;
constexpr size_t WS_CTL = 0;
constexpr size_t WS_MOD = 64 * 1024;
constexpr size_t WS_BT_IN = 1 * MiB;
constexpr size_t WS_BT_Q = WS_BT_IN + 16 * MiB;
constexpr size_t WS_BT_OUT = WS_BT_Q + 3 * MiB;
constexpr size_t WS_BT_1 = WS_BT_OUT + 8 * MiB;
constexpr size_t WS_BT_2 = WS_BT_1 + 32 * MiB;
constexpr size_t WS_WUVT = WS_BT_2 + 32 * MiB;
constexpr size_t WS_R2 = 93 * MiB;
constexpr size_t WS_R3 = WS_R2 + 64 * MiB;
constexpr size_t WS_PROJA = WS_R3;
constexpr size_t WS_PROJB = WS_R3 + 64 * MiB;
constexpr size_t WS_OLAT = WS_R3 + 64 * MiB;
constexpr size_t WS_QABS = WS_R3 + 160 * MiB;
constexpr size_t WS_IQ = WS_R3 + 224 * MiB;
constexpr size_t WS_R4 = WS_R3 + 256 * MiB;
constexpr size_t WS_CQ = WS_R4;
constexpr size_t WS_CKV = WS_CQ + 16 * MiB;
constexpr size_t WS_KIDX = WS_CKV + 8 * MiB;
constexpr size_t WS_WIDX = WS_KIDX + 2 * MiB;
constexpr size_t WS_SEL = WS_WIDX + 1 * MiB;
constexpr size_t WS_Y6 = WS_SEL + 8 * MiB;
constexpr size_t WS_END = WS_Y6 + 64 * MiB;

struct Params {
    const float *x, *c, *w_ada, *b_ada, *norm1_g, *norm2_g, *w_in, *cq_norm_g, *w_uq, *w_uk, *kv_norm_g, *q_abs_norm_g, *w_uv, *w_iq,
        *idx_k_norm_g, *idx_k_norm_b, *rel_bias, *conv_w, *conv_b, *attn_out_norm_g, *conv_out_norm_g, *w_out, *w_mlp1, *b_mlp1, *w_mlp2, *b_mlp2;
    float* out;
    unsigned char* ws;
    int ph_lo, ph_hi;
};

__device__ __forceinline__ float wave_sum(float v) {
#pragma unroll
    for (int o = 1; o < 64; o <<= 1) v += __shfl_xor(v, o);
    return v;
}
__device__ __forceinline__ float wave_max(float v) {
#pragma unroll
    for (int o = 1; o < 64; o <<= 1) v = fmaxf(v, __shfl_xor(v, o));
    return v;
}
#define LDS_WAIT() asm volatile("s_waitcnt lgkmcnt(0)" ::: "memory")

namespace pg8 {
constexpr int BM = 256, BK = 64, HALF = 128, HTB = HALF * BK * 2, STAGE_BYTES = 8 * HTB, NXCD = 8;
__host__ __device__ __forceinline__ int lds_byte(int r, int c) { const int st = (r >> 4) * 2 + (c >> 5), rr = r & 15, cc = c & 31, ob = rr * 64 + cc * 2; return st * 1024 + (ob ^ (((ob >> 9) & 1) << 5)); }
__host__ __device__ __forceinline__ int perm32(int rho) { const int n = rho >> 4, i = rho & 15; return 8 * (i >> 2) + 4 * n + (i & 3); }
__host__ __device__ __forceinline__ void stage_rc(int b, int& R, int& C) { const int st = b / 1024, sb = b % 1024, swz = sb ^ (((sb >> 9) & 1) << 5); R = (st >> 1) * 16 + swz / 64; C = (st & 1) * 32 + (swz % 64) / 2; }
struct Unit { int pm, pn; };
struct Gemm { const h16* A; const h16* Bt; int M, N, K; };
struct StaticOrder {
    int nM, nN, nwg, G, c, WGM;
    __host__ __device__ void init(int M, int N, int G_, int c_, int wgm) { nM = M / BM; nN = N / BM; nwg = nM * nN; G = G_; c = c_; WGM = wgm; }
    __host__ __device__ bool next(int i, Unit& u) const {
        const long L = (long)i * G + c; if (L >= nwg) return false;
        int wgid = (int)L; { const int q = nwg / NXCD, r = nwg % NXCD, xcd = wgid % NXCD, off = wgid / NXCD; wgid = (xcd < r ? xcd * (q + 1) : r * (q + 1) + (xcd - r) * q) + off; }
        const int nig = WGM * nN, gid = wgid / nig, fm = gid * WGM, gsz = (nM - fm) < WGM ? (nM - fm) : WGM;
        u.pm = fm + ((wgid % nig) % gsz); u.pn = (wgid % nig) / gsz; return true;
    }
};

#ifndef PG8_SP2
#define PG8_SP2 true
#endif
#ifndef PG8_ALIGN
#define PG8_ALIGN true
#endif
template <class Epi, bool ALIGN_EPI = PG8_ALIGN, bool SP2 = PG8_SP2>
__device__ __forceinline__ void gemm_phase(LAS unsigned char* lds, const Gemm g, const StaticOrder& S, const Epi& E) {
    const int tid = threadIdx.x, wid = __builtin_amdgcn_readfirstlane(tid >> 6), lane = tid & 63, wr = wid >> 2, wc = wid & 3, fr = lane & 15, fq = lane >> 4;
    const int K = g.K, nt = K / BK;
    unsigned voffA[2], voffB[2];
#pragma unroll
    for (int i = 0; i < 2; ++i) { int R, C; stage_rc(tid * 16 + i * 8192, R, C); const int Rb = Epi::PERM ? ((R & ~31) + perm32(R & 31)) : R; voffA[i] = (unsigned)(R * K + C) * 2u; voffB[i] = (unsigned)(Rb * K + C) * 2u; }
    const size_t kstep = (size_t)(BK * 2);
    const size_t hstep = (size_t)HALF * K * 2;
    const size_t tstep = 2 * hstep;
    const unsigned ldsw = (unsigned)wid * 1024u;
    const int aoff = lds_byte(wr * 64 + fr, fq * 8), boff = lds_byte(wc * 32 + fr, fq * 8);
#define PG8_SA(b, h) (((b) * 2 + (h)) * HTB)
#define PG8_SB(b, h) ((4 + (b) * 2 + (h)) * HTB)
#define PG8_STAGE(bufoff, gbase, voff) do { _Pragma("unroll") for (int _i = 0; _i < 2; ++_i) \
        __builtin_amdgcn_global_load_lds((const unsigned*)((const char*)(gbase) + (voff)[_i]), (LAS unsigned*)(lds + (bufoff) + ldsw + _i * 8192), 16, 0, 0); } while (0)
#define PG8_LDA(dst, b, h) do { _Pragma("unroll") for (int m = 0; m < 4; ++m) _Pragma("unroll") for (int k = 0; k < 2; ++k) dst[m][k] = *(const LAS h16x8*)(lds + PG8_SA(b, h) + aoff + m * 2048 + k * 1024); } while (0)
#define PG8_LDB(dst, b, h) do { _Pragma("unroll") for (int n = 0; n < 2; ++n) _Pragma("unroll") for (int k = 0; k < 2; ++k) dst[n][k] = *(const LAS h16x8*)(lds + PG8_SB(b, h) + boff + n * 2048 + k * 1024); } while (0)
#define PG8_MMA(ai, bj, At, Bt) do { __builtin_amdgcn_s_setprio(1); _Pragma("unroll") for (int m = 0; m < 4; ++m) _Pragma("unroll") for (int n = 0; n < 2; ++n) _Pragma("unroll") for (int k = 0; k < 2; ++k) \
        acc[ai][bj][m][n] = __builtin_amdgcn_mfma_f32_16x16x32_f16(Bt[n][k], At[m][k], acc[ai][bj][m][n], 0, 0, 0); __builtin_amdgcn_s_setprio(0); } while (0)
#define PG8_WAIT_V(n) asm volatile("s_waitcnt vmcnt(" #n ")" ::: "memory")
#define PG8_WAIT_L(n) asm volatile("s_waitcnt lgkmcnt(" #n ")" ::: "memory")
#define PG8_BAR __builtin_amdgcn_s_barrier()
#define PG8_SCHED __builtin_amdgcn_sched_barrier(0)
    Unit cur, nxt; int ui = 0;
    if (!S.next(0, cur)) return;
    f32x4 acc[2][2][4][2];
#pragma unroll
    for (int a = 0; a < 2; ++a)
#pragma unroll
        for (int b = 0; b < 2; ++b)
#pragma unroll
            for (int m = 0; m < 4; ++m)
#pragma unroll
                for (int n = 0; n < 2; ++n) acc[a][b][m][n] = (f32x4){0.f, 0.f, 0.f, 0.f};
    h16x8 At[4][2], B0[2][2], B1[2][2];
    const char* cA = (const char*)g.A + (size_t)cur.pm * tstep; const char* cB = (const char*)g.Bt + (size_t)cur.pn * tstep;
    if constexpr (SP2) {
        PG8_STAGE(PG8_SB(0, 0), cB, voffB); PG8_STAGE(PG8_SB(0, 1), cB + hstep, voffB); PG8_STAGE(PG8_SA(0, 0), cA, voffA); PG8_STAGE(PG8_SA(0, 1), cA + hstep, voffA);
        if (wr == 1) PG8_BAR;
        PG8_WAIT_V(2); PG8_BAR;
        PG8_STAGE(PG8_SB(1, 0), cB + kstep, voffB); PG8_STAGE(PG8_SA(1, 0), cA + kstep, voffA); PG8_STAGE(PG8_SB(1, 1), cB + hstep + kstep, voffB);
        PG8_WAIT_V(6); PG8_BAR;
    } else {
        PG8_STAGE(PG8_SB(0, 0), cB, voffB); PG8_STAGE(PG8_SA(0, 0), cA, voffA); PG8_STAGE(PG8_SB(0, 1), cB + hstep, voffB); PG8_STAGE(PG8_SA(0, 1), cA + hstep, voffA);
        if (wr == 1) PG8_BAR;
        PG8_WAIT_V(4); PG8_BAR;
        PG8_STAGE(PG8_SB(1, 0), cB + kstep, voffB); PG8_STAGE(PG8_SA(1, 0), cA + kstep, voffA); PG8_STAGE(PG8_SB(1, 1), cB + hstep + kstep, voffB);
        PG8_WAIT_V(6); PG8_BAR;
    }
    for (;;) {
        const bool has_next = S.next(ui + 1, nxt);
        const char* nA = has_next ? (const char*)g.A + (size_t)nxt.pm * tstep : cA; const char* nB = has_next ? (const char*)g.Bt + (size_t)nxt.pn * tstep : cB;
        for (int t = 0; t < nt; t += 2) {
            const bool last = (t == nt - 2);
            const char* a1 = cA + (size_t)(t + 1) * kstep;
            const char* a2 = last ? nA : cA + (size_t)(t + 2) * kstep; const char* b2 = last ? nB : cB + (size_t)(t + 2) * kstep;
            const char* a3 = a2 + kstep; const char* b3 = b2 + kstep;
            if constexpr (SP2) {
            PG8_LDB(B0, 0, 0); PG8_LDB(B1, 0, 1); PG8_SCHED; PG8_LDA(At, 0, 0); PG8_STAGE(PG8_SA(1, 1), a1 + hstep, voffA);
            PG8_WAIT_V(8); PG8_WAIT_L(0); PG8_BAR; PG8_MMA(0, 0, At, B0); PG8_MMA(0, 1, At, B1); PG8_BAR; PG8_SCHED;
            PG8_LDA(At, 0, 1); PG8_STAGE(PG8_SB(0, 0), b2, voffB); PG8_STAGE(PG8_SB(0, 1), b2 + hstep, voffB); PG8_STAGE(PG8_SA(0, 0), a2, voffA);
            PG8_WAIT_V(8); PG8_WAIT_L(0); PG8_BAR; PG8_MMA(1, 0, At, B0); PG8_MMA(1, 1, At, B1); PG8_BAR; PG8_SCHED;
            PG8_LDB(B0, 1, 0); PG8_LDB(B1, 1, 1); PG8_SCHED; PG8_LDA(At, 1, 0); PG8_STAGE(PG8_SA(0, 1), a2 + hstep, voffA);
            PG8_WAIT_V(8); PG8_WAIT_L(0); PG8_BAR; PG8_MMA(0, 0, At, B0); PG8_MMA(0, 1, At, B1); PG8_BAR; PG8_SCHED;
            PG8_LDA(At, 1, 1); PG8_STAGE(PG8_SB(1, 0), b3, voffB); PG8_STAGE(PG8_SB(1, 1), b3 + hstep, voffB); PG8_STAGE(PG8_SA(1, 0), a3, voffA);
            PG8_WAIT_V(8); PG8_WAIT_L(0); PG8_BAR; PG8_MMA(1, 0, At, B0); PG8_MMA(1, 1, At, B1); PG8_BAR; PG8_SCHED;
            } else {
            PG8_LDB(B0, 0, 0); PG8_SCHED; PG8_LDA(At, 0, 0); PG8_STAGE(PG8_SA(1, 1), a1 + hstep, voffA);
            PG8_WAIT_L(8); PG8_BAR; PG8_WAIT_L(0); PG8_MMA(0, 0, At, B0); PG8_BAR; PG8_SCHED;
            PG8_LDB(B1, 0, 1); PG8_STAGE(PG8_SB(0, 0), b2, voffB);
            PG8_BAR; PG8_WAIT_L(0); PG8_MMA(0, 1, At, B1); PG8_BAR;
            PG8_LDA(At, 0, 1); PG8_STAGE(PG8_SA(0, 0), a2, voffA);
            PG8_BAR; PG8_WAIT_L(0); PG8_MMA(1, 0, At, B0); PG8_BAR; PG8_SCHED;
            PG8_STAGE(PG8_SB(0, 1), b2 + hstep, voffB);
            PG8_WAIT_V(6); PG8_BAR; PG8_MMA(1, 1, At, B1); PG8_BAR;
            PG8_LDB(B0, 1, 0); PG8_SCHED; PG8_LDA(At, 1, 0); PG8_STAGE(PG8_SA(0, 1), a2 + hstep, voffA);
            PG8_WAIT_L(8); PG8_BAR; PG8_WAIT_L(0); PG8_MMA(0, 0, At, B0); PG8_BAR; PG8_SCHED;
            PG8_LDB(B1, 1, 1); PG8_STAGE(PG8_SB(1, 0), b3, voffB);
            PG8_BAR; PG8_WAIT_L(0); PG8_MMA(0, 1, At, B1); PG8_BAR;
            PG8_LDA(At, 1, 1); PG8_STAGE(PG8_SA(1, 0), a3, voffA);
            PG8_BAR; PG8_WAIT_L(0); PG8_MMA(1, 0, At, B0); PG8_BAR; PG8_SCHED;
            PG8_STAGE(PG8_SB(1, 1), b3 + hstep, voffB);
            PG8_WAIT_V(6); PG8_BAR; PG8_MMA(1, 1, At, B1); PG8_BAR;
            }
        }
        if constexpr (ALIGN_EPI) { if (wr == 0) PG8_BAR; }
        if constexpr (Epi::CUSTOM) { E.run(acc, cur, wr, wc, fr, fq, lds); }
        else if constexpr (Epi::PERM) {
            const int row0 = cur.pm * BM + wr * 64 + fr, col0 = cur.pn * BM + wc * 32 + 8 * fq;
            E.begin_unit(cur.pn, col0);
#pragma unroll
            for (int ai = 0; ai < 2; ++ai)
#pragma unroll
                for (int m = 0; m < 4; ++m)
#pragma unroll
                    for (int bj = 0; bj < 2; ++bj) E.store8(row0 + ai * HALF + m * 16, col0 + bj * HALF, acc[ai][bj][m][0], acc[ai][bj][m][1]);
        } else {
            const int row0 = cur.pm * BM + wr * 64 + fr, col0 = cur.pn * BM + wc * 32 + 4 * fq;
#pragma unroll
            for (int ai = 0; ai < 2; ++ai)
#pragma unroll
                for (int m = 0; m < 4; ++m)
#pragma unroll
                    for (int bj = 0; bj < 2; ++bj)
#pragma unroll
                        for (int n = 0; n < 2; ++n) E.store4(row0 + ai * HALF + m * 16, col0 + bj * HALF + n * 16, acc[ai][bj][m][n]);
        }
        if (!has_next) break;
#pragma unroll
        for (int a = 0; a < 2; ++a)
#pragma unroll
            for (int b = 0; b < 2; ++b)
#pragma unroll
                for (int m = 0; m < 4; ++m)
#pragma unroll
                    for (int n = 0; n < 2; ++n) acc[a][b][m][n] = (f32x4){0.f, 0.f, 0.f, 0.f};
        cur = nxt; cA = nA; cB = nB; ++ui;
        if constexpr (ALIGN_EPI) { if (wr == 1) PG8_BAR; }
    }
    PG8_WAIT_V(0);
    if constexpr (!ALIGN_EPI) { if (wr == 0) PG8_BAR; }
    PG8_BAR;
#undef PG8_SA
#undef PG8_SB
#undef PG8_STAGE
#undef PG8_LDA
#undef PG8_LDB
#undef PG8_MMA
#undef PG8_WAIT_V
#undef PG8_WAIT_L
#undef PG8_BAR
#undef PG8_SCHED
}

}

template <class Epi>
__device__ __forceinline__ void run_gemm(LAS unsigned char* lds, const h16* A, const h16* Bt, int M, int N, int K, int bid, int nb, const Epi& E, int wgm) {
    pg8::Gemm g{A, Bt, M, N, K};
    pg8::StaticOrder S; S.init(M, N, nb, bid, wgm);
    pg8::gemm_phase(lds, g, S, E);
}

__device__ __forceinline__ u32x2 pack_h4(f32x4 v) {
    h16x2 a = {(h16)v[0], (h16)v[1]}, b = {(h16)v[2], (h16)v[3]};
    u32x2 r; r.x = __builtin_bit_cast(unsigned, a); r.y = __builtin_bit_cast(unsigned, b); return r;
}

__device__ __forceinline__ u32x4 pack_h8(f32x4 a, f32x4 b) { const u32x2 x = pack_h4(a), y = pack_h4(b); return (u32x4){x.x, x.y, y.x, y.y}; }
struct EpiProj {
    static constexpr bool PERM = true, CUSTOM = true;
    h16* cq; float* ssq; h16* ckv; h16* kidx; float* widx; h16* projB; const float* gkv; const float* gk; const float* bk;
    __device__ __forceinline__ void run(const f32x4 (&acc)[2][2][4][2], const pg8::Unit& u, int wr, int wc, int fr, int fq, LAS unsigned char* lds) const {
        const int row0 = u.pm * 256 + wr * 64 + fr, cin = wc * 32 + 8 * fq;
        if (u.pn >= 4) {
            h16* base = projB + (size_t)row0 * 3072 + (u.pn - 4) * 256 + cin;
#pragma unroll
            for (int ai = 0; ai < 2; ++ai)
#pragma unroll
                for (int m = 0; m < 4; ++m)
#pragma unroll
                    for (int bj = 0; bj < 2; ++bj) *(u32x4*)(base + (size_t)(ai * 128 + m * 16) * 3072 + bj * 128) = pack_h8(acc[ai][bj][m][0], acc[ai][bj][m][1]);
            return;
        }
        LAS float* P = (LAS float*)(lds + 131072);
        if (u.pn == 3) {
            if (wc < 2) {
#pragma unroll
                for (int ai = 0; ai < 2; ++ai)
#pragma unroll
                    for (int m = 0; m < 4; ++m) {
                        const f32x4 a = acc[ai][0][m][0], b = acc[ai][0][m][1];
                        float sm = (a[0] + a[1]) + (a[2] + a[3]) + (b[0] + b[1]) + (b[2] + b[3]);
                        float sq = (a[0] * a[0] + a[1] * a[1]) + (a[2] * a[2] + a[3] * a[3]) + (b[0] * b[0] + b[1] * b[1]) + (b[2] * b[2] + b[3] * b[3]);
                        sm += __shfl_xor(sm, 16); sm += __shfl_xor(sm, 32); sq += __shfl_xor(sq, 16); sq += __shfl_xor(sq, 32);
                        if (fq == 0) *(LAS f32x2*)(P + ((ai * 128 + wr * 64 + m * 16 + fr) * 2 + wc) * 2) = (f32x2){sm, sq};
                    }
            }
            asm volatile("s_waitcnt lgkmcnt(0)" ::: "memory"); __builtin_amdgcn_s_barrier(); asm volatile("" ::: "memory");
            if (wc < 2) {
                const f32x4 g0 = *(const f32x4*)(gk + cin), g1 = *(const f32x4*)(gk + cin + 4), b0 = *(const f32x4*)(bk + cin), b1 = *(const f32x4*)(bk + cin + 4);
#pragma unroll
                for (int ai = 0; ai < 2; ++ai)
#pragma unroll
                    for (int m = 0; m < 4; ++m) {
                        const f32x4 pp = *(const LAS f32x4*)(P + (ai * 128 + wr * 64 + m * 16 + fr) * 4);
                        const float mean = (pp[0] + pp[2]) * (1.f / 64.f);
                        const f32x4 xa = acc[ai][0][m][0] - mean, xb = acc[ai][0][m][1] - mean;
                        const float var = fmaxf((pp[1] + pp[3]) * (1.f / 64.f) - mean * mean, 0.f);
                        const float rstd = rsqrtf(var + EPS);
                        *(u32x4*)(kidx + (size_t)((row0 >> 4) + ai * 8 + m) * 1024 + ((cin >> 3) * 16 + fr) * 8) = pack_h8(xa * rstd * g0 + b0, xb * rstd * g1 + b1);
                    }
            } else if (wc == 2 && fq < 2) {
#pragma unroll
                for (int ai = 0; ai < 2; ++ai)
#pragma unroll
                    for (int m = 0; m < 4; ++m) {
                        float* o = widx + (size_t)(row0 + ai * 128 + m * 16) * 16 + 8 * fq;
                        *(f32x4*)o = acc[ai][0][m][0] * (1.f / 32.f); *(f32x4*)(o + 4) = acc[ai][0][m][1] * (1.f / 32.f);
                    }
            }
            return;
        }
#pragma unroll
        for (int ai = 0; ai < 2; ++ai)
#pragma unroll
            for (int m = 0; m < 4; ++m) {
                float ss = 0.f;
#pragma unroll
                for (int bj = 0; bj < 2; ++bj)
#pragma unroll
                    for (int n = 0; n < 2; ++n) { const f32x4 v = acc[ai][bj][m][n]; ss += (v[0] * v[0] + v[1] * v[1]) + (v[2] * v[2] + v[3] * v[3]); }
                ss += __shfl_xor(ss, 16); ss += __shfl_xor(ss, 32);
                if (fq == 0) P[(ai * 128 + wr * 64 + m * 16 + fr) * 4 + wc] = ss;
            }
        asm volatile("s_waitcnt lgkmcnt(0)" ::: "memory"); __builtin_amdgcn_s_barrier(); asm volatile("" ::: "memory");
        if (u.pn < 2) {
            h16* base = cq + (size_t)row0 * 512 + u.pn * 256 + cin;
#pragma unroll
            for (int ai = 0; ai < 2; ++ai)
#pragma unroll
                for (int m = 0; m < 4; ++m) {
#pragma unroll
                    for (int bj = 0; bj < 2; ++bj) *(u32x4*)(base + (size_t)(ai * 128 + m * 16) * 512 + bj * 128) = pack_h8(acc[ai][bj][m][0], acc[ai][bj][m][1]);
                    if (wc == 0 && fq == 0) { const f32x4 pp = *(const LAS f32x4*)(P + (ai * 128 + wr * 64 + m * 16 + fr) * 4); ssq[(size_t)(row0 + ai * 128 + m * 16) * 2 + u.pn] = (pp[0] + pp[1]) + (pp[2] + pp[3]); }
                }
        } else {
            h16* base = ckv + (size_t)row0 * 256 + cin;
            f32x4 g[2][2];
#pragma unroll
            for (int bj = 0; bj < 2; ++bj)
#pragma unroll
                for (int n = 0; n < 2; ++n) g[bj][n] = *(const f32x4*)(gkv + cin + bj * 128 + 4 * n);
#pragma unroll
            for (int ai = 0; ai < 2; ++ai)
#pragma unroll
                for (int m = 0; m < 4; ++m) {
                    const f32x4 pp = *(const LAS f32x4*)(P + (ai * 128 + wr * 64 + m * 16 + fr) * 4);
                    const float rstd = rsqrtf(((pp[0] + pp[1]) + (pp[2] + pp[3])) * (1.f / 256.f) + EPS);
#pragma unroll
                    for (int bj = 0; bj < 2; ++bj) *(u32x4*)(base + (size_t)(ai * 128 + m * 16) * 256 + bj * 128) = pack_h8(acc[ai][bj][m][0] * rstd * g[bj][0], acc[ai][bj][m][1] * rstd * g[bj][1]);
                }
        }
    }
};
struct EpiQ {
    static constexpr bool PERM = true, CUSTOM = true;
    h16* qabs; h16* iq; const float* gq; const float* ssq;
    __device__ __forceinline__ void run(const f32x4 (&acc)[2][2][4][2], const pg8::Unit& u, int wr, int wc, int fr, int fq, LAS unsigned char* lds) const {
        const int row0 = u.pm * 256 + wr * 64 + fr, cin = wc * 32 + 8 * fq;
        float rr[2][4];
#pragma unroll
        for (int ai = 0; ai < 2; ++ai)
#pragma unroll
            for (int m = 0; m < 4; ++m) { const f32x2 s2 = *(const f32x2*)(ssq + (size_t)(row0 + ai * 128 + m * 16) * 2); rr[ai][m] = rsqrtf((s2[0] + s2[1]) * (1.f / 512.f) + EPS); }
        if (u.pn >= 8) {
            h16* base = iq + (size_t)row0 * 1024 + ((((wc & 1) * 4 + fq) * 16) + (u.pn - 8) * 4 + (wc >> 1)) * 8;
#pragma unroll
            for (int ai = 0; ai < 2; ++ai)
#pragma unroll
                for (int m = 0; m < 4; ++m)
#pragma unroll
                    for (int bj = 0; bj < 2; ++bj) *(u32x4*)(base + (size_t)(ai * 128 + m * 16) * 1024 + bj * 16) = pack_h8(acc[ai][bj][m][0] * rr[ai][m], acc[ai][bj][m][1] * rr[ai][m]);
            return;
        }
        LAS float* P = (LAS float*)(lds + 131072);
#pragma unroll
        for (int ai = 0; ai < 2; ++ai)
#pragma unroll
            for (int m = 0; m < 4; ++m) {
                float ss = 0.f;
#pragma unroll
                for (int bj = 0; bj < 2; ++bj)
#pragma unroll
                    for (int n = 0; n < 2; ++n) { const f32x4 v = acc[ai][bj][m][n]; ss += (v[0] * v[0] + v[1] * v[1]) + (v[2] * v[2] + v[3] * v[3]); }
                ss += __shfl_xor(ss, 16); ss += __shfl_xor(ss, 32);
                if (fq == 0) P[(ai * 128 + wr * 64 + m * 16 + fr) * 4 + wc] = ss * (rr[ai][m] * rr[ai][m]);
            }
        asm volatile("s_waitcnt lgkmcnt(0)" ::: "memory"); __builtin_amdgcn_s_barrier(); asm volatile("" ::: "memory");
        h16* base = qabs + (size_t)row0 * 2048 + u.pn * 256 + cin;
        f32x4 g[2][2];
#pragma unroll
        for (int bj = 0; bj < 2; ++bj)
#pragma unroll
            for (int n = 0; n < 2; ++n) g[bj][n] = *(const f32x4*)(gq + cin + bj * 128 + 4 * n) * 0.0625f;
#pragma unroll
        for (int ai = 0; ai < 2; ++ai)
#pragma unroll
            for (int m = 0; m < 4; ++m) {
                const f32x4 pp = *(const LAS f32x4*)(P + (ai * 128 + wr * 64 + m * 16 + fr) * 4);
                const float rstd = rsqrtf(((pp[0] + pp[1]) + (pp[2] + pp[3])) * (1.f / 256.f) + EPS) * rr[ai][m];
#pragma unroll
                for (int bj = 0; bj < 2; ++bj) *(u32x4*)(base + (size_t)(ai * 128 + m * 16) * 2048 + bj * 128) = pack_h8(acc[ai][bj][m][0] * rstd * g[bj][0], acc[ai][bj][m][1] * rstd * g[bj][1]);
            }
    }
};
struct EpiF16 {
    static constexpr bool PERM = true, CUSTOM = false;
    h16* o; const float* bias; mutable f32x4 bz[2][2]; mutable int cbase;
    __device__ __forceinline__ void begin_unit(int, int col0) const {
        cbase = col0;
#pragma unroll
        for (int bj = 0; bj < 2; ++bj)
#pragma unroll
            for (int n = 0; n < 2; ++n) bz[bj][n] = bias ? *(const f32x4*)(bias + col0 + bj * 128 + 4 * n) : (f32x4){0.f, 0.f, 0.f, 0.f};
    }
    __device__ __forceinline__ void store8(int row, int col, f32x4 v0, f32x4 v1) const {
        const int bj = (col - cbase) >> 7;
        *(u32x4*)(o + (size_t)row * 2048 + col) = pack_h8(v0 + (bj ? bz[1][0] : bz[0][0]), v1 + (bj ? bz[1][1] : bz[0][1]));
    }
};
struct EpiMlp1 {
    static constexpr bool PERM = true, CUSTOM = false;
    LAS const h16* b1l; h16* a; mutable f32x4 bz[2][2]; mutable int cbase;
    __device__ __forceinline__ void begin_unit(int, int col0) const {
        cbase = col0;
#pragma unroll
        for (int bj = 0; bj < 2; ++bj)
#pragma unroll
            for (int n = 0; n < 2; ++n) { const h16x4 hb = *(LAS const h16x4*)(b1l + col0 + bj * 128 + 4 * n); bz[bj][n] = (f32x4){(float)hb[0], (float)hb[1], (float)hb[2], (float)hb[3]}; }
    }
    __device__ __forceinline__ f32x4 actb(f32x4 v, f32x4 b) const {
        f32x4 z = v + b;
#pragma unroll
        for (int j = 0; j < 4; ++j) { const float r = fmaxf(z[j], 0.f); z[j] = r * r; }
        return z;
    }
    __device__ __forceinline__ void store8(int row, int col, f32x4 v0, f32x4 v1) const {
        const int bj = (col - cbase) >> 7;
        *(u32x4*)(a + (size_t)row * D_FF + col) = pack_h8(actb(v0, bj ? bz[1][0] : bz[0][0]), actb(v1, bj ? bz[1][1] : bz[0][1]));
    }
};
template <bool SCALE>
__device__ __forceinline__ void transpose_item(const float* __restrict__ src, int ld, int k0, int n0, int nvalid, const float* __restrict__ kscale,
                                               h16* __restrict__ dst, int dst_ld, int dst_row0, int dst_k0, LAS float* scr, int lane) {
    const int n = lane & 31, nn = n < nvalid ? n : nvalid - 1;
    const float msk = n < nvalid ? 1.f : 0.f;
    const float* sp = src + (size_t)(k0 + (lane >> 5)) * ld + n0 + nn;
    float v[32];
#pragma unroll
    for (int i = 0; i < 32; ++i) v[i] = sp[(size_t)(2 * i) * ld];
    if (SCALE) {
        float sc[32];
#pragma unroll
        for (int i = 0; i < 32; ++i) sc[i] = kscale[k0 + 2 * i + (lane >> 5)];
#pragma unroll
        for (int i = 0; i < 32; ++i) v[i] *= sc[i];
    }
#pragma unroll
    for (int i = 0; i < 32; ++i) scr[(2 * i + (lane >> 5)) * 33 + n] = v[i] * msk;
    LDS_WAIT(); asm volatile("" ::: "memory");
    const int c = lane & 7;
#pragma unroll
    for (int j = 0; j < 4; ++j) {
        const int nr = (lane >> 3) + 8 * j; const LAS float* s = scr + (8 * c) * 33 + nr;
        h16x8 o;
#pragma unroll
        for (int q = 0; q < 8; ++q) o[q] = (h16)s[q * 33];
        *(h16x8*)(dst + (size_t)(dst_row0 + nr) * dst_ld + dst_k0 + 8 * c) = o;
    }
    LDS_WAIT(); asm volatile("" ::: "memory");
}

__device__ __forceinline__ void phase_prep(const Params& p, LAS unsigned char* lds, int bid, int nb) {
    const int tid = threadIdx.x, lane = tid & 63, wave = tid >> 6;
    unsigned char* ws = p.ws;
    __syncthreads();
    {
        LAS f32x4* cact = (LAS f32x4*)lds;
        LAS float* red = (LAS float*)(lds + 32768);
        for (int i = tid; i < 4 * 2048; i += NTHREADS) { const int b = i >> 11, k = i & 2047; const float v = p.c[b * 2048 + k]; ((LAS float*)cact)[k * 4 + b] = v / (1.f + __expf(-v)); }
        __syncthreads();
        float* mod = (float*)(ws + WS_MOD);
        for (int cgp = bid; cgp < 192; cgp += nb) {
            const int col = cgp * 64 + lane;
            float a0 = 0.f, a1 = 0.f, a2 = 0.f, a3 = 0.f;
            const float* wp = p.w_ada + (size_t)(wave * 256) * 12288 + col;
            for (int kb = 0; kb < 256; kb += 32) {
                float wv[32];
#pragma unroll
                for (int j = 0; j < 32; ++j) wv[j] = wp[(size_t)(kb + j) * 12288];
#pragma unroll
                for (int j = 0; j < 32; ++j) { const f32x4 cv = cact[wave * 256 + kb + j]; a0 += cv[0] * wv[j]; a1 += cv[1] * wv[j]; a2 += cv[2] * wv[j]; a3 += cv[3] * wv[j]; }
            }
            red[(wave * 4 + 0) * 64 + lane] = a0; red[(wave * 4 + 1) * 64 + lane] = a1; red[(wave * 4 + 2) * 64 + lane] = a2; red[(wave * 4 + 3) * 64 + lane] = a3;
            __syncthreads();
            if (tid < 256) {
                const int b = tid >> 6, l = tid & 63; float s = 0.f;
#pragma unroll
                for (int w = 0; w < 8; ++w) s += red[(w * 4 + b) * 64 + l];
                const int cc = cgp * 64 + l;
                mod[b * 12288 + cc] = s + p.b_ada[cc];
            }
            __syncthreads();
        }
    }
    LAS float* scr = (LAS float*)(lds + wave * 16384);
    const int gw = bid * NWAVES + wave, NGW = nb * NWAVES;
    constexpr int I_IN = 32 * 128, I_1 = 32 * 256, I_2 = 128 * 64, I_OUT = 32 * 64, I_IQ = 8 * 32, I_UV = 8 * 4 * 4, I_QA = 8 * 8 * 8;
    constexpr int NITEMS = I_IN + I_1 + I_2 + I_OUT + I_IQ + I_UV + I_QA;
    const bool bal = (nb == 256);
    const int nextra = bal ? 6 : 0, base_it = bal ? 3072 : 0;
    const int nstr = (NITEMS - I_QA - base_it - gw + NGW - 1) / NGW;
    for (int kk = 0; kk < nextra + nstr; ++kk) {
        int it;
        if (kk < nextra) { if (bid < 192) continue; it = ((bid - 192) * NWAVES + wave) + 512 * kk; }
        else it = base_it + gw + (kk - nextra) * NGW;
        int r = it;
        const float* src; int ld, k0, n0, nvalid = 32, dld, drow0; const float* ksc = nullptr; h16* dst;
        if (r < I_IN) {
            const int kb = r / 128, nbk = r % 128, n0d = nbk * 32;
            if (n0d >= 864 && n0d < 1024) continue;
            src = p.w_in; ld = IN_COLS; k0 = kb * 64; n0 = n0d < 1024 ? n0d : n0d - 176; nvalid = (n0d == 832) ? 16 : 32; dst = (h16*)(ws + WS_BT_IN); dld = 2048; drow0 = n0d;
        } else if ((r -= I_IN) < I_1) { const int kb = r / 256, nbk = r % 256; src = p.w_mlp1; ld = D_FF; k0 = kb * 64; n0 = nbk * 32; dst = (h16*)(ws + WS_BT_1); dld = 2048; drow0 = n0; }
        else if ((r -= I_1) < I_2) { const int kb = r / 64, nbk = r % 64; src = p.w_mlp2; ld = 2048; k0 = kb * 64; n0 = nbk * 32; dst = (h16*)(ws + WS_BT_2); dld = 8192; drow0 = n0; }
        else if ((r -= I_2) < I_OUT) { const int kb = r / 64, nbk = r % 64; src = p.w_out; ld = 2048; k0 = kb * 64; n0 = nbk * 32; dst = (h16*)(ws + WS_BT_OUT); dld = 2048; drow0 = n0; }
        else if ((r -= I_OUT) < I_IQ) { const int kb = r / 32, nbk = r % 32; src = p.w_iq; ld = 1024; k0 = kb * 64; n0 = nbk * 32; ksc = p.cq_norm_g; dst = (h16*)(ws + WS_BT_Q); dld = 512; drow0 = 2048 + n0; }
        else { r -= I_IQ; const int h = r / 16, kb = (r % 16) / 4, nbk = r % 4; src = p.w_uv + (size_t)h * 256 * 128; ld = 128; k0 = kb * 64; n0 = nbk * 32; dst = (h16*)(ws + WS_WUVT) + (size_t)h * 128 * 256; dld = 256; drow0 = n0; }
        if (ksc) transpose_item<true>(src, ld, k0, n0, nvalid, ksc, dst, dld, drow0, k0, scr, lane);
        else transpose_item<false>(src, ld, k0, n0, nvalid, ksc, dst, dld, drow0, k0, scr, lane);
    }
    for (int r = gw; r < I_QA; r += NGW) {
        {
            const int h = r / 64, kb = (r % 64) / 8, cb = r % 8, k0 = kb * 64, c0 = cb * 32;
#pragma unroll 8
            for (int e = lane; e < 128 * 32; e += 64) { const int d = e >> 5, c = e & 31; scr[e] = p.w_uk[((size_t)h * 128 + d) * 256 + c0 + c]; }
            LDS_WAIT(); asm volatile("" ::: "memory");
            float acc[32];
#pragma unroll
            for (int c = 0; c < 32; ++c) acc[c] = 0.f;
            const float* uq = p.w_uq + (size_t)(k0 + lane) * 1024 + h * 128;
#pragma unroll 1
            for (int d0 = 0; d0 < 128; d0 += 4) {
                const f32x4 a = *(const f32x4*)(uq + d0);
#pragma unroll
                for (int dd = 0; dd < 4; ++dd) {
#pragma unroll
                    for (int c4 = 0; c4 < 8; ++c4) { const f32x4 w = *(const LAS f32x4*)(scr + (d0 + dd) * 32 + c4 * 4);
                        acc[c4 * 4 + 0] += a[dd] * w[0]; acc[c4 * 4 + 1] += a[dd] * w[1]; acc[c4 * 4 + 2] += a[dd] * w[2]; acc[c4 * 4 + 3] += a[dd] * w[3]; }
                    asm volatile("" ::: "memory");
                }
            }
            const float gk = p.cq_norm_g[k0 + lane];
            h16* dst = (h16*)(ws + WS_BT_Q);
            h16* dp = dst + (size_t)(h * 256 + c0) * 512 + k0 + lane;
#pragma unroll
            for (int c = 0; c < 32; ++c) { dp[(size_t)c * 512] = (h16)(acc[c] * gk); if ((c & 3) == 3) asm volatile("" ::: "memory"); }
            LDS_WAIT(); asm volatile("" ::: "memory");
        }
    }
    {
        u32x4* z = (u32x4*)((h16*)(ws + WS_BT_IN) + (size_t)848 * 2048);
        const int n16 = 176 * 2048 * 2 / 16;
        for (int i = bid * NTHREADS + tid; i < n16; i += nb * NTHREADS) z[i] = (u32x4){0u, 0u, 0u, 0u};
    }
}

__device__ __forceinline__ void phase_normmod(const float* __restrict__ xin, const float* __restrict__ g, const float* __restrict__ mod, int sh_off, int sc_off, h16* __restrict__ hout, int bid, int nb) {
    const int tid = threadIdx.x, lane = tid & 63, wave = tid >> 6;
    for (int t = bid * NWAVES + wave; t < T; t += nb * NWAVES) {
        const int b = t >> 12;
        const f32x4* xr = (const f32x4*)(xin + (size_t)t * 2048) + lane;
        f32x4 v[8]; float ss = 0.f;
#pragma unroll
        for (int j = 0; j < 8; ++j) { v[j] = xr[64 * j]; ss += (v[j][0] * v[j][0] + v[j][1] * v[j][1]) + (v[j][2] * v[j][2] + v[j][3] * v[j][3]); }
        const float rstd = rsqrtf(wave_sum(ss) * (1.f / 2048.f) + EPS);
        const float* mb = mod + b * 12288;
        u32x2* o = (u32x2*)(hout + (size_t)t * 2048) + lane;
#pragma unroll
        for (int j = 0; j < 8; ++j) {
            const int d = (lane + 64 * j) * 4;
            const f32x4 gg = *(const f32x4*)(g + d), sc = *(const f32x4*)(mb + sc_off + d), sh = *(const f32x4*)(mb + sh_off + d);
            f32x4 y = (v[j] * rstd) * gg;
            y = y * (sc + 1.f) + sh;
            o[64 * j] = pack_h4(y);
        }
    }
}

__device__ __forceinline__ void phase_normmod2(const Params& p, int bid, int nb) {
    const int tid = threadIdx.x, lane = tid & 63, wave = tid >> 6;
    const float* mod = (const float*)(p.ws + WS_MOD); const h16* y6 = (const h16*)(p.ws + WS_Y6); h16* hout = (h16*)(p.ws + WS_R2);
    for (int t = bid * NWAVES + wave; t < T; t += nb * NWAVES) {
        const int b = t >> 12; const float* mb = mod + b * 12288;
        const f32x4* xr = (const f32x4*)(p.x + (size_t)t * 2048) + lane;
        const u32x2* yr = (const u32x2*)(y6 + (size_t)t * 2048) + lane;
        f32x4 v[8]; float ss = 0.f;
#pragma unroll
        for (int j = 0; j < 8; ++j) {
            const int d = (lane + 64 * j) * 4;
            const f32x4 xv = xr[64 * j]; const h16x4 yh = __builtin_bit_cast(h16x4, yr[64 * j]); const f32x4 g1 = *(const f32x4*)(mb + 2 * 2048 + d);
            const f32x4 yv = {(float)yh[0], (float)yh[1], (float)yh[2], (float)yh[3]};
            v[j] = xv + g1 * yv;
            ss += (v[j][0] * v[j][0] + v[j][1] * v[j][1]) + (v[j][2] * v[j][2] + v[j][3] * v[j][3]);
        }
        const float rstd = rsqrtf(wave_sum(ss) * (1.f / 2048.f) + EPS);
        u32x2* o = (u32x2*)(hout + (size_t)t * 2048) + lane;
#pragma unroll
        for (int j = 0; j < 8; ++j) {
            const int d = (lane + 64 * j) * 4;
            const f32x4 gg = *(const f32x4*)(p.norm2_g + d), sc = *(const f32x4*)(mb + 4 * 2048 + d), sh = *(const f32x4*)(mb + 3 * 2048 + d);
            f32x4 y = (v[j] * rstd) * gg;
            y = y * (sc + 1.f) + sh;
            o[64 * j] = pack_h4(y);
        }
    }
}
__device__ __forceinline__ void phase_final(const Params& p, int bid, int nb) {
    const int tid = threadIdx.x, lane = tid & 63, wave = tid >> 6;
    const float* mod = (const float*)(p.ws + WS_MOD); const h16* y6 = (const h16*)(p.ws + WS_Y6); const h16* m16 = (const h16*)(p.ws + WS_R2);
    for (int t = bid * NWAVES + wave; t < T; t += nb * NWAVES) {
        const int b = t >> 12; const float* mb = mod + b * 12288;
        const f32x4* xr = (const f32x4*)(p.x + (size_t)t * 2048) + lane;
        const u32x2* yr = (const u32x2*)(y6 + (size_t)t * 2048) + lane;
        const u32x2* mr = (const u32x2*)(m16 + (size_t)t * 2048) + lane;
        f32x4* orow = (f32x4*)(p.out + (size_t)t * 2048) + lane;
#pragma unroll
        for (int j = 0; j < 8; ++j) {
            const int d = (lane + 64 * j) * 4;
            const f32x4 xv = xr[64 * j]; const h16x4 yh = __builtin_bit_cast(h16x4, yr[64 * j]), mh = __builtin_bit_cast(h16x4, mr[64 * j]);
            const f32x4 g1 = *(const f32x4*)(mb + 2 * 2048 + d), g2 = *(const f32x4*)(mb + 5 * 2048 + d);
            const f32x4 yv = {(float)yh[0], (float)yh[1], (float)yh[2], (float)yh[3]}, mv = {(float)mh[0], (float)mh[1], (float)mh[2], (float)mh[3]};
            orow[64 * j] = (xv + g1 * yv) + g2 * mv;
        }
    }
}

__device__ __forceinline__ void phase_rows3(const Params& p, int bid, int nb) {
    const int tid = threadIdx.x, lane = tid & 63, wave = tid >> 6;
    unsigned char* ws = p.ws;
    const h16* projB = (const h16*)(ws + WS_PROJB);
    h16* ymix = (h16*)(ws + WS_R2);
    f32x4 w0[4], w1[4], w2[4], bb[4], gn[4];
#pragma unroll
    for (int q4 = 0; q4 < 4; ++q4) {
        const int c = lane * 16 + q4 * 4;
        w0[q4] = *(const f32x4*)(p.conv_w + c); w1[q4] = *(const f32x4*)(p.conv_w + 1024 + c); w2[q4] = *(const f32x4*)(p.conv_w + 2048 + c);
        bb[q4] = *(const f32x4*)(p.conv_b + c); gn[q4] = *(const f32x4*)(p.conv_out_norm_g + c);
    }
    for (int t = bid * NWAVES + wave; t < T; t += nb * NWAVES) {
        const int tl = t & (SEQ - 1);
        const h16* pb = projB + (size_t)t * 3072 + lane * 16;
        const int d1 = tl >= 1 ? 1 : 0, d2 = tl >= 2 ? 2 : 0;
        const float m1 = tl >= 1 ? 1.f : 0.f, m2 = tl >= 2 ? 1.f : 0.f;
        h16x8 gbv[2], cv[3][2], hv[3][2];
#pragma unroll
        for (int hh = 0; hh < 2; ++hh) {
            gbv[hh] = *(const h16x8*)(pb + hh * 8);
            cv[2][hh] = *(const h16x8*)(pb + 1024 + hh * 8); hv[2][hh] = *(const h16x8*)(pb + 2048 + hh * 8);
            cv[1][hh] = *(const h16x8*)(pb - (size_t)d1 * 3072 + 1024 + hh * 8); hv[1][hh] = *(const h16x8*)(pb - (size_t)d1 * 3072 + 2048 + hh * 8);
            cv[0][hh] = *(const h16x8*)(pb - (size_t)d2 * 3072 + 1024 + hh * 8); hv[0][hh] = *(const h16x8*)(pb - (size_t)d2 * 3072 + 2048 + hh * 8);
        }
        float y[16], ss = 0.f;
#pragma unroll
        for (int i = 0; i < 16; ++i) {
            const int hh = i >> 3, q = i & 7, q4 = i >> 2, qq = i & 3;
            const float u0 = (float)cv[0][hh][q] * (float)hv[0][hh][q] * m2, u1 = (float)cv[1][hh][q] * (float)hv[1][hh][q] * m1, u2 = (float)cv[2][hh][q] * (float)hv[2][hh][q];
            float sacc = bb[q4][qq] + w0[q4][qq] * u0; sacc = sacc + w1[q4][qq] * u1; sacc = sacc + w2[q4][qq] * u2;
            y[i] = (float)gbv[hh][q] * sacc; ss += y[i] * y[i];
        }
        ss += __shfl_xor(ss, 1); ss += __shfl_xor(ss, 2); ss += __shfl_xor(ss, 4);
        const float rstd = rsqrtf(ss * (1.f / 128.f) + EPS);
        h16x8 o0, o1;
#pragma unroll
        for (int q = 0; q < 8; ++q) { o0[q] = (h16)(y[q] * rstd * gn[q >> 2][q & 3]); o1[q] = (h16)(y[8 + q] * rstd * gn[2 + (q >> 2)][q & 3]); }
        *(h16x8*)(ymix + (size_t)t * 2048 + 1024 + lane * 16) = o0;
        *(h16x8*)(ymix + (size_t)t * 2048 + 1024 + lane * 16 + 8) = o1;
    }
}

__constant__ unsigned char c_bucket_thr[15] = {19, 21, 24, 27, 31, 35, 40, 46, 52, 59, 67, 77, 87, 99, 113};
__device__ __forceinline__ int t5_bucket(int n) {
    if (n < 16) return n;
    int bkt = 16;
#pragma unroll
    for (int i = 0; i < 15; ++i) bkt += (n >= (int)c_bucket_thr[i]) ? 1 : 0;
    return bkt;
}
typedef float f32x16 __attribute__((ext_vector_type(16)));
__device__ __forceinline__ float next_up(float x) {
    const unsigned u = __float_as_uint(x);
    if ((u << 1) == 0u) return __uint_as_float(1u);
    return __uint_as_float((u >> 31) ? u - 1u : u + 1u);
}
__device__ __forceinline__ float qinv_upper(float p) {
    const float pt = p < 0.5f ? p : 1.f - p;
    const float tt = sqrtf(-2.f * __logf(fmaxf(pt, 1e-7f)));
    const float z = tt - (2.515517f + tt * (0.802853f + tt * 0.010328f)) / (1.f + tt * (1.432788f + tt * (0.189269f + tt * 0.001308f)));
    return p < 0.5f ? z : -z;
}
__device__ __forceinline__ int wave_sum_dpp(int x) {
    x += __builtin_amdgcn_update_dpp(0, x, 0xB1, 0xf, 0xf, false);
    x += __builtin_amdgcn_update_dpp(0, x, 0x4E, 0xf, 0xf, false);
    x += __builtin_amdgcn_update_dpp(0, x, 0x124, 0xf, 0xf, false);
    x += __builtin_amdgcn_update_dpp(0, x, 0x128, 0xf, 0xf, false);
    return (__builtin_amdgcn_readlane(x, 0) + __builtin_amdgcn_readlane(x, 16)) + (__builtin_amdgcn_readlane(x, 32) + __builtin_amdgcn_readlane(x, 48));
}
__device__ __forceinline__ float dpp_f(float v, const int ctrl_sel) {
    const int i = __float_as_int(v);
    int r;
    if (ctrl_sel == 0) r = __builtin_amdgcn_update_dpp(i, i, 0xB1, 0xf, 0xf, false);
    else if (ctrl_sel == 1) r = __builtin_amdgcn_update_dpp(i, i, 0x4E, 0xf, 0xf, false);
    else if (ctrl_sel == 2) r = __builtin_amdgcn_update_dpp(i, i, 0x124, 0xf, 0xf, false);
    else r = __builtin_amdgcn_update_dpp(i, i, 0x128, 0xf, 0xf, false);
    return __int_as_float(r);
}
__device__ __forceinline__ float wave_sum_f_dpp(float v) {
    v += dpp_f(v, 0); v += dpp_f(v, 1); v += dpp_f(v, 2); v += dpp_f(v, 3);
    const float a = __int_as_float(__builtin_amdgcn_readlane(__float_as_int(v), 0)), b = __int_as_float(__builtin_amdgcn_readlane(__float_as_int(v), 16));
    const float c = __int_as_float(__builtin_amdgcn_readlane(__float_as_int(v), 32)), d = __int_as_float(__builtin_amdgcn_readlane(__float_as_int(v), 48));
    return (a + b) + (c + d);
}
__device__ __forceinline__ float wave_min_dpp(float v) {
    v = fminf(v, dpp_f(v, 0)); v = fminf(v, dpp_f(v, 1)); v = fminf(v, dpp_f(v, 2)); v = fminf(v, dpp_f(v, 3));
    const float a = __int_as_float(__builtin_amdgcn_readlane(__float_as_int(v), 0)), b = __int_as_float(__builtin_amdgcn_readlane(__float_as_int(v), 16));
    const float c = __int_as_float(__builtin_amdgcn_readlane(__float_as_int(v), 32)), d = __int_as_float(__builtin_amdgcn_readlane(__float_as_int(v), 48));
    return fminf(fminf(a, b), fminf(c, d));
}
__device__ __forceinline__ float wave_max_dpp(float v) {
    v = fmaxf(v, dpp_f(v, 0)); v = fmaxf(v, dpp_f(v, 1)); v = fmaxf(v, dpp_f(v, 2)); v = fmaxf(v, dpp_f(v, 3));
    const float a = __int_as_float(__builtin_amdgcn_readlane(__float_as_int(v), 0)), b = __int_as_float(__builtin_amdgcn_readlane(__float_as_int(v), 16));
    const float c = __int_as_float(__builtin_amdgcn_readlane(__float_as_int(v), 32)), d = __int_as_float(__builtin_amdgcn_readlane(__float_as_int(v), 48));
    return fmaxf(fmaxf(a, b), fmaxf(c, d));
}
typedef short s16x2 __attribute__((ext_vector_type(2)));
__device__ __forceinline__ h16x2 relu_pk(h16x2 x) { const s16x2 z = {0, 0}; return __builtin_bit_cast(h16x2, __builtin_elementwise_max(__builtin_bit_cast(s16x2, x), z)); }
__device__ __forceinline__ float relu_asm(float x) { const int i = __builtin_bit_cast(int, x); return __builtin_bit_cast(float, i > 0 ? i : 0); }
constexpr int IDX_CHUNK = 512;
constexpr int IDX_NG = IDX_CHUNK / 64;
constexpr int IDX_CHB = IDX_CHUNK * 128;
__device__ __forceinline__ void phase_index(const Params& p, LAS unsigned char* lds, int bid, int nb) {
    const int tid = threadIdx.x, lane = tid & 63, wave = __builtin_amdgcn_readfirstlane(tid >> 6), k16 = lane & 15, g = lane >> 4;
    unsigned char* ws = p.ws;
    const h16* iq = (const h16*)(ws + WS_IQ); const h16* kidx = (const h16*)(ws + WS_KIDX); const float* widx = (const float*)(ws + WS_WIDX);
    unsigned short* sel = (unsigned short*)(ws + WS_SEL);
    LAS float* S = (LAS float*)lds;
    const int kq0 = k16 >> 2;
    const int nitems = (nb == 256) ? 8 : (2048 + nb - 1) / nb;
    for (int ii = 0; ii < nitems; ++ii) {
        int b, i;
        if (nb == 256) { b = (bid & 7) >> 1; const int idx = ((bid >> 3) << 1) | (bid & 1); const int pr = ii >> 1; i = (ii & 1) ? (128 * pr + idx) : (128 * pr + 127 - idx); }
        else { const int item = bid + ii * nb; if (item >= 2048) break; b = item >> 9; i = item & 511; }
        if (i < 32) continue;
        const int t0 = i * 8;
        const int tq = t0 + wave;
        const size_t tg = (size_t)b * SEQ + tq;
        const h16* kb = kidx + (size_t)b * SEQ * 64;
        const int nhalf = ((t0 + 7) >> 5) + 1;
        h16x8 Af[8][2]; u32x2 W2[8];
#pragma unroll
        for (int q = 0; q < 8; ++q) {
            const size_t tgq = (size_t)b * SEQ + t0 + q;
            const h16* ap = iq + tgq * 1024 + lane * 8;
            Af[q][0] = *(const h16x8*)ap; Af[q][1] = *(const h16x8*)(ap + 512);
            const f32x4 wv = *(const f32x4*)(widx + tgq * 16 + 4 * g);
            h16x4 wsel;
#pragma unroll
            for (int r = 0; r < 4; ++r) { const h16 whi = (h16)wv[r]; const h16 wlo = (h16)(wv[r] - (float)whi); wsel[r] = (k16 & 2) ? (h16)0.f : ((k16 & 1) ? wlo : whi); }
            W2[q] = __builtin_bit_cast(u32x2, wsel);
        }
        {
            h16x8 Bc[4];
            {
                const h16* rp = kb + (size_t)wave * 2048 + lane * 8;
#pragma unroll
                for (int x = 0; x < 2; ++x)
#pragma unroll
                    for (int ks = 0; ks < 2; ++ks) Bc[2 * x + ks] = *(const h16x8*)(rp + x * 1024 + ks * 512);
            }
#pragma unroll 1
            for (int gi = wave; gi < nhalf; gi += 8) {
                const int gn = (gi + 8 < nhalf) ? gi + 8 : gi;
                int kq = kq0; asm volatile("" : "+v"(kq));
                h16x8 Bn[4];
                {
                    const h16* rp = kb + (size_t)gn * 2048 + lane * 8;
#pragma unroll
                    for (int x = 0; x < 2; ++x)
#pragma unroll
                        for (int ks = 0; ks < 2; ++ks) Bn[2 * x + ks] = *(const h16x8*)(rp + x * 1024 + ks * 512);
                }
                f32x4 accc[2], accn[2], D2p = {0.f, 0.f, 0.f, 0.f};
#pragma unroll
                for (int x = 0; x < 2; ++x) accc[x] = __builtin_amdgcn_mfma_f32_16x16x32_f16(Af[0][0], Bc[2 * x], (f32x4){0.f, 0.f, 0.f, 0.f}, 0, 0, 0);
#pragma unroll
                for (int x = 0; x < 2; ++x) accc[x] = __builtin_amdgcn_mfma_f32_16x16x32_f16(Af[0][1], Bc[2 * x + 1], accc[x], 0, 0, 0);
                __builtin_amdgcn_sched_barrier(0);
#pragma unroll
                for (int q = 0; q < 8; ++q) {
                    if (q < 7) {
#pragma unroll
                        for (int x = 0; x < 2; ++x) accn[x] = __builtin_amdgcn_mfma_f32_16x16x32_f16(Af[q + 1][0], Bc[2 * x], (f32x4){0.f, 0.f, 0.f, 0.f}, 0, 0, 0);
#pragma unroll
                        for (int x = 0; x < 2; ++x) accn[x] = __builtin_amdgcn_mfma_f32_16x16x32_f16(Af[q + 1][1], Bc[2 * x + 1], accn[x], 0, 0, 0);
                    }
                    h16x2 qv[4];
#pragma unroll
                    for (int e = 0; e < 2; ++e) {
                        const f32x2 r01 = {accc[e][0], accc[e][1]}, r23 = {accc[e][2], accc[e][3]};
                        qv[2 * e] = relu_pk(__builtin_convertvector(r01, h16x2)); qv[2 * e + 1] = relu_pk(__builtin_convertvector(r23, h16x2));
                    }
                    h16x8 B2; B2[0] = qv[0][0]; B2[1] = qv[0][1]; B2[2] = qv[1][0]; B2[3] = qv[1][1]; B2[4] = qv[2][0]; B2[5] = qv[2][1]; B2[6] = qv[3][0]; B2[7] = qv[3][1];
                    const u32x4 a2 = {kq == 0 ? W2[q].x : 0u, kq == 0 ? W2[q].y : 0u, kq == 1 ? W2[q].x : 0u, kq == 1 ? W2[q].y : 0u};
                    const f32x4 D2 = __builtin_amdgcn_mfma_f32_16x16x32_f16(__builtin_bit_cast(h16x8, a2), B2, (f32x4){0.f, 0.f, 0.f, 0.f}, 0, 0, 0);
                    if (q > 0) { if (lane < 32) S[(q - 1) * 4096 + gi * 32 + lane] = D2p[0] + D2p[1]; }
                    D2p = D2;
#pragma unroll
                    for (int x = 0; x < 2; ++x) accc[x] = accn[x];
                    __builtin_amdgcn_sched_barrier(0);
                }
                if (lane < 32) S[7 * 4096 + gi * 32 + lane] = D2p[0] + D2p[1];
#pragma unroll
                for (int x = 0; x < 4; ++x) Bc[x] = Bn[x];
            }
        }
        __syncthreads();
        const int nq = (tq >> 10) + 1;
        float sc[64];
#pragma unroll
        for (int q = 0; q < 4; ++q) {
#pragma unroll
            for (int j = 16 * q; j < 16 * q + 16; ++j) {
                float v = -INFINITY;
                if (q < nq) { const int k = j * 64 + lane; const float sv = S[wave * 4096 + k]; v = (k <= tq) ? sv : -INFINITY; }
                sc[j] = v;
            }
        }
        __syncthreads();
        float vmin = INFINITY, vmax = -INFINITY, s1 = 0.f, s2 = 0.f;
#pragma unroll
        for (int q = 0; q < 4; ++q) if (q < nq) {
#pragma unroll
            for (int j = 16 * q; j < 16 * q + 16; ++j) { const float v = sc[j]; const bool ok = !(v == -INFINITY); vmax = fmaxf(vmax, v); vmin = fminf(vmin, ok ? v : INFINITY); const float vz = ok ? v : 0.f; s1 += vz; s2 += vz * vz; }
        }
        float lo = wave_min_dpp(vmin), hi = next_up(wave_max_dpp(vmax));
        int clo = tq + 1, chi = 0;
        float Tsel = lo; bool exact = false, finished = false;
        unsigned short* so = sel + tg * TOPK;
        int it = 0;
        if (clo > 512) {
            const float nn = (float)(tq + 1);
            const float mu = wave_sum_f_dpp(s1) / nn;
            float sg = sqrtf(fmaxf(wave_sum_f_dpp(s2) / nn - mu * mu, 0.f));
            const float zt = qinv_upper(384.5f / nn);
            for (int pa = 0; pa < 3 && clo > 512 && !finished; ++pa) {
                const float tp = mu + zt * sg;
                if (!(tp > lo && tp < hi)) break;
                int cn = 0;
#pragma unroll
                for (int q = 0; q < 4; ++q) if (q < nq) {
#pragma unroll
                    for (int j = 16 * q; j < 16 * q + 16; ++j) cn += (sc[j] >= tp) ? 1 : 0;
                }
                cn = wave_sum_dpp(cn);
                if (cn == TOPK) { Tsel = tp; exact = true; finished = true; break; }
                if (cn > TOPK) { lo = tp; clo = cn; } else { hi = tp; chi = cn; }
                Tsel = lo;
                const int cc = cn < 1 ? 1 : (cn > tq ? tq : cn);
                const float zm = qinv_upper((float)cc / nn);
                if (fabsf(zm) < 0.05f || (tp - mu) * zm <= 0.f) break;
                sg = (tp - mu) / zm;
            }
        }
        for (; it < 200 && !finished; ++it) {
            if (clo <= 512) break;
            float mid = 0.5f * lo + 0.5f * hi;
            if (!(it & 1)) { const float frac = ((float)(clo - TOPK) - 0.5f) / (float)(clo - chi); const float sm = lo + (hi - lo) * frac; if (sm > lo && sm < hi) mid = sm; }
            if (!(mid > lo && mid < hi)) { Tsel = lo; finished = true; break; }
            int cn = 0;
#pragma unroll
            for (int q = 0; q < 4; ++q) if (q < nq) {
#pragma unroll
                for (int j = 16 * q; j < 16 * q + 16; ++j) cn += (sc[j] >= mid) ? 1 : 0;
            }
            cn = wave_sum_dpp(cn);
            if (cn == TOPK) { Tsel = mid; exact = true; finished = true; break; }
            if (cn > TOPK) { lo = mid; clo = cn; } else { hi = mid; chi = cn; }
            Tsel = lo;
        }
        if (clo <= 512 && !finished) {
            LAS float* cl = (LAS float*)(lds + 131072 + wave * 3072);
            LAS unsigned short* ckl = (LAS unsigned short*)(lds + 131072 + wave * 3072 + 2048);
            int nc = 0;
#pragma unroll
            for (int q = 0; q < 4; ++q) if (q < nq) {
#pragma unroll
                for (int j = 16 * q; j < 16 * q + 16; ++j) {
                    const float v = sc[j];
                    const bool isc = v >= lo;
                    const unsigned long long bc = __ballot(isc);
                    const int pr = __builtin_amdgcn_mbcnt_hi((unsigned)(bc >> 32), __builtin_amdgcn_mbcnt_lo((unsigned)bc, 0u));
                    if (isc) { cl[nc + pr] = v; ckl[nc + pr] = (unsigned short)(j * 64 + lane); }
                    nc += __popcll(bc);
                }
            }
            LDS_WAIT();
            float cv[8]; int ck[8];
#pragma unroll
            for (int j = 0; j < 8; ++j) { const int pos = 64 * j + lane; const bool in = pos < nc; cv[j] = in ? cl[pos] : -INFINITY; ck[j] = in ? (int)ckl[pos] : 0; }
            for (; it < 400; ++it) {
                float mid = 0.5f * lo + 0.5f * hi;
                if (!(it & 1)) { const float frac = ((float)(clo - TOPK) - 0.5f) / (float)(clo - chi); const float sm = lo + (hi - lo) * frac; if (sm > lo && sm < hi) mid = sm; }
                if (!(mid > lo && mid < hi)) { Tsel = lo; break; }
                int cn = 0;
#pragma unroll
                for (int j = 0; j < 8; ++j) cn += (cv[j] >= mid) ? 1 : 0;
                cn = wave_sum_dpp(cn);
                if (cn == TOPK) { Tsel = mid; exact = true; break; }
                if (cn > TOPK) { lo = mid; clo = cn; } else { hi = mid; chi = cn; }
                Tsel = lo;
            }
            int quota = 0;
            if (!exact) { int ngt = 0;
#pragma unroll
                for (int j = 0; j < 8; ++j) ngt += (cv[j] > Tsel) ? 1 : 0;
                quota = TOPK - wave_sum_dpp(ngt); }
            int outb = 0, eqb = 0;
#pragma unroll
            for (int j = 0; j < 8; ++j) {
                const float v = cv[j];
                bool take;
                if (exact) take = v >= Tsel;
                else {
                    const bool eq = v == Tsel;
                    const unsigned long long beq = __ballot(eq);
                    const int eqr = __builtin_amdgcn_mbcnt_hi((unsigned)(beq >> 32), __builtin_amdgcn_mbcnt_lo((unsigned)beq, 0u));
                    take = (v > Tsel) || (eq && (eqb + eqr) < quota);
                    eqb += __popcll(beq);
                }
                const unsigned long long bt = __ballot(take);
                const int tr = __builtin_amdgcn_mbcnt_hi((unsigned)(bt >> 32), __builtin_amdgcn_mbcnt_lo((unsigned)bt, 0u));
                if (take) so[outb + tr] = (unsigned short)ck[j];
                outb += __popcll(bt);
            }
            LDS_WAIT();
        } else if (exact) {
            int outb = 0;
#pragma unroll
            for (int q = 0; q < 4; ++q) if (q < nq) {
#pragma unroll
                for (int j = 16 * q; j < 16 * q + 16; ++j) {
                    const bool take = sc[j] >= Tsel;
                    const unsigned long long bt = __ballot(take);
                    const int tr = __builtin_amdgcn_mbcnt_hi((unsigned)(bt >> 32), __builtin_amdgcn_mbcnt_lo((unsigned)bt, 0u));
                    if (take) so[outb + tr] = (unsigned short)(j * 64 + lane);
                    outb += __popcll(bt);
                }
            }
        } else {
            int ngt = 0;
#pragma unroll
            for (int j = 0; j < 64; ++j) ngt += (sc[j] > Tsel) ? 1 : 0;
            ngt = wave_sum_dpp(ngt);
            const int quota = TOPK - ngt;
            int outb = 0, eqb = 0;
#pragma unroll
            for (int j = 0; j < 64; ++j) {
                const float v = sc[j];
                const bool gt = v > Tsel, eq = v == Tsel;
                const unsigned long long beq = __ballot(eq);
                const int eqr = __builtin_amdgcn_mbcnt_hi((unsigned)(beq >> 32), __builtin_amdgcn_mbcnt_lo((unsigned)beq, 0u));
                const bool take = gt || (eq && (eqb + eqr) < quota);
                const unsigned long long bt = __ballot(take);
                const int tr = __builtin_amdgcn_mbcnt_hi((unsigned)(bt >> 32), __builtin_amdgcn_mbcnt_lo((unsigned)bt, 0u));
                if (take) so[outb + tr] = (unsigned short)(j * 64 + lane);
                outb += __popcll(bt); eqb += __popcll(beq);
            }
        }
    }
    __syncthreads();
}

typedef short s16x4v __attribute__((__vector_size__(4 * sizeof(short))));
__device__ __forceinline__ h16x4 lds_tr_read(const LAS unsigned char* p) {
    return __builtin_bit_cast(h16x4, __builtin_amdgcn_ds_read_tr16_b64_v4i16((LAS s16x4v*)p));
}
__device__ __forceinline__ void phase_attn(const Params& p, LAS unsigned char* lds, int bid, int nb) {
    const int tid = threadIdx.x, lane = tid & 63, wave = __builtin_amdgcn_readfirstlane(tid >> 6), g = lane >> 4, hd = lane & 15;
    unsigned char* ws = p.ws;
    const h16* qabs = (const h16*)(ws + WS_QABS); const h16* ckv = (const h16*)(ws + WS_CKV);
    const unsigned short* sel = (const unsigned short*)(ws + WS_SEL);
    h16* olat = (h16*)(ws + WS_OLAT);
    LAS unsigned char* kv = lds + wave * 16384;
    LAS int* sidx = (LAS int*)(lds + 131072 + wave * 1024);
    LAS float* biasT = (LAS float*)(lds + 131072 + 8192);
    LAS unsigned char* bktT = lds + 131072 + 8192 + 1024;
    __syncthreads();
    if (tid < 256) biasT[tid] = p.rel_bias[tid];
    if (tid < 128) bktT[tid] = (unsigned char)t5_bucket(tid);
    __syncthreads();
    int tstart, tstride, tcount;
    if (nb == 256) { const int b = (bid & 7) >> 1, wq = ((((bid >> 3) << 1) | (bid & 1)) << 3) + wave; tstart = b * SEQ + wq; tstride = 512; tcount = 8; }
    else { tstart = bid * NWAVES + wave; tstride = nb * NWAVES; tcount = (T - tstart + tstride - 1) / tstride; }
    const int rowA = hd;
    const int fswA = ((rowA & 3) << 1) | (((rowA >> 2) & 1) << 3);
    const int q4 = hd >> 2, p4 = hd & 3;
    const int rowT = 4 * g + q4;
    const int fswT = ((rowT & 3) << 1) | (((rowT >> 2) & 1) << 3);
    const LAS unsigned char* trbase = kv + rowT * 512 + 8 * (p4 & 1);
    for (int qi = 0; qi < tcount; ++qi) {
        const int tg = tstart + qi * tstride;
        const int b = tg >> 12, tl = tg & (SEQ - 1);
        const int cnt = tl + 1 < TOPK ? tl + 1 : TOPK, nch = (cnt + 31) >> 5;
        {
            int i0, i1, i2, i3;
            if (tl + 1 > TOPK) { const u32x2 s4 = *(const u32x2*)(sel + (size_t)tg * TOPK + lane * 4); i0 = s4.x & 0xffff; i1 = s4.x >> 16; i2 = s4.y & 0xffff; i3 = s4.y >> 16; }
            else { const int j = lane * 4; i0 = j < cnt ? j : 0; i1 = j + 1 < cnt ? j + 1 : 0; i2 = j + 2 < cnt ? j + 2 : 0; i3 = j + 3 < cnt ? j + 3 : 0; }
            *(LAS i32x4*)(sidx + lane * 4) = (i32x4){i0, i1, i2, i3};
        }
        h16x8 Qf[8];
#pragma unroll
        for (int ks = 0; ks < 8; ++ks) {
            h16x8 z;
#pragma unroll
            for (int e = 0; e < 8; ++e) z[e] = (h16)0.f;
            Qf[ks] = (hd < 8) ? *(const h16x8*)(qabs + (size_t)tg * 2048 + hd * 256 + ks * 32 + g * 8) : z;
        }
        f32x4 O[16];
#pragma unroll
        for (int ct = 0; ct < 16; ++ct) O[ct] = (f32x4){0.f, 0.f, 0.f, 0.f};
        float m = -INFINITY, l = 0.f;
        const unsigned char* ckvb = (const unsigned char*)(ckv + (size_t)b * SEQ * 256);
        LDS_WAIT();
        for (int c = 0; c < nch; ++c) {
            asm volatile("" ::: "memory");
#pragma unroll
            for (int i = 0; i < 16; ++i) {
                const int row = 2 * i + (lane >> 5);
                const int idx = sidx[32 * c + row];
                const int fsw = ((row & 3) << 1) | (((row >> 2) & 1) << 3);
                const unsigned char* src = ckvb + (size_t)idx * 512 + ((((lane & 31) ^ fsw)) << 4);
                __builtin_amdgcn_global_load_lds((const unsigned*)src, (LAS unsigned*)(kv + i * 1024), 16, 0, 0);
            }
            const i32x4 ia = *(const LAS i32x4*)(sidx + 32 * c + 4 * g), ib = *(const LAS i32x4*)(sidx + 32 * c + 16 + 4 * g);
            const int h7 = hd & 7;
            const int kk8[8] = {ia.x, ia.y, ia.z, ia.w, ib.x, ib.y, ib.z, ib.w};
            float bias8[8];
#pragma unroll
            for (int r = 0; r < 8; ++r) {
                const int slot = 32 * c + (r < 4 ? 4 * g + r : 16 + 4 * g + (r - 4));
                int dist = tl - kk8[r]; dist = dist < 0 ? 0 : (dist > 127 ? 127 : dist);
                bias8[r] = (slot < cnt) ? biasT[(int)bktT[dist] * 8 + h7] : -INFINITY;
            }
            asm volatile("s_waitcnt vmcnt(0)" ::: "memory");
            __builtin_amdgcn_sched_barrier(0);
            f32x4 S0 = {0.f, 0.f, 0.f, 0.f}, S1 = {0.f, 0.f, 0.f, 0.f};
#pragma unroll
            for (int ks = 0; ks < 8; ++ks) {
                const h16x8 A0 = *(const LAS h16x8*)(kv + rowA * 512 + (((4 * ks + g) ^ fswA) << 4));
                const h16x8 A1 = *(const LAS h16x8*)(kv + (rowA + 16) * 512 + (((4 * ks + g) ^ fswA) << 4));
                S0 = __builtin_amdgcn_mfma_f32_16x16x32_f16(A0, Qf[ks], S0, 0, 0, 0);
                S1 = __builtin_amdgcn_mfma_f32_16x16x32_f16(A1, Qf[ks], S1, 0, 0, 0);
            }
            float sv[8]; float cmax = -INFINITY;
#pragma unroll
            for (int r = 0; r < 8; ++r) { sv[r] = ((r < 4) ? S0[r] : S1[r - 4]) + bias8[r]; cmax = fmaxf(cmax, sv[r]); }
            if (__any(cmax > m + 8.f)) {
                cmax = fmaxf(cmax, __shfl_xor(cmax, 16)); cmax = fmaxf(cmax, __shfl_xor(cmax, 32));
                const float mnew = fmaxf(m, cmax);
                const float alpha = __expf(m - mnew);
                l *= alpha; m = mnew;
#pragma unroll
                for (int ct = 0; ct < 16; ++ct) O[ct] *= alpha;
            }
            h16x8 Pf;
#pragma unroll
            for (int r = 0; r < 8; ++r) { const float pv = __expf(sv[r] - m); l += pv; Pf[r] = (h16)pv; }
#pragma unroll
            for (int ct = 0; ct < 16; ++ct) {
                const int choff = ((((2 * (ct & 7)) ^ fswT) + (p4 >> 1)) << 4) + (ct >> 3) * 256;
                const h16x4 a0 = lds_tr_read(trbase + choff);
                const h16x4 a1 = lds_tr_read(trbase + 16 * 512 + choff);
                h16x8 Av; Av[0] = a0[0]; Av[1] = a0[1]; Av[2] = a0[2]; Av[3] = a0[3]; Av[4] = a1[0]; Av[5] = a1[1]; Av[6] = a1[2]; Av[7] = a1[3];
                O[ct] = __builtin_amdgcn_mfma_f32_16x16x32_f16(Av, Pf, O[ct], 0, 0, 0);
            }
            asm volatile("" ::: "memory");
        }
        l += __shfl_xor(l, 16); l += __shfl_xor(l, 32);
        if (hd < 8) {
            const float inv = 1.f / l;
            h16* op = olat + (size_t)tg * 2048 + hd * 256 + 4 * g;
#pragma unroll
            for (int ct = 0; ct < 16; ++ct) *(u32x2*)(op + 16 * ct) = pack_h4(O[ct] * inv);
        }
    }
    __syncthreads();
}

__device__ __forceinline__ void phase_uv(const Params& p, LAS unsigned char* lds, int bid, int nb) {
    const int tid = threadIdx.x, lane = tid & 63, wave = tid >> 6, r31 = lane & 31, hh = lane >> 5;
    unsigned char* ws = p.ws;
    const h16* olat = (const h16*)(ws + WS_OLAT); const h16* wuvT = (const h16*)(ws + WS_WUVT);
    h16* ymix = (h16*)(ws + WS_R2);
    for (int u = bid; u < 256; u += nb) {
        const int h = u & 7, rb = u >> 3;
        __syncthreads();
        for (int e = tid; e < 128 * 32; e += NTHREADS) { const int v = e >> 5, ch = e & 31; *(LAS u32x4*)(lds + v * 528 + ch * 16) = *(const u32x4*)(wuvT + ((size_t)h * 128 + v) * 256 + ch * 8); }
        __syncthreads();
        for (int tile = wave; tile < 16; tile += NWAVES) {
            const int row0 = rb * 512 + tile * 32;
            f32x16 acc[4];
#pragma unroll
            for (int vt = 0; vt < 4; ++vt)
#pragma unroll
                for (int r = 0; r < 16; ++r) acc[vt][r] = 0.f;
            const h16* bp = olat + (size_t)(row0 + r31) * 2048 + h * 256 + hh * 8;
#pragma unroll 4
            for (int ks = 0; ks < 16; ++ks) {
                const h16x8 Bf = *(const h16x8*)(bp + ks * 16);
#pragma unroll
                for (int vt = 0; vt < 4; ++vt) {
                    const h16x8 Af = *(const LAS h16x8*)(lds + (vt * 32 + r31) * 528 + ks * 32 + hh * 16);
                    acc[vt] = __builtin_amdgcn_mfma_f32_32x32x16_f16(Af, Bf, acc[vt], 0, 0, 0);
                }
            }
            float ss = 0.f;
#pragma unroll
            for (int vt = 0; vt < 4; ++vt)
#pragma unroll
                for (int r = 0; r < 16; ++r) ss += acc[vt][r] * acc[vt][r];
            ss += __shfl_xor(ss, 32);
            const float rstd = rsqrtf(ss * (1.f / 128.f) + EPS);
            h16* yp = ymix + (size_t)(row0 + r31) * 2048 + h * 128 + 4 * hh;
            const float* gp = p.attn_out_norm_g + h * 128 + 4 * hh;
#pragma unroll
            for (int vt = 0; vt < 4; ++vt)
#pragma unroll
                for (int rq = 0; rq < 4; ++rq) {
                    const f32x4 gg = *(const f32x4*)(gp + vt * 32 + 8 * rq);
                    const f32x4 y = {acc[vt][4 * rq + 0] * rstd * gg[0], acc[vt][4 * rq + 1] * rstd * gg[1], acc[vt][4 * rq + 2] * rstd * gg[2], acc[vt][4 * rq + 3] * rstd * gg[3]};
                    *(u32x2*)(yp + vt * 32 + 8 * rq) = pack_h4(y);
                }
        }
    }
    __syncthreads();
}

#define XB_TMO      128
#define XB_XCNT(j)  (256  + 64 * (j))
#define XB_XSUB(j)  (1280 + 64 * (j))
#define XB_XGEN(j)  (2304 + 64 * (j))
#define XB_TOP      3328
#define XB_TOPGEN   3392
#define XCD_BAR_WORDS 3456
#define XB_SPIN_CAP (1u << 22)
__device__ __forceinline__ unsigned xb_ld(unsigned* p)              { return __hip_atomic_load(p, __ATOMIC_RELAXED, __HIP_MEMORY_SCOPE_AGENT); }
__device__ __forceinline__ unsigned xb_add(unsigned* p, unsigned v) { return __hip_atomic_fetch_add(p, v, __ATOMIC_RELAXED, __HIP_MEMORY_SCOPE_AGENT); }
__device__ __forceinline__ unsigned xb_xcc_id() { return (unsigned)__builtin_amdgcn_s_getreg((3 << 11) | 20) & 0xFu; }
#define XB_SPIN(cond, bar) do { unsigned _sp = 0; while (cond) { __builtin_amdgcn_s_sleep(1); \
    if ((++_sp & 255u) == 0u) { if (xb_ld(&(bar)[XB_TMO])) break; if (_sp > XB_SPIN_CAP) { atomicAdd(&(bar)[XB_TMO], 1u); break; } } } } while (0)
struct XcdBarrier { unsigned* bar; unsigned x; volatile LAS unsigned* st; };
__device__ __forceinline__ XcdBarrier xcd_barrier_post(unsigned* bar, volatile LAS unsigned* st) {
    XcdBarrier b; b.bar = bar; b.x = xb_xcc_id(); b.st = st;
    if (threadIdx.x == 0) (void)xb_add(&bar[XB_XCNT(b.x)], 1u);
    return b;
}
__device__ __forceinline__ void xcd_barrier_complete(unsigned* bar, unsigned x, unsigned& nloc, unsigned& nx) {
    const unsigned G = gridDim.x * gridDim.y * gridDim.z;
    unsigned sum, cnt, mine, sp = 0u;
    for (;;) {
        sum = 0u; cnt = 0u; mine = 0u;
#pragma unroll
        for (unsigned j = 0; j < 16; ++j) { const unsigned c = xb_ld(&bar[XB_XCNT(j)]); sum += c; cnt += (c > 0u) ? 1u : 0u; mine = (j == x) ? c : mine; }
        if (sum == G) break;
        __builtin_amdgcn_s_sleep(1);
        if ((++sp & 255u) == 0u) { if (xb_ld(&bar[XB_TMO])) break; if (sp > XB_SPIN_CAP) { atomicAdd(&bar[XB_TMO], 1u); break; } }
    }
    nloc = mine > 0u ? mine : 1u; nx = cnt > 0u ? cnt : 1u;
}
__device__ __forceinline__ void xcd_barrier(const XcdBarrier& b) {
    asm volatile("s_waitcnt vmcnt(0)" ::: "memory");
    __syncthreads();
    if (threadIdx.x == 0) {
        unsigned* bar = b.bar;
        __builtin_amdgcn_s_waitcnt(0);
        unsigned nloc = b.st[0], nx = b.st[1];
        if (nloc == 0u) { xcd_barrier_complete(bar, b.x, nloc, nx); b.st[0] = nloc; b.st[1] = nx; }
        const unsigned old = xb_add(&bar[XB_XSUB(b.x)], 1u);
        const unsigned gen = old / nloc;
        if (old + 1u == (gen + 1u) * nloc) {
            __builtin_amdgcn_fence(__ATOMIC_RELEASE, "agent");
            asm volatile("s_waitcnt vmcnt(0)" ::: "memory");
            const unsigned og = xb_add(&bar[XB_TOP], 1u);
            const unsigned tg = og / nx;
            if (og + 1u == (tg + 1u) * nx) xb_add(&bar[XB_TOPGEN], 1u);
            else XB_SPIN(xb_ld(&bar[XB_TOPGEN]) == tg, bar);
            __builtin_amdgcn_fence(__ATOMIC_ACQUIRE, "agent");
            xb_add(&bar[XB_XGEN(b.x)], 1u);
            asm volatile("s_waitcnt vmcnt(0)" ::: "memory");
        } else {
            XB_SPIN(xb_ld(&bar[XB_XGEN(b.x)]) == gen, bar);
            __builtin_amdgcn_fence(__ATOMIC_ACQUIRE, "agent");
            asm volatile("s_waitcnt vmcnt(0)" ::: "memory");
        }
    }
    __syncthreads();
}

constexpr int LDS_BYTES = 160 * 1024;
constexpr int WGM_G1 = 2, WGM_G2 = 2, WGM_G6 = 2, WGM_G7 = 8, WGM_G8 = 2;
constexpr int NPHASES = 13;
__global__ void __launch_bounds__(NTHREADS, 2) fwd_kernel(Params p) {
    extern __shared__ __attribute__((aligned(16))) unsigned char lds_raw[];
    LAS unsigned char* lds = (LAS unsigned char*)lds_raw;
    const int bid = blockIdx.x, nb = gridDim.x;
    unsigned char* ws = p.ws;
    float* mod = (float*)(ws + WS_MOD);
    volatile LAS unsigned* bst = (volatile LAS unsigned*)(lds + LDS_BYTES - 64);
    if (threadIdx.x < 2) bst[threadIdx.x] = 0u;
    __syncthreads();
    XcdBarrier xbar = xcd_barrier_post((unsigned*)(ws + WS_CTL), bst);
#define IN(k) (p.ph_lo <= (k) && (k) < p.ph_hi)
#define SEAM(k) do { if (IN(k) && IN((k) + 1)) xcd_barrier(xbar); } while (0)
    if (IN(0)) { phase_prep(p, lds, bid, nb); } SEAM(0);
    if (IN(1)) { phase_normmod(p.x, p.norm1_g, mod, 0, 2048, (h16*)(ws + WS_R2), bid, nb); } SEAM(1);
    if (IN(2)) { EpiProj E{(h16*)(ws + WS_CQ), (float*)(ws + WS_PROJA), (h16*)(ws + WS_CKV), (h16*)(ws + WS_KIDX), (float*)(ws + WS_WIDX), (h16*)(ws + WS_PROJB), p.kv_norm_g, p.idx_k_norm_g, p.idx_k_norm_b};
                 run_gemm(lds, (const h16*)(ws + WS_R2), (const h16*)(ws + WS_BT_IN), T, N_IN, 2048, bid, nb, E, WGM_G1); } SEAM(2);
    if (IN(3)) { phase_rows3(p, bid, nb); } SEAM(3);
    if (IN(4)) { EpiQ E{(h16*)(ws + WS_QABS), (h16*)(ws + WS_IQ), p.q_abs_norm_g, (const float*)(ws + WS_PROJA)}; run_gemm(lds, (const h16*)(ws + WS_CQ), (const h16*)(ws + WS_BT_Q), T, N_Q, 512, bid, nb, E, WGM_G2); } SEAM(4);
    if (IN(5)) { phase_index(p, lds, bid, nb); } SEAM(5);
    if (IN(6)) { phase_attn(p, lds, bid, nb); } SEAM(6);
    if (IN(7)) { phase_uv(p, lds, bid, nb); } SEAM(7);
    if (IN(8)) { EpiF16 E{(h16*)(ws + WS_Y6), nullptr}; run_gemm(lds, (const h16*)(ws + WS_R2), (const h16*)(ws + WS_BT_OUT), T, 2048, 2048, bid, nb, E, WGM_G6); } SEAM(8);
    if (IN(9)) { phase_normmod2(p, bid, nb); } SEAM(9);
    if (IN(10)) {
        LAS h16* bl = (LAS h16*)(lds + 131072 + 8192);
        __syncthreads();
        for (int i = threadIdx.x; i < D_FF / 4; i += NTHREADS) { const f32x4 b4 = *(const f32x4*)(p.b_mlp1 + 4 * i); *(LAS u32x2*)(bl + 4 * i) = pack_h4(b4); }
        __syncthreads();
        EpiMlp1 E{bl, (h16*)(ws + WS_R3)}; run_gemm(lds, (const h16*)(ws + WS_R2), (const h16*)(ws + WS_BT_1), T, D_FF, 2048, bid, nb, E, WGM_G7); } SEAM(10);
    if (IN(11)) { EpiF16 E{(h16*)(ws + WS_R2), p.b_mlp2}; run_gemm(lds, (const h16*)(ws + WS_R3), (const h16*)(ws + WS_BT_2), T, 2048, D_FF, bid, nb, E, WGM_G8); } SEAM(11);
    if (IN(12)) { phase_final(p, bid, nb); }
#undef IN
#undef SEAM
}

#ifndef N_LAUNCH_MODE
#define N_LAUNCH_MODE 1
#endif
extern "C" void kernel_launch(void* const* d_in, const int* in_sizes, int n_in, void* d_out, int out_size, void* d_ws, size_t ws_size, hipStream_t stream) {
    static int grid = 0;
    if (grid == 0) {
        if (ws_size < WS_END) { fprintf(stderr, "kernel_launch: workspace too small (%zu < %zu)\n", ws_size, (size_t)WS_END); grid = -1; return; }
        int dev = 0, cus = 0, per_cu = 0;
        hipGetDevice(&dev);
        hipDeviceGetAttribute(&cus, hipDeviceAttributeMultiprocessorCount, dev);
        if (hipFuncSetAttribute((const void*)fwd_kernel, hipFuncAttributeMaxDynamicSharedMemorySize, LDS_BYTES) != hipSuccess) { fprintf(stderr, "kernel_launch: hipFuncSetAttribute failed\n"); grid = -1; return; }
        hipOccupancyMaxActiveBlocksPerMultiprocessor(&per_cu, (const void*)fwd_kernel, NTHREADS, LDS_BYTES);
        if (per_cu < 1) { fprintf(stderr, "kernel_launch: occupancy query says %d\n", per_cu); per_cu = 1; }
        grid = cus;
        if (grid > 256) grid = 256;
    }
    if (grid < 0) return;
    Params p{};
    const float** f = (const float**)&p;
    for (int i = 0; i < 26; ++i) f[i] = (const float*)d_in[i];
    p.out = (float*)d_out; p.ws = (unsigned char*)d_ws;
#if N_LAUNCH_MODE == 1
    if (hipMemsetAsync((char*)d_ws + WS_CTL, 0, XCD_BAR_WORDS * 4, stream) != hipSuccess) { fprintf(stderr, "kernel_launch: memset failed\n"); return; }
    p.ph_lo = 0; p.ph_hi = NPHASES;
    void* args[] = {&p};
    hipError_t e = hipLaunchCooperativeKernel((const void*)fwd_kernel, dim3(grid), dim3(NTHREADS), args, LDS_BYTES, stream);
    if (e != hipSuccess) fprintf(stderr, "cooperative launch failed: %s (grid %d)\n", hipGetErrorString(e), grid);
#else
    for (int ph = 0; ph < 13; ++ph) {
        p.ph_lo = ph; p.ph_hi = ph + 1;
        hipLaunchKernelGGL(fwd_kernel, dim3(grid), dim3(NTHREADS), LDS_BYTES, stream, p);
    }
#endif
}
```

```cpp
#include <hip/hip_runtime.h>
#include <cstdio>
#include <cstdint>

#define LAS __attribute__((address_space(3)))
typedef _Float16 h16;
typedef _Float16 h16x8 __attribute__((ext_vector_type(8)));
typedef _Float16 h16x4 __attribute__((ext_vector_type(4)));
typedef _Float16 h16x2 __attribute__((ext_vector_type(2)));
typedef float f32x4 __attribute__((ext_vector_type(4)));
typedef float f32x2 __attribute__((ext_vector_type(2)));
typedef unsigned u32x4 __attribute__((ext_vector_type(4)));
typedef unsigned u32x2 __attribute__((ext_vector_type(2)));
typedef int i32x4 __attribute__((ext_vector_type(4)));
typedef int i32x2 __attribute__((ext_vector_type(2)));

constexpr int D_MODEL = 2048, BATCH = 4, SEQ = 4096, T = BATCH * SEQ;
constexpr int ATTN_HEADS = 8, HEAD_DIM = 128, Q_LORA = 512, KV_LORA = 256, IDX_HEADS = 16, IDX_DIM = 64, TOPK = 256;
constexpr int CONV_WIDTH = 1024, D_FF = 8192, IN_COLS = 3920;
constexpr float EPS = 1e-6f;
constexpr int NTHREADS = 512, NWAVES = 8;
constexpr int N_IN = 4096;
constexpr int N_Q = 3072;

constexpr size_t MiB = (size_t)1 << 20;
constexpr size_t WS_CTL = 0;
constexpr size_t WS_MOD = 64 * 1024;
constexpr size_t WS_BT_IN = 1 * MiB;
constexpr size_t WS_BT_Q = WS_BT_IN + 16 * MiB;
constexpr size_t WS_BT_OUT = WS_BT_Q + 3 * MiB;
constexpr size_t WS_BT_1 = WS_BT_OUT + 8 * MiB;
constexpr size_t WS_BT_2 = WS_BT_1 + 32 * MiB;
constexpr size_t WS_WUVT = WS_BT_2 + 32 * MiB;
constexpr size_t WS_R2 = 93 * MiB;
constexpr size_t WS_R3 = WS_R2 + 64 * MiB;
constexpr size_t WS_PROJA = WS_R3;
constexpr size_t WS_PROJB = WS_R3 + 64 * MiB;
constexpr size_t WS_OLAT = WS_R3 + 64 * MiB;
constexpr size_t WS_QABS = WS_R3 + 160 * MiB;
constexpr size_t WS_IQ = WS_R3 + 224 * MiB;
constexpr size_t WS_R4 = WS_R3 + 256 * MiB;
constexpr size_t WS_CQ = WS_R4;
constexpr size_t WS_CKV = WS_CQ + 16 * MiB;
constexpr size_t WS_KIDX = WS_CKV + 8 * MiB;
constexpr size_t WS_WIDX = WS_KIDX + 2 * MiB;
constexpr size_t WS_SEL = WS_WIDX + 1 * MiB;
constexpr size_t WS_Y6 = WS_SEL + 8 * MiB;
constexpr size_t WS_END = WS_Y6 + 64 * MiB;

struct Params {
    const float *x, *c, *w_ada, *b_ada, *norm1_g, *norm2_g, *w_in, *cq_norm_g, *w_uq, *w_uk, *kv_norm_g, *q_abs_norm_g, *w_uv, *w_iq,
        *idx_k_norm_g, *idx_k_norm_b, *rel_bias, *conv_w, *conv_b, *attn_out_norm_g, *conv_out_norm_g, *w_out, *w_mlp1, *b_mlp1, *w_mlp2, *b_mlp2;
    float* out;
    unsigned char* ws;
    int ph_lo, ph_hi;
};

__device__ __forceinline__ float wave_sum(float v) {
#pragma unroll
    for (int o = 1; o < 64; o <<= 1) v += __shfl_xor(v, o);
    return v;
}
__device__ __forceinline__ float wave_max(float v) {
#pragma unroll
    for (int o = 1; o < 64; o <<= 1) v = fmaxf(v, __shfl_xor(v, o));
    return v;
}
#define LDS_WAIT() asm volatile("s_waitcnt lgkmcnt(0)" ::: "memory")

namespace pg8 {
constexpr int BM = 256, BK = 64, HALF = 128, HTB = HALF * BK * 2, STAGE_BYTES = 8 * HTB, NXCD = 8;
__host__ __device__ __forceinline__ int lds_byte(int r, int c) { const int st = (r >> 4) * 2 + (c >> 5), rr = r & 15, cc = c & 31, ob = rr * 64 + cc * 2; return st * 1024 + (ob ^ (((ob >> 9) & 1) << 5)); }
__host__ __device__ __forceinline__ int perm32(int rho) { const int n = rho >> 4, i = rho & 15; return 8 * (i >> 2) + 4 * n + (i & 3); }
__host__ __device__ __forceinline__ void stage_rc(int b, int& R, int& C) { const int st = b / 1024, sb = b % 1024, swz = sb ^ (((sb >> 9) & 1) << 5); R = (st >> 1) * 16 + swz / 64; C = (st & 1) * 32 + (swz % 64) / 2; }
struct Unit { int pm, pn; };
struct Gemm { const h16* A; const h16* Bt; int M, N, K; };
struct StaticOrder {
    int nM, nN, nwg, G, c, WGM;
    __host__ __device__ void init(int M, int N, int G_, int c_, int wgm) { nM = M / BM; nN = N / BM; nwg = nM * nN; G = G_; c = c_; WGM = wgm; }
    __host__ __device__ bool next(int i, Unit& u) const {
        const long L = (long)i * G + c; if (L >= nwg) return false;
        int wgid = (int)L; { const int q = nwg / NXCD, r = nwg % NXCD, xcd = wgid % NXCD, off = wgid / NXCD; wgid = (xcd < r ? xcd * (q + 1) : r * (q + 1) + (xcd - r) * q) + off; }
        const int nig = WGM * nN, gid = wgid / nig, fm = gid * WGM, gsz = (nM - fm) < WGM ? (nM - fm) : WGM;
        u.pm = fm + ((wgid % nig) % gsz); u.pn = (wgid % nig) / gsz; return true;
    }
};

#ifndef PG8_SP2
#define PG8_SP2 true
#endif
#ifndef PG8_ALIGN
#define PG8_ALIGN true
#endif
template <class Epi, bool ALIGN_EPI = PG8_ALIGN, bool SP2 = PG8_SP2>
__device__ __forceinline__ void gemm_phase(LAS unsigned char* lds, const Gemm g, const StaticOrder& S, const Epi& E) {
    const int tid = threadIdx.x, wid = __builtin_amdgcn_readfirstlane(tid >> 6), lane = tid & 63, wr = wid >> 2, wc = wid & 3, fr = lane & 15, fq = lane >> 4;
    const int K = g.K, nt = K / BK;
    unsigned voffA[2], voffB[2];
#pragma unroll
    for (int i = 0; i < 2; ++i) { int R, C; stage_rc(tid * 16 + i * 8192, R, C); const int Rb = Epi::PERM ? ((R & ~31) + perm32(R & 31)) : R; voffA[i] = (unsigned)(R * K + C) * 2u; voffB[i] = (unsigned)(Rb * K + C) * 2u; }
    const size_t kstep = (size_t)(BK * 2);
    const size_t hstep = (size_t)HALF * K * 2;
    const size_t tstep = 2 * hstep;
    const unsigned ldsw = (unsigned)wid * 1024u;
    const int aoff = lds_byte(wr * 64 + fr, fq * 8), boff = lds_byte(wc * 32 + fr, fq * 8);
#define PG8_SA(b, h) (((b) * 2 + (h)) * HTB)
#define PG8_SB(b, h) ((4 + (b) * 2 + (h)) * HTB)
#define PG8_STAGE(bufoff, gbase, voff) do { _Pragma("unroll") for (int _i = 0; _i < 2; ++_i) \
        __builtin_amdgcn_global_load_lds((const unsigned*)((const char*)(gbase) + (voff)[_i]), (LAS unsigned*)(lds + (bufoff) + ldsw + _i * 8192), 16, 0, 0); } while (0)
#define PG8_LDA(dst, b, h) do { _Pragma("unroll") for (int m = 0; m < 4; ++m) _Pragma("unroll") for (int k = 0; k < 2; ++k) dst[m][k] = *(const LAS h16x8*)(lds + PG8_SA(b, h) + aoff + m * 2048 + k * 1024); } while (0)
#define PG8_LDB(dst, b, h) do { _Pragma("unroll") for (int n = 0; n < 2; ++n) _Pragma("unroll") for (int k = 0; k < 2; ++k) dst[n][k] = *(const LAS h16x8*)(lds + PG8_SB(b, h) + boff + n * 2048 + k * 1024); } while (0)
#define PG8_MMA(ai, bj, At, Bt) do { __builtin_amdgcn_s_setprio(1); _Pragma("unroll") for (int m = 0; m < 4; ++m) _Pragma("unroll") for (int n = 0; n < 2; ++n) _Pragma("unroll") for (int k = 0; k < 2; ++k) \
        acc[ai][bj][m][n] = __builtin_amdgcn_mfma_f32_16x16x32_f16(Bt[n][k], At[m][k], acc[ai][bj][m][n], 0, 0, 0); __builtin_amdgcn_s_setprio(0); } while (0)
#define PG8_WAIT_V(n) asm volatile("s_waitcnt vmcnt(" #n ")" ::: "memory")
#define PG8_WAIT_L(n) asm volatile("s_waitcnt lgkmcnt(" #n ")" ::: "memory")
#define PG8_BAR __builtin_amdgcn_s_barrier()
#define PG8_SCHED __builtin_amdgcn_sched_barrier(0)
    Unit cur, nxt; int ui = 0;
    if (!S.next(0, cur)) return;
    f32x4 acc[2][2][4][2];
#pragma unroll
    for (int a = 0; a < 2; ++a)
#pragma unroll
        for (int b = 0; b < 2; ++b)
#pragma unroll
            for (int m = 0; m < 4; ++m)
#pragma unroll
                for (int n = 0; n < 2; ++n) acc[a][b][m][n] = (f32x4){0.f, 0.f, 0.f, 0.f};
    h16x8 At[4][2], B0[2][2], B1[2][2];
    const char* cA = (const char*)g.A + (size_t)cur.pm * tstep; const char* cB = (const char*)g.Bt + (size_t)cur.pn * tstep;
    if constexpr (SP2) {
        PG8_STAGE(PG8_SB(0, 0), cB, voffB); PG8_STAGE(PG8_SB(0, 1), cB + hstep, voffB); PG8_STAGE(PG8_SA(0, 0), cA, voffA); PG8_STAGE(PG8_SA(0, 1), cA + hstep, voffA);
        if (wr == 1) PG8_BAR;
        PG8_WAIT_V(2); PG8_BAR;
        PG8_STAGE(PG8_SB(1, 0), cB + kstep, voffB); PG8_STAGE(PG8_SA(1, 0), cA + kstep, voffA); PG8_STAGE(PG8_SB(1, 1), cB + hstep + kstep, voffB);
        PG8_WAIT_V(6); PG8_BAR;
    } else {
        PG8_STAGE(PG8_SB(0, 0), cB, voffB); PG8_STAGE(PG8_SA(0, 0), cA, voffA); PG8_STAGE(PG8_SB(0, 1), cB + hstep, voffB); PG8_STAGE(PG8_SA(0, 1), cA + hstep, voffA);
        if (wr == 1) PG8_BAR;
        PG8_WAIT_V(4); PG8_BAR;
        PG8_STAGE(PG8_SB(1, 0), cB + kstep, voffB); PG8_STAGE(PG8_SA(1, 0), cA + kstep, voffA); PG8_STAGE(PG8_SB(1, 1), cB + hstep + kstep, voffB);
        PG8_WAIT_V(6); PG8_BAR;
    }
    for (;;) {
        const bool has_next = S.next(ui + 1, nxt);
        const char* nA = has_next ? (const char*)g.A + (size_t)nxt.pm * tstep : cA; const char* nB = has_next ? (const char*)g.Bt + (size_t)nxt.pn * tstep : cB;
        for (int t = 0; t < nt; t += 2) {
            const bool last = (t == nt - 2);
            const char* a1 = cA + (size_t)(t + 1) * kstep;
            const char* a2 = last ? nA : cA + (size_t)(t + 2) * kstep; const char* b2 = last ? nB : cB + (size_t)(t + 2) * kstep;
            const char* a3 = a2 + kstep; const char* b3 = b2 + kstep;
            if constexpr (SP2) {
            PG8_LDB(B0, 0, 0); PG8_LDB(B1, 0, 1); PG8_SCHED; PG8_LDA(At, 0, 0); PG8_STAGE(PG8_SA(1, 1), a1 + hstep, voffA);
            PG8_WAIT_V(8); PG8_WAIT_L(0); PG8_BAR; PG8_MMA(0, 0, At, B0); PG8_MMA(0, 1, At, B1); PG8_BAR; PG8_SCHED;
            PG8_LDA(At, 0, 1); PG8_STAGE(PG8_SB(0, 0), b2, voffB); PG8_STAGE(PG8_SB(0, 1), b2 + hstep, voffB); PG8_STAGE(PG8_SA(0, 0), a2, voffA);
            PG8_WAIT_V(8); PG8_WAIT_L(0); PG8_BAR; PG8_MMA(1, 0, At, B0); PG8_MMA(1, 1, At, B1); PG8_BAR; PG8_SCHED;
            PG8_LDB(B0, 1, 0); PG8_LDB(B1, 1, 1); PG8_SCHED; PG8_LDA(At, 1, 0); PG8_STAGE(PG8_SA(0, 1), a2 + hstep, voffA);
            PG8_WAIT_V(8); PG8_WAIT_L(0); PG8_BAR; PG8_MMA(0, 0, At, B0); PG8_MMA(0, 1, At, B1); PG8_BAR; PG8_SCHED;
            PG8_LDA(At, 1, 1); PG8_STAGE(PG8_SB(1, 0), b3, voffB); PG8_STAGE(PG8_SB(1, 1), b3 + hstep, voffB); PG8_STAGE(PG8_SA(1, 0), a3, voffA);
            PG8_WAIT_V(8); PG8_WAIT_L(0); PG8_BAR; PG8_MMA(1, 0, At, B0); PG8_MMA(1, 1, At, B1); PG8_BAR; PG8_SCHED;
            } else {
            PG8_LDB(B0, 0, 0); PG8_SCHED; PG8_LDA(At, 0, 0); PG8_STAGE(PG8_SA(1, 1), a1 + hstep, voffA);
            PG8_WAIT_L(8); PG8_BAR; PG8_WAIT_L(0); PG8_MMA(0, 0, At, B0); PG8_BAR; PG8_SCHED;
            PG8_LDB(B1, 0, 1); PG8_STAGE(PG8_SB(0, 0), b2, voffB);
            PG8_BAR; PG8_WAIT_L(0); PG8_MMA(0, 1, At, B1); PG8_BAR;
            PG8_LDA(At, 0, 1); PG8_STAGE(PG8_SA(0, 0), a2, voffA);
            PG8_BAR; PG8_WAIT_L(0); PG8_MMA(1, 0, At, B0); PG8_BAR; PG8_SCHED;
            PG8_STAGE(PG8_SB(0, 1), b2 + hstep, voffB);
            PG8_WAIT_V(6); PG8_BAR; PG8_MMA(1, 1, At, B1); PG8_BAR;
            PG8_LDB(B0, 1, 0); PG8_SCHED; PG8_LDA(At, 1, 0); PG8_STAGE(PG8_SA(0, 1), a2 + hstep, voffA);
            PG8_WAIT_L(8); PG8_BAR; PG8_WAIT_L(0); PG8_MMA(0, 0, At, B0); PG8_BAR; PG8_SCHED;
            PG8_LDB(B1, 1, 1); PG8_STAGE(PG8_SB(1, 0), b3, voffB);
            PG8_BAR; PG8_WAIT_L(0); PG8_MMA(0, 1, At, B1); PG8_BAR;
            PG8_LDA(At, 1, 1); PG8_STAGE(PG8_SA(1, 0), a3, voffA);
            PG8_BAR; PG8_WAIT_L(0); PG8_MMA(1, 0, At, B0); PG8_BAR; PG8_SCHED;
            PG8_STAGE(PG8_SB(1, 1), b3 + hstep, voffB);
            PG8_WAIT_V(6); PG8_BAR; PG8_MMA(1, 1, At, B1); PG8_BAR;
            }
        }
        if constexpr (ALIGN_EPI) { if (wr == 0) PG8_BAR; }
        if constexpr (Epi::CUSTOM) { E.run(acc, cur, wr, wc, fr, fq, lds); }
        else if constexpr (Epi::PERM) {
            const int row0 = cur.pm * BM + wr * 64 + fr, col0 = cur.pn * BM + wc * 32 + 8 * fq;
            E.begin_unit(cur.pn, col0);
#pragma unroll
            for (int ai = 0; ai < 2; ++ai)
#pragma unroll
                for (int m = 0; m < 4; ++m)
#pragma unroll
                    for (int bj = 0; bj < 2; ++bj) E.store8(row0 + ai * HALF + m * 16, col0 + bj * HALF, acc[ai][bj][m][0], acc[ai][bj][m][1]);
        } else {
            const int row0 = cur.pm * BM + wr * 64 + fr, col0 = cur.pn * BM + wc * 32 + 4 * fq;
#pragma unroll
            for (int ai = 0; ai < 2; ++ai)
#pragma unroll
                for (int m = 0; m < 4; ++m)
#pragma unroll
                    for (int bj = 0; bj < 2; ++bj)
#pragma unroll
                        for (int n = 0; n < 2; ++n) E.store4(row0 + ai * HALF + m * 16, col0 + bj * HALF + n * 16, acc[ai][bj][m][n]);
        }
        if (!has_next) break;
#pragma unroll
        for (int a = 0; a < 2; ++a)
#pragma unroll
            for (int b = 0; b < 2; ++b)
#pragma unroll
                for (int m = 0; m < 4; ++m)
#pragma unroll
                    for (int n = 0; n < 2; ++n) acc[a][b][m][n] = (f32x4){0.f, 0.f, 0.f, 0.f};
        cur = nxt; cA = nA; cB = nB; ++ui;
        if constexpr (ALIGN_EPI) { if (wr == 1) PG8_BAR; }
    }
    PG8_WAIT_V(0);
    if constexpr (!ALIGN_EPI) { if (wr == 0) PG8_BAR; }
    PG8_BAR;
#undef PG8_SA
#undef PG8_SB
#undef PG8_STAGE
#undef PG8_LDA
#undef PG8_LDB
#undef PG8_MMA
#undef PG8_WAIT_V
#undef PG8_WAIT_L
#undef PG8_BAR
#undef PG8_SCHED
}

}

template <class Epi>
__device__ __forceinline__ void run_gemm(LAS unsigned char* lds, const h16* A, const h16* Bt, int M, int N, int K, int bid, int nb, const Epi& E, int wgm) {
    pg8::Gemm g{A, Bt, M, N, K};
    pg8::StaticOrder S; S.init(M, N, nb, bid, wgm);
    pg8::gemm_phase(lds, g, S, E);
}

__device__ __forceinline__ u32x2 pack_h4(f32x4 v) {
    h16x2 a = {(h16)v[0], (h16)v[1]}, b = {(h16)v[2], (h16)v[3]};
    u32x2 r; r.x = __builtin_bit_cast(unsigned, a); r.y = __builtin_bit_cast(unsigned, b); return r;
}

__device__ __forceinline__ u32x4 pack_h8(f32x4 a, f32x4 b) { const u32x2 x = pack_h4(a), y = pack_h4(b); return (u32x4){x.x, x.y, y.x, y.y}; }
struct EpiProj {
    static constexpr bool PERM = true, CUSTOM = true;
    h16* cq; float* ssq; h16* ckv; h16* kidx; float* widx; h16* projB; const float* gkv; const float* gk; const float* bk;
    __device__ __forceinline__ void run(const f32x4 (&acc)[2][2][4][2], const pg8::Unit& u, int wr, int wc, int fr, int fq, LAS unsigned char* lds) const {
        const int row0 = u.pm * 256 + wr * 64 + fr, cin = wc * 32 + 8 * fq;
        if (u.pn >= 8) {
            h16* base = projB + (size_t)row0 * 2048 + 1024 + (u.pn - 8) * 128 + cin;
#pragma unroll
            for (int ai = 0; ai < 2; ++ai)
#pragma unroll
                for (int m = 0; m < 4; ++m) *(u32x4*)(base + (size_t)(ai * 128 + m * 16) * 2048) = pack_h8(acc[ai][0][m][0] * acc[ai][1][m][0], acc[ai][0][m][1] * acc[ai][1][m][1]);
            return;
        }
        if (u.pn >= 4) {
            h16* base = projB + (size_t)row0 * 2048 + (u.pn - 4) * 256 + cin;
#pragma unroll
            for (int ai = 0; ai < 2; ++ai)
#pragma unroll
                for (int m = 0; m < 4; ++m)
#pragma unroll
                    for (int bj = 0; bj < 2; ++bj) *(u32x4*)(base + (size_t)(ai * 128 + m * 16) * 2048 + bj * 128) = pack_h8(acc[ai][bj][m][0], acc[ai][bj][m][1]);
            return;
        }
        LAS float* P = (LAS float*)(lds + 131072);
        if (u.pn == 3) {
            if (wc < 2) {
#pragma unroll
                for (int ai = 0; ai < 2; ++ai)
#pragma unroll
                    for (int m = 0; m < 4; ++m) {
                        const f32x4 a = acc[ai][0][m][0], b = acc[ai][0][m][1];
                        float sm = (a[0] + a[1]) + (a[2] + a[3]) + (b[0] + b[1]) + (b[2] + b[3]);
                        float sq = (a[0] * a[0] + a[1] * a[1]) + (a[2] * a[2] + a[3] * a[3]) + (b[0] * b[0] + b[1] * b[1]) + (b[2] * b[2] + b[3] * b[3]);
                        sm += __shfl_xor(sm, 16); sm += __shfl_xor(sm, 32); sq += __shfl_xor(sq, 16); sq += __shfl_xor(sq, 32);
                        if (fq == 0) *(LAS f32x2*)(P + ((ai * 128 + wr * 64 + m * 16 + fr) * 2 + wc) * 2) = (f32x2){sm, sq};
                    }
            }
            asm volatile("s_waitcnt lgkmcnt(0)" ::: "memory"); __builtin_amdgcn_s_barrier(); asm volatile("" ::: "memory");
            if (wc < 2) {
                const f32x4 g0 = *(const f32x4*)(gk + cin), g1 = *(const f32x4*)(gk + cin + 4), b0 = *(const f32x4*)(bk + cin), b1 = *(const f32x4*)(bk + cin + 4);
#pragma unroll
                for (int ai = 0; ai < 2; ++ai)
#pragma unroll
                    for (int m = 0; m < 4; ++m) {
                        const f32x4 pp = *(const LAS f32x4*)(P + (ai * 128 + wr * 64 + m * 16 + fr) * 4);
                        const float mean = (pp[0] + pp[2]) * (1.f / 64.f);
                        const f32x4 xa = acc[ai][0][m][0] - mean, xb = acc[ai][0][m][1] - mean;
                        const float var = fmaxf((pp[1] + pp[3]) * (1.f / 64.f) - mean * mean, 0.f);
                        const float rstd = rsqrtf(var + EPS);
                        *(u32x4*)(kidx + (size_t)((row0 >> 4) + ai * 8 + m) * 1024 + ((cin >> 3) * 16 + fr) * 8) = pack_h8(xa * rstd * g0 + b0, xb * rstd * g1 + b1);
                    }
            } else if (wc == 2 && fq < 2) {
#pragma unroll
                for (int ai = 0; ai < 2; ++ai)
#pragma unroll
                    for (int m = 0; m < 4; ++m) {
                        float* o = widx + (size_t)(row0 + ai * 128 + m * 16) * 16 + 8 * fq;
                        *(f32x4*)o = acc[ai][0][m][0] * (1.f / 32.f); *(f32x4*)(o + 4) = acc[ai][0][m][1] * (1.f / 32.f);
                    }
            }
            return;
        }
#pragma unroll
        for (int ai = 0; ai < 2; ++ai)
#pragma unroll
            for (int m = 0; m < 4; ++m) {
                float ss = 0.f;
#pragma unroll
                for (int bj = 0; bj < 2; ++bj)
#pragma unroll
                    for (int n = 0; n < 2; ++n) { const f32x4 v = acc[ai][bj][m][n]; ss += (v[0] * v[0] + v[1] * v[1]) + (v[2] * v[2] + v[3] * v[3]); }
                ss += __shfl_xor(ss, 16); ss += __shfl_xor(ss, 32);
                if (fq == 0) P[(ai * 128 + wr * 64 + m * 16 + fr) * 4 + wc] = ss;
            }
        asm volatile("s_waitcnt lgkmcnt(0)" ::: "memory"); __builtin_amdgcn_s_barrier(); asm volatile("" ::: "memory");
        if (u.pn < 2) {
            h16* base = cq + (size_t)row0 * 512 + u.pn * 256 + cin;
#pragma unroll
            for (int ai = 0; ai < 2; ++ai)
#pragma unroll
                for (int m = 0; m < 4; ++m) {
#pragma unroll
                    for (int bj = 0; bj < 2; ++bj) *(u32x4*)(base + (size_t)(ai * 128 + m * 16) * 512 + bj * 128) = pack_h8(acc[ai][bj][m][0], acc[ai][bj][m][1]);
                    if (wc == 0 && fq == 0) { const f32x4 pp = *(const LAS f32x4*)(P + (ai * 128 + wr * 64 + m * 16 + fr) * 4); ssq[(size_t)(row0 + ai * 128 + m * 16) * 2 + u.pn] = (pp[0] + pp[1]) + (pp[2] + pp[3]); }
                }
        } else {
            h16* base = ckv + (size_t)row0 * 256 + cin;
            f32x4 g[2][2];
#pragma unroll
            for (int bj = 0; bj < 2; ++bj)
#pragma unroll
                for (int n = 0; n < 2; ++n) g[bj][n] = *(const f32x4*)(gkv + cin + bj * 128 + 4 * n);
#pragma unroll
            for (int ai = 0; ai < 2; ++ai)
#pragma unroll
                for (int m = 0; m < 4; ++m) {
                    const f32x4 pp = *(const LAS f32x4*)(P + (ai * 128 + wr * 64 + m * 16 + fr) * 4);
                    const float rstd = rsqrtf(((pp[0] + pp[1]) + (pp[2] + pp[3])) * (1.f / 256.f) + EPS);
#pragma unroll
                    for (int bj = 0; bj < 2; ++bj) *(u32x4*)(base + (size_t)(ai * 128 + m * 16) * 256 + bj * 128) = pack_h8(acc[ai][bj][m][0] * rstd * g[bj][0], acc[ai][bj][m][1] * rstd * g[bj][1]);
                }
        }
    }
};
struct EpiQ {
    static constexpr bool PERM = true, CUSTOM = true;
    h16* qabs; h16* iq; const float* gq; const float* ssq;
    __device__ __forceinline__ void run(const f32x4 (&acc)[2][2][4][2], const pg8::Unit& u, int wr, int wc, int fr, int fq, LAS unsigned char* lds) const {
        const int row0 = u.pm * 256 + wr * 64 + fr, cin = wc * 32 + 8 * fq;
        float rr[2][4];
#pragma unroll
        for (int ai = 0; ai < 2; ++ai)
#pragma unroll
            for (int m = 0; m < 4; ++m) { const f32x2 s2 = *(const f32x2*)(ssq + (size_t)(row0 + ai * 128 + m * 16) * 2); rr[ai][m] = rsqrtf((s2[0] + s2[1]) * (1.f / 512.f) + EPS); }
        if (u.pn >= 8) {
            h16* base = iq + (size_t)row0 * 1024 + ((((wc & 1) * 4 + fq) * 16) + (u.pn - 8) * 4 + (wc >> 1)) * 8;
#pragma unroll
            for (int ai = 0; ai < 2; ++ai)
#pragma unroll
                for (int m = 0; m < 4; ++m)
#pragma unroll
                    for (int bj = 0; bj < 2; ++bj) *(u32x4*)(base + (size_t)(ai * 128 + m * 16) * 1024 + bj * 16) = pack_h8(acc[ai][bj][m][0] * rr[ai][m], acc[ai][bj][m][1] * rr[ai][m]);
            return;
        }
        LAS float* P = (LAS float*)(lds + 131072);
#pragma unroll
        for (int ai = 0; ai < 2; ++ai)
#pragma unroll
            for (int m = 0; m < 4; ++m) {
                float ss = 0.f;
#pragma unroll
                for (int bj = 0; bj < 2; ++bj)
#pragma unroll
                    for (int n = 0; n < 2; ++n) { const f32x4 v = acc[ai][bj][m][n]; ss += (v[0] * v[0] + v[1] * v[1]) + (v[2] * v[2] + v[3] * v[3]); }
                ss += __shfl_xor(ss, 16); ss += __shfl_xor(ss, 32);
                if (fq == 0) P[(ai * 128 + wr * 64 + m * 16 + fr) * 4 + wc] = ss * (rr[ai][m] * rr[ai][m]);
            }
        asm volatile("s_waitcnt lgkmcnt(0)" ::: "memory"); __builtin_amdgcn_s_barrier(); asm volatile("" ::: "memory");
        h16* base = qabs + (size_t)row0 * 2048 + u.pn * 256 + cin;
        f32x4 g[2][2];
#pragma unroll
        for (int bj = 0; bj < 2; ++bj)
#pragma unroll
            for (int n = 0; n < 2; ++n) g[bj][n] = *(const f32x4*)(gq + cin + bj * 128 + 4 * n) * 0.0625f;
#pragma unroll
        for (int ai = 0; ai < 2; ++ai)
#pragma unroll
            for (int m = 0; m < 4; ++m) {
                const f32x4 pp = *(const LAS f32x4*)(P + (ai * 128 + wr * 64 + m * 16 + fr) * 4);
                const float rstd = rsqrtf(((pp[0] + pp[1]) + (pp[2] + pp[3])) * (1.f / 256.f) + EPS) * rr[ai][m];
#pragma unroll
                for (int bj = 0; bj < 2; ++bj) *(u32x4*)(base + (size_t)(ai * 128 + m * 16) * 2048 + bj * 128) = pack_h8(acc[ai][bj][m][0] * rstd * g[bj][0], acc[ai][bj][m][1] * rstd * g[bj][1]);
            }
    }
};
struct EpiF16 {
    static constexpr bool PERM = true, CUSTOM = false;
    h16* o; const float* bias; mutable f32x4 bz[2][2]; mutable int cbase;
    __device__ __forceinline__ void begin_unit(int, int col0) const {
        cbase = col0;
#pragma unroll
        for (int bj = 0; bj < 2; ++bj)
#pragma unroll
            for (int n = 0; n < 2; ++n) bz[bj][n] = bias ? *(const f32x4*)(bias + col0 + bj * 128 + 4 * n) : (f32x4){0.f, 0.f, 0.f, 0.f};
    }
    __device__ __forceinline__ void store8(int row, int col, f32x4 v0, f32x4 v1) const {
        const int bj = (col - cbase) >> 7;
        *(u32x4*)(o + (size_t)row * 2048 + col) = pack_h8(v0 + (bj ? bz[1][0] : bz[0][0]), v1 + (bj ? bz[1][1] : bz[0][1]));
    }
};
struct EpiX1 {
    static constexpr bool PERM = true, CUSTOM = true;
    h16* x1; const float* x; const float* mod;
    __device__ __forceinline__ void run(const f32x4 (&acc)[2][2][4][2], const pg8::Unit& u, int wr, int wc, int fr, int fq, LAS unsigned char*) const {
        const int row0 = u.pm * 256 + wr * 64 + fr, col0 = u.pn * 256 + wc * 32 + 8 * fq;
        const float* g1p = mod + ((u.pm * 256) >> 12) * 12288 + 2 * 2048;
        f32x4 gz[2][2];
#pragma unroll
        for (int bj = 0; bj < 2; ++bj)
#pragma unroll
            for (int n = 0; n < 2; ++n) gz[bj][n] = *(const f32x4*)(g1p + col0 + bj * 128 + 4 * n);
#pragma unroll
        for (int ai = 0; ai < 2; ++ai) {
            f32x4 xr[4][2][2];
#pragma unroll
            for (int m = 0; m < 4; ++m)
#pragma unroll
                for (int bj = 0; bj < 2; ++bj) { const float* xp = x + (size_t)(row0 + ai * 128 + m * 16) * 2048 + col0 + bj * 128; xr[m][bj][0] = *(const f32x4*)xp; xr[m][bj][1] = *(const f32x4*)(xp + 4); }
#pragma unroll
            for (int m = 0; m < 4; ++m)
#pragma unroll
                for (int bj = 0; bj < 2; ++bj)
                    *(u32x4*)(x1 + (size_t)(row0 + ai * 128 + m * 16) * 2048 + col0 + bj * 128) = pack_h8(xr[m][bj][0] + gz[bj][0] * acc[ai][bj][m][0], xr[m][bj][1] + gz[bj][1] * acc[ai][bj][m][1]);
        }
    }
};
struct EpiFinal {
    static constexpr bool PERM = true, CUSTOM = true;
    float* out; const h16* x1; const float* b2; const float* mod;
    __device__ __forceinline__ void run(const f32x4 (&acc)[2][2][4][2], const pg8::Unit& u, int wr, int wc, int fr, int fq, LAS unsigned char*) const {
        const int row0 = u.pm * 256 + wr * 64 + fr, col0 = u.pn * 256 + wc * 32 + 8 * fq;
        const float* g2p = mod + ((u.pm * 256) >> 12) * 12288 + 5 * 2048;
        f32x4 bz[2][2], gz[2][2];
#pragma unroll
        for (int bj = 0; bj < 2; ++bj)
#pragma unroll
            for (int n = 0; n < 2; ++n) { bz[bj][n] = *(const f32x4*)(b2 + col0 + bj * 128 + 4 * n); gz[bj][n] = *(const f32x4*)(g2p + col0 + bj * 128 + 4 * n); }
#pragma unroll
        for (int ai = 0; ai < 2; ++ai) {
            u32x4 xr[4][2];
#pragma unroll
            for (int m = 0; m < 4; ++m)
#pragma unroll
                for (int bj = 0; bj < 2; ++bj) xr[m][bj] = *(const u32x4*)(x1 + (size_t)(row0 + ai * 128 + m * 16) * 2048 + col0 + bj * 128);
#pragma unroll
            for (int m = 0; m < 4; ++m)
#pragma unroll
                for (int bj = 0; bj < 2; ++bj) {
                    const h16x8 xh = __builtin_bit_cast(h16x8, xr[m][bj]);
                    const f32x4 x0 = {(float)xh[0], (float)xh[1], (float)xh[2], (float)xh[3]}, x1v = {(float)xh[4], (float)xh[5], (float)xh[6], (float)xh[7]};
                    float* op = out + (size_t)(row0 + ai * 128 + m * 16) * 2048 + col0 + bj * 128;
                    *(f32x4*)op = x0 + gz[bj][0] * (acc[ai][bj][m][0] + bz[bj][0]);
                    *(f32x4*)(op + 4) = x1v + gz[bj][1] * (acc[ai][bj][m][1] + bz[bj][1]);
                }
        }
    }
};
struct EpiMlp1 {
    static constexpr bool PERM = true, CUSTOM = false;
    LAS const h16* b1l; h16* a; mutable f32x4 bz[2][2]; mutable int cbase;
    __device__ __forceinline__ void begin_unit(int, int col0) const {
        cbase = col0;
#pragma unroll
        for (int bj = 0; bj < 2; ++bj)
#pragma unroll
            for (int n = 0; n < 2; ++n) { const h16x4 hb = *(LAS const h16x4*)(b1l + col0 + bj * 128 + 4 * n); bz[bj][n] = (f32x4){(float)hb[0], (float)hb[1], (float)hb[2], (float)hb[3]}; }
    }
    __device__ __forceinline__ f32x4 actb(f32x4 v, f32x4 b) const {
        f32x4 z = v + b;
#pragma unroll
        for (int j = 0; j < 4; ++j) { const float r = fmaxf(z[j], 0.f); z[j] = r * r; }
        return z;
    }
    __device__ __forceinline__ void store8(int row, int col, f32x4 v0, f32x4 v1) const {
        const int bj = (col - cbase) >> 7;
        *(u32x4*)(a + (size_t)row * D_FF + col) = pack_h8(actb(v0, bj ? bz[1][0] : bz[0][0]), actb(v1, bj ? bz[1][1] : bz[0][1]));
    }
};
constexpr int FQ_OUT = 32 * 64, FQ_1 = 32 * 256, FQ_2 = 128 * 64, FQ_TOTAL = FQ_OUT + FQ_1 + FQ_2, LATE0 = 0;
__device__ __forceinline__ void late_item_geom(const float* w_out, const float* w_mlp1, const float* w_mlp2, unsigned char* ws, int qi, const float*& src, int& ld, int& k0, int& n0, h16*& dst, int& dld) {
    int r = qi;
    if (r < FQ_OUT) { const int kb = r / 64, nbk = r % 64; src = w_out; ld = 2048; k0 = kb * 64; n0 = nbk * 32; dst = (h16*)(ws + WS_BT_OUT); dld = 2048; }
    else if ((r -= FQ_OUT) < FQ_1) { const int kb = r / 256, nbk = r % 256; src = w_mlp1; ld = D_FF; k0 = kb * 64; n0 = nbk * 32; dst = (h16*)(ws + WS_BT_1); dld = 2048; }
    else { r -= FQ_1; const int kb = r / 64, nbk = r % 64; src = w_mlp2; ld = 2048; k0 = kb * 64; n0 = nbk * 32; dst = (h16*)(ws + WS_BT_2); dld = 8192; }
}
__device__ __forceinline__ void late_item_load(const float* w_out, const float* w_mlp1, const float* w_mlp2, unsigned char* ws, int qi, float (&v)[32], int lane) {
    const float* src; int ld, k0, n0, dld; h16* dst;
    late_item_geom(w_out, w_mlp1, w_mlp2, ws, qi, src, ld, k0, n0, dst, dld);
    const float* sp = src + (size_t)(k0 + (lane >> 5)) * ld + n0 + (lane & 31);
#pragma unroll
    for (int i = 0; i < 32; ++i) v[i] = sp[(size_t)(2 * i) * ld];
}
__device__ __forceinline__ void late_item_finish(const float* w_out, const float* w_mlp1, const float* w_mlp2, unsigned char* ws, int qi, const float (&v)[32], int lane) {
    const float* src; int ld, k0, n0, dld; h16* dst;
    late_item_geom(w_out, w_mlp1, w_mlp2, ws, qi, src, ld, k0, n0, dst, dld);
    const int n = lane & 31, hi = lane >> 5;
    float rcv[16];
#pragma unroll
    for (int i = 0; i < 16; ++i) { const float t = hi ? v[i] : v[16 + i]; rcv[i] = __shfl_xor(t, 32); }
    h16x8 o[4];
#pragma unroll
    for (int i = 0; i < 16; ++i) {
        const float e0 = hi ? rcv[i] : v[i], e1 = hi ? v[16 + i] : rcv[i];
        o[i >> 2][2 * (i & 3)] = (h16)e0; o[i >> 2][2 * (i & 3) + 1] = (h16)e1;
    }
    h16* dp = dst + (size_t)(n0 + n) * dld + k0 + 32 * hi;
#pragma unroll
    for (int j = 0; j < 4; ++j) *(h16x8*)(dp + 8 * j) = o[j];
}
template <bool SCALE>
__device__ __forceinline__ void transpose_item(const float* __restrict__ src, int ld, int k0, int n0, int nvalid, const float* __restrict__ kscale,
                                               h16* __restrict__ dst, int dst_ld, int dst_row0, int dst_k0, LAS float* scr, int lane, bool frag = false) {
    const int n = lane & 31, nn = n < nvalid ? n : nvalid - 1;
    const float msk = n < nvalid ? 1.f : 0.f;
    const float* sp = src + (size_t)(k0 + (lane >> 5)) * ld + n0 + nn;
    float v[32];
#pragma unroll
    for (int i = 0; i < 32; ++i) v[i] = sp[(size_t)(2 * i) * ld];
    if (SCALE) {
        float sc[32];
#pragma unroll
        for (int i = 0; i < 32; ++i) sc[i] = kscale[k0 + 2 * i + (lane >> 5)];
#pragma unroll
        for (int i = 0; i < 32; ++i) v[i] *= sc[i];
    }
#pragma unroll
    for (int i = 0; i < 32; ++i) scr[(2 * i + (lane >> 5)) * 33 + n] = v[i] * msk;
    LDS_WAIT(); asm volatile("" ::: "memory");
    const int c = lane & 7;
#pragma unroll
    for (int j = 0; j < 4; ++j) {
        const int nr = (lane >> 3) + 8 * j; const LAS float* s = scr + (8 * c) * 33 + nr;
        h16x8 o;
#pragma unroll
        for (int q = 0; q < 8; ++q) o[q] = (h16)s[q * 33];
        if (frag) *(h16x8*)(dst + (size_t)(((((dst_row0 >> 5) * 16 + ((dst_k0 + 8 * c) >> 4)) * 2 + (((dst_k0 + 8 * c) >> 3) & 1)) * 32 + nr) * 8)) = o;
        else *(h16x8*)(dst + (size_t)(dst_row0 + nr) * dst_ld + dst_k0 + 8 * c) = o;
    }
    LDS_WAIT(); asm volatile("" ::: "memory");
}

__device__ __forceinline__ void phase_prep(const Params& p, LAS unsigned char* lds, int bid, int nb) {
    const int tid = threadIdx.x, lane = tid & 63, wave = tid >> 6;
    unsigned char* ws = p.ws;
    __syncthreads();
    {
        LAS f32x4* cact = (LAS f32x4*)lds;
        LAS float* red = (LAS float*)(lds + 32768);
        {
            float cvv[16];
#pragma unroll
            for (int q = 0; q < 16; ++q) cvv[q] = p.c[tid + q * NTHREADS];
#pragma unroll
            for (int q = 0; q < 16; ++q) { const int i = tid + q * NTHREADS, b = i >> 11, k = i & 2047; const float v = cvv[q]; ((LAS float*)cact)[k * 4 + b] = v / (1.f + __expf(-v)); }
        }
        __syncthreads();
        float* mod = (float*)(ws + WS_MOD);
        const int NCG = (nb == 256) ? 256 : 192, CW = (nb == 256) ? 48 : 64;
        for (int cgp = bid; cgp < NCG; cgp += nb) {
            const int col = cgp * CW + (lane < CW ? lane : CW - 1);
            float a0 = 0.f, a1 = 0.f, a2 = 0.f, a3 = 0.f;
            const float* wp = p.w_ada + (size_t)(wave * 256) * 12288 + col;
            for (int kb = 0; kb < 256; kb += 32) {
                float wv[32];
#pragma unroll
                for (int j = 0; j < 32; ++j) wv[j] = wp[(size_t)(kb + j) * 12288];
#pragma unroll
                for (int j = 0; j < 32; ++j) { const f32x4 cv = cact[wave * 256 + kb + j]; a0 += cv[0] * wv[j]; a1 += cv[1] * wv[j]; a2 += cv[2] * wv[j]; a3 += cv[3] * wv[j]; }
            }
            red[(wave * 4 + 0) * 64 + lane] = a0; red[(wave * 4 + 1) * 64 + lane] = a1; red[(wave * 4 + 2) * 64 + lane] = a2; red[(wave * 4 + 3) * 64 + lane] = a3;
            __syncthreads();
            if (tid < 256) {
                const int b = tid >> 6, l = tid & 63; float s = 0.f;
#pragma unroll
                for (int w = 0; w < 8; ++w) s += red[(w * 4 + b) * 64 + l];
                const int cc = cgp * CW + l;
                if (l < CW) mod[b * 12288 + cc] = s + p.b_ada[cc];
            }
            __syncthreads();
        }
    }
    LAS float* scr = (LAS float*)(lds + wave * 16384);
    const int gw = bid * NWAVES + wave, NGW = nb * NWAVES;
    constexpr int I_IN = 32 * 128, I_1 = 0, I_2 = 0, I_OUT = 0, I_IQ = 8 * 32, I_UV = 8 * 4 * 4, I_QA = 8 * 8 * 8;
    constexpr int NITEMS = I_IN + I_1 + I_2 + I_OUT + I_IQ + I_UV + I_QA;
    const bool bal = (nb == 256);
    const int nextra = 0, base_it = 0; (void)bal;
    const int nstr = (NITEMS - I_QA - base_it - gw + NGW - 1) / NGW;
    for (int kk = 0; kk < nextra + nstr; ++kk) {
        int it;
        if (kk < nextra) { if (bid < 192) continue; it = ((bid - 192) * NWAVES + wave) + 512 * kk; }
        else it = base_it + gw + (kk - nextra) * NGW;
        int r = it; bool isuv = false;
        const float* src; int ld, k0, n0, nvalid = 32, dld, drow0; const float* ksc = nullptr; h16* dst;
        if (r < I_IN) {
            const int kb = r / 128, nbk = r % 128, n0d = nbk * 32;
            if (n0d >= 864 && n0d < 1024) continue;
            src = p.w_in; ld = IN_COLS; k0 = kb * 64; n0 = n0d < 1024 ? n0d : (n0d < 2048 ? n0d - 176 : (((n0d - 2048) & 255) < 128 ? 1872 : 2896) + 128 * ((n0d - 2048) >> 8) + ((n0d - 2048) & 127)); nvalid = (n0d == 832) ? 16 : 32;     dst = (h16*)(ws + WS_BT_IN); dld = 2048; drow0 = n0d;
        } else if ((r -= I_IN) < I_1) { const int kb = r / 256, nbk = r % 256; src = p.w_mlp1; ld = D_FF; k0 = kb * 64; n0 = nbk * 32; dst = (h16*)(ws + WS_BT_1); dld = 2048; drow0 = n0; }
        else if ((r -= I_1) < I_2) { const int kb = r / 64, nbk = r % 64; src = p.w_mlp2; ld = 2048; k0 = kb * 64; n0 = nbk * 32; dst = (h16*)(ws + WS_BT_2); dld = 8192; drow0 = n0; }
        else if ((r -= I_2) < I_OUT) { const int kb = r / 64, nbk = r % 64; src = p.w_out; ld = 2048; k0 = kb * 64; n0 = nbk * 32; dst = (h16*)(ws + WS_BT_OUT); dld = 2048; drow0 = n0; }
        else if ((r -= I_OUT) < I_IQ) { const int kb = r / 32, nbk = r % 32; src = p.w_iq; ld = 1024; k0 = kb * 64; n0 = nbk * 32; ksc = p.cq_norm_g; dst = (h16*)(ws + WS_BT_Q); dld = 512; drow0 = 2048 + n0; }
        else { r -= I_IQ; isuv = true; const int h = r / 16, kb = (r % 16) / 4, nbk = r % 4; src = p.w_uv + (size_t)h * 256 * 128; ld = 128; k0 = kb * 64; n0 = nbk * 32; dst = (h16*)(ws + WS_WUVT) + (size_t)h * 128 * 256; dld = 256; drow0 = n0; }
        if (ksc) transpose_item<true>(src, ld, k0, n0, nvalid, ksc, dst, dld, drow0, k0, scr, lane);
        else transpose_item<false>(src, ld, k0, n0, nvalid, ksc, dst, dld, drow0, k0, scr, lane, isuv);
    }
    for (int r4 = gw; r4 < I_QA * 4; r4 += NGW) {
        {
            const int r = r4 >> 2, h = r / 64, kb = (r % 64) / 8, cb = r % 8, k0 = kb * 64, c0 = cb * 32 + (r4 & 3) * 8;
#pragma unroll 8
            for (int e = lane; e < 128 * 8; e += 64) { const int d = e >> 3, c = e & 7; scr[e] = p.w_uk[((size_t)h * 128 + d) * 256 + c0 + c]; }
            LDS_WAIT(); asm volatile("" ::: "memory");
            float acc[8];
#pragma unroll
            for (int c = 0; c < 8; ++c) acc[c] = 0.f;
            const float* uq = p.w_uq + (size_t)(k0 + lane) * 1024 + h * 128;
            f32x4 ar[4];
#pragma unroll
            for (int u = 0; u < 4; ++u) ar[u] = *(const f32x4*)(uq + 4 * u);
#pragma unroll 1
            for (int d0 = 0; d0 < 128; d0 += 16) {
#pragma unroll
                for (int u = 0; u < 4; ++u) {
                    const f32x4 av = ar[u];
                    const int dn = d0 + 16 + 4 * u;
                    ar[u] = *(const f32x4*)(uq + (dn < 128 ? dn : 124));
#pragma unroll
                    for (int dd = 0; dd < 4; ++dd) {
                        const f32x4 w0 = *(const LAS f32x4*)(scr + (d0 + 4 * u + dd) * 8), w1 = *(const LAS f32x4*)(scr + (d0 + 4 * u + dd) * 8 + 4);
                        acc[0] += av[dd] * w0[0]; acc[1] += av[dd] * w0[1]; acc[2] += av[dd] * w0[2]; acc[3] += av[dd] * w0[3];
                        acc[4] += av[dd] * w1[0]; acc[5] += av[dd] * w1[1]; acc[6] += av[dd] * w1[2]; acc[7] += av[dd] * w1[3];
                    }
                }
            }
            const float gk = p.cq_norm_g[k0 + lane];
            h16* dst = (h16*)(ws + WS_BT_Q);
            h16* dp = dst + (size_t)(h * 256 + c0) * 512 + k0 + lane;
#pragma unroll
            for (int c = 0; c < 8; ++c) dp[(size_t)c * 512] = (h16)(acc[c] * gk);
            LDS_WAIT(); asm volatile("" ::: "memory");
        }
    }
    {
        u32x4* z = (u32x4*)((h16*)(ws + WS_BT_IN) + (size_t)848 * 2048);
        const int n16 = 176 * 2048 * 2 / 16;
        for (int i = bid * NTHREADS + tid; i < n16; i += nb * NTHREADS) z[i] = (u32x4){0u, 0u, 0u, 0u};
    }
}

__device__ __forceinline__ void phase_normmod(const float* __restrict__ xin, const float* __restrict__ g, const float* __restrict__ mod, int sh_off, int sc_off, h16* __restrict__ hout, int bid, int nb, f32x4 (&v)[8]) {
    const int tid = threadIdx.x, lane = tid & 63, wave = tid >> 6;
    const int tstep = nb * NWAVES;
    int t = bid * NWAVES + wave;
    for (; t < T; t += tstep) {
        const int b = t >> 12;
        const float* mb = mod + b * 12288;
        f32x4 vn[8], gg[8], sc[8], sh[8]; float ss = 0.f;
        {
            const int tn = t + tstep < T ? t + tstep : t;
            const f32x4* xn = (const f32x4*)(xin + (size_t)tn * 2048) + lane;
#pragma unroll
            for (int j = 0; j < 8; ++j) vn[j] = xn[64 * j];
        }
#pragma unroll
        for (int j = 0; j < 8; ++j) { const int d = (lane + 64 * j) * 4; gg[j] = *(const f32x4*)(g + d); sc[j] = *(const f32x4*)(mb + sc_off + d); sh[j] = *(const f32x4*)(mb + sh_off + d); }
#pragma unroll
        for (int j = 0; j < 8; ++j) ss += (v[j][0] * v[j][0] + v[j][1] * v[j][1]) + (v[j][2] * v[j][2] + v[j][3] * v[j][3]);
        const float rstd = rsqrtf(wave_sum(ss) * (1.f / 2048.f) + EPS);
        u32x2* o = (u32x2*)(hout + (size_t)t * 2048) + lane;
        u32x2 ov[8];
#pragma unroll
        for (int j = 0; j < 8; ++j) {
            f32x4 y = (v[j] * rstd) * gg[j];
            y = y * (sc[j] + 1.f) + sh[j];
            ov[j] = pack_h4(y);
        }
#pragma unroll
        for (int j = 0; j < 8; ++j) o[64 * j] = ov[j];
#pragma unroll
        for (int j = 0; j < 8; ++j) v[j] = vn[j];
    }
}

__device__ __forceinline__ void phase_normmod2(const Params& p, int bid, int nb) {
    const int tid = threadIdx.x, lane = tid & 63, wave = tid >> 6;
    const float* mod = (const float*)(p.ws + WS_MOD); const h16* x16 = (const h16*)(p.ws + WS_Y6); h16* hout = (h16*)(p.ws + WS_R2);
    const int tstep = nb * NWAVES;
    int t = bid * NWAVES + wave;
    u32x2 x2[8];
    if (t < T) {
        const u32x2* xr = (const u32x2*)(x16 + (size_t)t * 2048) + lane;
#pragma unroll
        for (int j = 0; j < 8; ++j) x2[j] = xr[64 * j];
    }
    for (; t < T; t += tstep) {
        const int b = t >> 12; const float* mb = mod + b * 12288;
        f32x4 v[8], gg[8], sc[8], sh[8]; float ss = 0.f;
        u32x2 xn2[8];
        {
            const int tn = t + tstep < T ? t + tstep : t;
            const u32x2* xn = (const u32x2*)(x16 + (size_t)tn * 2048) + lane;
#pragma unroll
            for (int j = 0; j < 8; ++j) xn2[j] = xn[64 * j];
        }
#pragma unroll
        for (int j = 0; j < 8; ++j) { const int d = (lane + 64 * j) * 4; gg[j] = *(const f32x4*)(p.norm2_g + d); sc[j] = *(const f32x4*)(mb + 4 * 2048 + d); sh[j] = *(const f32x4*)(mb + 3 * 2048 + d); }
#pragma unroll
        for (int j = 0; j < 8; ++j) {
            const h16x4 xh = __builtin_bit_cast(h16x4, x2[j]);
            v[j] = (f32x4){(float)xh[0], (float)xh[1], (float)xh[2], (float)xh[3]};
            ss += (v[j][0] * v[j][0] + v[j][1] * v[j][1]) + (v[j][2] * v[j][2] + v[j][3] * v[j][3]);
        }
        const float rstd = rsqrtf(wave_sum(ss) * (1.f / 2048.f) + EPS);
        u32x2* o = (u32x2*)(hout + (size_t)t * 2048) + lane;
        u32x2 ov[8];
#pragma unroll
        for (int j = 0; j < 8; ++j) {
            f32x4 y = (v[j] * rstd) * gg[j];
            y = y * (sc[j] + 1.f) + sh[j];
            ov[j] = pack_h4(y);
        }
#pragma unroll
        for (int j = 0; j < 8; ++j) o[64 * j] = ov[j];
#pragma unroll
        for (int j = 0; j < 8; ++j) x2[j] = xn2[j];
    }
}
__device__ __forceinline__ void phase_final(const Params& p, int bid, int nb) {
    const int tid = threadIdx.x, lane = tid & 63, wave = tid >> 6;
    const float* mod = (const float*)(p.ws + WS_MOD); const h16* x16 = (const h16*)(p.ws + WS_Y6); const h16* m16 = (const h16*)(p.ws + WS_R2);
    for (int t = bid * NWAVES + wave; t < T; t += nb * NWAVES) {
        const int b = t >> 12; const float* mb = mod + b * 12288;
        const u32x2* xr = (const u32x2*)(x16 + (size_t)t * 2048) + lane;
        const u32x2* mr = (const u32x2*)(m16 + (size_t)t * 2048) + lane;
        f32x4* orow = (f32x4*)(p.out + (size_t)t * 2048) + lane;
        f32x4 g2[8]; u32x2 x2[8], m2[8];
#pragma unroll
        for (int j = 0; j < 8; ++j) { x2[j] = xr[64 * j]; m2[j] = mr[64 * j]; }
#pragma unroll
        for (int j = 0; j < 8; ++j) { const int d = (lane + 64 * j) * 4; g2[j] = *(const f32x4*)(mb + 5 * 2048 + d); }
        f32x4 res[8];
#pragma unroll
        for (int j = 0; j < 8; ++j) {
            const h16x4 xh = __builtin_bit_cast(h16x4, x2[j]), mh = __builtin_bit_cast(h16x4, m2[j]);
            const f32x4 xv = {(float)xh[0], (float)xh[1], (float)xh[2], (float)xh[3]}, mv = {(float)mh[0], (float)mh[1], (float)mh[2], (float)mh[3]};
            res[j] = xv + g2[j] * mv;
        }
#pragma unroll
        for (int j = 0; j < 8; ++j) orow[64 * j] = res[j];
    }
}

__device__ __forceinline__ void phase_rows3(const Params& p, int bid, int nb) {
    const int tid = threadIdx.x, lane = tid & 63, wave = tid >> 6;
    unsigned char* ws = p.ws;
    const h16* projB = (const h16*)(ws + WS_PROJB);
    h16* ymix = (h16*)(ws + WS_R2);
    f32x4 w0[4], w1[4], w2[4], bb[4], gn[4];
#pragma unroll
    for (int q4 = 0; q4 < 4; ++q4) {
        const int c = lane * 16 + q4 * 4;
        w0[q4] = *(const f32x4*)(p.conv_w + c); w1[q4] = *(const f32x4*)(p.conv_w + 1024 + c); w2[q4] = *(const f32x4*)(p.conv_w + 2048 + c);
        bb[q4] = *(const f32x4*)(p.conv_b + c); gn[q4] = *(const f32x4*)(p.conv_out_norm_g + c);
    }
    for (int t = bid * NWAVES + wave; t < T; t += nb * NWAVES) {
        const int tl = t & (SEQ - 1);
        const h16* pb = projB + (size_t)t * 2048 + lane * 16;
        const int d1 = tl >= 1 ? 1 : 0, d2 = tl >= 2 ? 2 : 0;
        const float m1 = tl >= 1 ? 1.f : 0.f, m2 = tl >= 2 ? 1.f : 0.f;
        h16x8 gbv[2], uv[3][2];
#pragma unroll
        for (int hh = 0; hh < 2; ++hh) {
            gbv[hh] = *(const h16x8*)(pb + hh * 8);
            uv[2][hh] = *(const h16x8*)(pb + 1024 + hh * 8);
            uv[1][hh] = *(const h16x8*)(pb - (size_t)d1 * 2048 + 1024 + hh * 8);
            uv[0][hh] = *(const h16x8*)(pb - (size_t)d2 * 2048 + 1024 + hh * 8);
        }
        float y[16], ss = 0.f;
#pragma unroll
        for (int i = 0; i < 16; ++i) {
            const int hh = i >> 3, q = i & 7, q4 = i >> 2, qq = i & 3;
            const float u0 = (float)uv[0][hh][q] * m2, u1 = (float)uv[1][hh][q] * m1, u2 = (float)uv[2][hh][q];
            float sacc = bb[q4][qq] + w0[q4][qq] * u0; sacc = sacc + w1[q4][qq] * u1; sacc = sacc + w2[q4][qq] * u2;
            y[i] = (float)gbv[hh][q] * sacc; ss += y[i] * y[i];
        }
        ss += __shfl_xor(ss, 1); ss += __shfl_xor(ss, 2); ss += __shfl_xor(ss, 4);
        const float rstd = rsqrtf(ss * (1.f / 128.f) + EPS);
        h16x8 o0, o1;
#pragma unroll
        for (int q = 0; q < 8; ++q) { o0[q] = (h16)(y[q] * rstd * gn[q >> 2][q & 3]); o1[q] = (h16)(y[8 + q] * rstd * gn[2 + (q >> 2)][q & 3]); }
        *(h16x8*)(ymix + (size_t)t * 2048 + 1024 + lane * 16) = o0;
        *(h16x8*)(ymix + (size_t)t * 2048 + 1024 + lane * 16 + 8) = o1;
    }
}

__constant__ unsigned char c_bucket_thr[15] = {19, 21, 24, 27, 31, 35, 40, 46, 52, 59, 67, 77, 87, 99, 113};
__device__ __forceinline__ int t5_bucket(int n) {
    if (n < 16) return n;
    int bkt = 16;
#pragma unroll
    for (int i = 0; i < 15; ++i) bkt += (n >= (int)c_bucket_thr[i]) ? 1 : 0;
    return bkt;
}
typedef float f32x16 __attribute__((ext_vector_type(16)));
__device__ __forceinline__ float next_up(float x) {
    const unsigned u = __float_as_uint(x);
    if ((u << 1) == 0u) return __uint_as_float(1u);
    return __uint_as_float((u >> 31) ? u - 1u : u + 1u);
}
__device__ __forceinline__ float fdiv(float a, float b) { return a * __builtin_amdgcn_rcpf(b); }
__device__ __forceinline__ float qinv_upper(float p) {
    const float pt = p < 0.5f ? p : 1.f - p;
    const float tt = __builtin_amdgcn_sqrtf(-2.f * __logf(fmaxf(pt, 1e-7f)));
    const float z = tt - fdiv(2.515517f + tt * (0.802853f + tt * 0.010328f), 1.f + tt * (1.432788f + tt * (0.189269f + tt * 0.001308f)));
    return p < 0.5f ? z : -z;
}
__device__ __forceinline__ int wave_sum_dpp(int x) {
    x += __builtin_amdgcn_update_dpp(0, x, 0xB1, 0xf, 0xf, false);
    x += __builtin_amdgcn_update_dpp(0, x, 0x4E, 0xf, 0xf, false);
    x += __builtin_amdgcn_update_dpp(0, x, 0x124, 0xf, 0xf, false);
    x += __builtin_amdgcn_update_dpp(0, x, 0x128, 0xf, 0xf, false);
    return (__builtin_amdgcn_readlane(x, 0) + __builtin_amdgcn_readlane(x, 16)) + (__builtin_amdgcn_readlane(x, 32) + __builtin_amdgcn_readlane(x, 48));
}
__device__ __forceinline__ float dpp_f(float v, const int ctrl_sel) {
    const int i = __float_as_int(v);
    int r;
    if (ctrl_sel == 0) r = __builtin_amdgcn_update_dpp(i, i, 0xB1, 0xf, 0xf, false);
    else if (ctrl_sel == 1) r = __builtin_amdgcn_update_dpp(i, i, 0x4E, 0xf, 0xf, false);
    else if (ctrl_sel == 2) r = __builtin_amdgcn_update_dpp(i, i, 0x124, 0xf, 0xf, false);
    else r = __builtin_amdgcn_update_dpp(i, i, 0x128, 0xf, 0xf, false);
    return __int_as_float(r);
}
__device__ __forceinline__ float wave_sum_f_dpp(float v) {
    v += dpp_f(v, 0); v += dpp_f(v, 1); v += dpp_f(v, 2); v += dpp_f(v, 3);
    const float a = __int_as_float(__builtin_amdgcn_readlane(__float_as_int(v), 0)), b = __int_as_float(__builtin_amdgcn_readlane(__float_as_int(v), 16));
    const float c = __int_as_float(__builtin_amdgcn_readlane(__float_as_int(v), 32)), d = __int_as_float(__builtin_amdgcn_readlane(__float_as_int(v), 48));
    return (a + b) + (c + d);
}
__device__ __forceinline__ float wave_min_dpp(float v) {
    v = fminf(v, dpp_f(v, 0)); v = fminf(v, dpp_f(v, 1)); v = fminf(v, dpp_f(v, 2)); v = fminf(v, dpp_f(v, 3));
    const float a = __int_as_float(__builtin_amdgcn_readlane(__float_as_int(v), 0)), b = __int_as_float(__builtin_amdgcn_readlane(__float_as_int(v), 16));
    const float c = __int_as_float(__builtin_amdgcn_readlane(__float_as_int(v), 32)), d = __int_as_float(__builtin_amdgcn_readlane(__float_as_int(v), 48));
    return fminf(fminf(a, b), fminf(c, d));
}
__device__ __forceinline__ float wave_max_dpp(float v) {
    v = fmaxf(v, dpp_f(v, 0)); v = fmaxf(v, dpp_f(v, 1)); v = fmaxf(v, dpp_f(v, 2)); v = fmaxf(v, dpp_f(v, 3));
    const float a = __int_as_float(__builtin_amdgcn_readlane(__float_as_int(v), 0)), b = __int_as_float(__builtin_amdgcn_readlane(__float_as_int(v), 16));
    const float c = __int_as_float(__builtin_amdgcn_readlane(__float_as_int(v), 32)), d = __int_as_float(__builtin_amdgcn_readlane(__float_as_int(v), 48));
    return fmaxf(fmaxf(a, b), fmaxf(c, d));
}
typedef short s16x2 __attribute__((ext_vector_type(2)));
__device__ __forceinline__ h16x2 relu_pk(h16x2 x) { const s16x2 z = {0, 0}; return __builtin_bit_cast(h16x2, __builtin_elementwise_max(__builtin_bit_cast(s16x2, x), z)); }
__device__ __forceinline__ float relu_asm(float x) { const int i = __builtin_bit_cast(int, x); return __builtin_bit_cast(float, i > 0 ? i : 0); }
__device__ __forceinline__ int wave_excl_scan(int v) {
    int x = v;
    x += __builtin_amdgcn_update_dpp(0, x, 0x111, 0xF, 0xF, true);
    x += __builtin_amdgcn_update_dpp(0, x, 0x112, 0xF, 0xF, true);
    x += __builtin_amdgcn_update_dpp(0, x, 0x114, 0xF, 0xF, true);
    x += __builtin_amdgcn_update_dpp(0, x, 0x118, 0xF, 0xF, true);
    x += __builtin_amdgcn_update_dpp(0, x, 0x142, 0xA, 0xF, false);
    x += __builtin_amdgcn_update_dpp(0, x, 0x143, 0xC, 0xF, false);
    return x - v;
}
#define COMPACT1(addr, key, v, lo) do { unsigned long long sv_; \
    asm volatile("v_cmp_ge_f32_e32 vcc, %3, %4\n\ts_and_saveexec_b64 %2, vcc\n\tds_write2_b32 %0, %3, %1 offset1:1\n\tv_add_u32_e32 %0, 8, %0\n\ts_mov_b64 exec, %2\n\tv_add_u32_e32 %1, 64, %1" \
        : "+v"(addr), "+v"(key), "=&s"(sv_) : "v"(v), "v"(lo) : "memory", "vcc"); } while (0)
#define CNT4(cnt, a0, a1, a2, a3, t) do { unsigned long long m0_, m1_, m2_, m3_; \
    asm("v_cmp_ge_f32_e64 %1, %5, %9\n\tv_cmp_ge_f32_e64 %2, %6, %9\n\tv_cmp_ge_f32_e64 %3, %7, %9\n\tv_cmp_ge_f32_e64 %4, %8, %9\n\t" \
        "v_addc_co_u32_e64 %0, vcc, 0, %0, %1\n\tv_addc_co_u32_e64 %0, vcc, 0, %0, %2\n\tv_addc_co_u32_e64 %0, vcc, 0, %0, %3\n\tv_addc_co_u32_e64 %0, vcc, 0, %0, %4" \
        : "+v"(cnt), "=&s"(m0_), "=&s"(m1_), "=&s"(m2_), "=&s"(m3_) : "v"(a0), "v"(a1), "v"(a2), "v"(a3), "v"(t) : "vcc"); } while (0)
constexpr int IDX_CHUNK = 512;
constexpr int IDX_NG = IDX_CHUNK / 64;
constexpr int IDX_CHB = IDX_CHUNK * 128;
__device__ __forceinline__ void phase_index(const Params& p, LAS unsigned char* lds, int bid, int nb) {
    const int tid = threadIdx.x, lane = tid & 63, wave = __builtin_amdgcn_readfirstlane(tid >> 6), k16 = lane & 15, g = lane >> 4;
    unsigned char* ws = p.ws;
    const h16* iq = (const h16*)(ws + WS_IQ); const h16* kidx = (const h16*)(ws + WS_KIDX); const float* widx = (const float*)(ws + WS_WIDX);
    unsigned short* sel = (unsigned short*)(ws + WS_SEL);
    LAS float* S = (LAS float*)lds;
    const int kq0 = k16 >> 2;
    const int nitems = (nb == 256) ? 8 : (2048 + nb - 1) / nb;
    int lk = 0;
    const int idxw_ = ((bid >> 3) << 1) | (bid & 1), bw_ = (bid & 7) >> 1;
    const bool cheap_ = (nb == 256) && idxw_ < 8;
    const int lbase_ = (nb != 256) ? bid * NWAVES + wave : (cheap_ ? 14336 + (bw_ * 8 + idxw_) * NWAVES + wave : (bw_ * 56 + (idxw_ - 8)) * NWAVES + wave);
    const int lstride_ = (nb != 256) ? nb * NWAVES : (cheap_ ? 256 : 1792), lcount_ = (nb != 256) ? (FQ_TOTAL + nb * NWAVES - 1) / (nb * NWAVES) : (cheap_ ? 16 : 8);
#define LATE_IDX(k) (((k) < lcount_ && lbase_ + (k) * lstride_ < FQ_TOTAL) ? lbase_ + (k) * lstride_ : FQ_TOTAL)
    for (int ii = 0; ii < nitems; ++ii) {
        int b, i;
        if (nb == 256) { b = (bid & 7) >> 1; const int idx = ((bid >> 3) << 1) | (bid & 1); i = ii < 4 ? 4 * idx + ii : 4 * (127 - idx) + (ii - 4); }
        else { const int item = bid + ii * nb; if (item >= 2048) break; b = item >> 9; i = item & 511; }
        if (i < 32) continue;
        const int t0 = i * 8;
        const int tq = t0 + wave;
        const size_t tg = (size_t)b * SEQ + tq;
        const h16* kb = kidx + (size_t)b * SEQ * 64;
        const int nhalf = ((t0 + 7) >> 5) + 1;
        h16x8 Af[8][2]; u32x2 W2[8];
#pragma unroll
        for (int q = 0; q < 8; ++q) {
            const size_t tgq = (size_t)b * SEQ + t0 + q;
            const h16* ap = iq + tgq * 1024 + lane * 8;
            Af[q][0] = *(const h16x8*)ap; Af[q][1] = *(const h16x8*)(ap + 512);
            const f32x4 wv = *(const f32x4*)(widx + tgq * 16 + 4 * g);
            h16x4 wsel;
#pragma unroll
            for (int r = 0; r < 4; ++r) { const h16 whi = (h16)wv[r]; const h16 wlo = (h16)(wv[r] - (float)whi); wsel[r] = (k16 & 2) ? (h16)0.f : ((k16 & 1) ? wlo : whi); }
            W2[q] = __builtin_bit_cast(u32x2, wsel);
        }
        {
            h16x8 Bc[4];
            {
                const h16* rp = kb + (size_t)wave * 2048 + lane * 8;
#pragma unroll
                for (int x = 0; x < 2; ++x)
#pragma unroll
                    for (int ks = 0; ks < 2; ++ks) Bc[2 * x + ks] = *(const h16x8*)(rp + x * 1024 + ks * 512);
            }
#pragma unroll 1
            for (int gi = wave; gi < nhalf; gi += 8) {
                const int gn = (gi + 8 < nhalf) ? gi + 8 : gi;
                const int kq = kq0;
                h16x8 Bn[4];
                {
                    const h16* rp = kb + (size_t)gn * 2048 + lane * 8;
#pragma unroll
                    for (int x = 0; x < 2; ++x)
#pragma unroll
                        for (int ks = 0; ks < 2; ++ks) Bn[2 * x + ks] = *(const h16x8*)(rp + x * 1024 + ks * 512);
                }
                f32x4 accc[2], accn[2], D2p = {0.f, 0.f, 0.f, 0.f};
                float scr[8];
#pragma unroll
                for (int x = 0; x < 2; ++x) accc[x] = __builtin_amdgcn_mfma_f32_16x16x32_f16(Af[0][0], Bc[2 * x], (f32x4){0.f, 0.f, 0.f, 0.f}, 0, 0, 0);
#pragma unroll
                for (int x = 0; x < 2; ++x) accc[x] = __builtin_amdgcn_mfma_f32_16x16x32_f16(Af[0][1], Bc[2 * x + 1], accc[x], 0, 0, 0);
                __builtin_amdgcn_sched_barrier(0);
#pragma unroll
                for (int q = 0; q < 8; ++q) {
                    if (q < 7) {
#pragma unroll
                        for (int x = 0; x < 2; ++x) accn[x] = __builtin_amdgcn_mfma_f32_16x16x32_f16(Af[q + 1][0], Bc[2 * x], (f32x4){0.f, 0.f, 0.f, 0.f}, 0, 0, 0);
#pragma unroll
                        for (int x = 0; x < 2; ++x) accn[x] = __builtin_amdgcn_mfma_f32_16x16x32_f16(Af[q + 1][1], Bc[2 * x + 1], accn[x], 0, 0, 0);
                    }
                    h16x2 qv[4];
#pragma unroll
                    for (int e = 0; e < 2; ++e) {
                        const f32x2 r01 = {accc[e][0], accc[e][1]}, r23 = {accc[e][2], accc[e][3]};
                        qv[2 * e] = relu_pk(__builtin_convertvector(r01, h16x2)); qv[2 * e + 1] = relu_pk(__builtin_convertvector(r23, h16x2));
                    }
                    h16x8 B2; B2[0] = qv[0][0]; B2[1] = qv[0][1]; B2[2] = qv[1][0]; B2[3] = qv[1][1]; B2[4] = qv[2][0]; B2[5] = qv[2][1]; B2[6] = qv[3][0]; B2[7] = qv[3][1];
                    const u32x4 a2 = {kq == 0 ? W2[q].x : 0u, kq == 0 ? W2[q].y : 0u, kq == 1 ? W2[q].x : 0u, kq == 1 ? W2[q].y : 0u};
                    const f32x4 D2 = __builtin_amdgcn_mfma_f32_16x16x32_f16(__builtin_bit_cast(h16x8, a2), B2, (f32x4){0.f, 0.f, 0.f, 0.f}, 0, 0, 0);
                    if (q > 0) scr[q - 1] = D2p[0] + D2p[1];
                    D2p = D2;
#pragma unroll
                    for (int x = 0; x < 2; ++x) accc[x] = accn[x];
                    if (q < 7) {
#pragma unroll
                        for (int i = 0; i < 4; ++i) { __builtin_amdgcn_sched_group_barrier(0x008, 1, 0); __builtin_amdgcn_sched_group_barrier(0x002, 3, 0); }
                    } else { __builtin_amdgcn_sched_group_barrier(0x002, 12, 0); }
                    __builtin_amdgcn_sched_group_barrier(0x008, 1, 0); __builtin_amdgcn_sched_group_barrier(0x002, 2, 0);
                    __builtin_amdgcn_sched_barrier(0);
                }
                scr[7] = D2p[0] + D2p[1];
                if (lane < 32) {
#pragma unroll
                    for (int q = 0; q < 8; ++q) S[q * 4096 + gi * 32 + lane] = scr[q];
                }
#pragma unroll
                for (int x = 0; x < 4; ++x) Bc[x] = Bn[x];
            }
        }
        __syncthreads();
        const int nq = (tq >> 10) + 1;
        float sc[64];
        {
            const LAS float* Sr = S + wave * 4096 + lane;
#pragma unroll
            for (int j = 0; j < 64; ++j) sc[j] = Sr[j * 64];
#pragma unroll
            for (int bk = 0; bk < 16; ++bk) if (bk >= (tq >> 8)) {
#pragma unroll
                for (int j = 4 * bk; j < 4 * bk + 4; ++j) sc[j] = (lane <= tq - 64 * j) ? sc[j] : -INFINITY;
            }
        }
        __syncthreads();
        const int lit = LATE_IDX(lk); ++lk;
        float ltv[32];
        if (lit < FQ_TOTAL) late_item_load(p.w_out, p.w_mlp1, p.w_mlp2, ws, lit, ltv, lane);
        constexpr int LCAP = 504;
        const int nblk = (tq >> 8) + 1;
        float vmin = INFINITY, vmax = -INFINITY, s1 = 0.f, s2 = 0.f;
#pragma unroll
        for (int bk = 0; bk < 16; ++bk) if (bk < nblk) {
            if (bk < nblk - 1) {
#pragma unroll
                for (int j = 4 * bk; j < 4 * bk + 4; ++j) { const float v = sc[j]; vmax = fmaxf(vmax, v); vmin = fminf(vmin, v); s1 += v; s2 += v * v; }
            } else {
#pragma unroll
                for (int j = 4 * bk; j < 4 * bk + 4; ++j) { const float v = sc[j]; const bool ok = !(v == -INFINITY); vmax = fmaxf(vmax, v); vmin = fminf(vmin, ok ? v : INFINITY); const float vz = ok ? v : 0.f; s1 += vz; s2 += vz * vz; }
            }
        }
        float lo = wave_min_dpp(vmin), hi = next_up(wave_max_dpp(vmax));
        int clo = tq + 1, chi = 0;
        int cl_lane = ((tq - lane) >> 6) + 1;
        float Tsel = lo; bool exact = false, finished = false;
        unsigned short* so = sel + tg * TOPK;
        int it = 0;
        if (clo > LCAP) {
            const float nn = (float)(tq + 1);
            const float rn = __builtin_amdgcn_rcpf(nn);
            const float mu = wave_sum_f_dpp(s1) * rn;
            float sg = __builtin_amdgcn_sqrtf(fmaxf(wave_sum_f_dpp(s2) * rn - mu * mu, 0.f));
            const float zt = qinv_upper(384.5f * rn);
            for (int pa = 0; pa < 3 && clo > LCAP && !finished; ++pa) {
                const float tp = mu + zt * sg;
                if (!(tp > lo && tp < hi)) break;
                int cn = 0;
#pragma unroll
                for (int bk = 0; bk < 16; ++bk) if (bk < nblk) CNT4(cn, sc[4 * bk], sc[4 * bk + 1], sc[4 * bk + 2], sc[4 * bk + 3], tp);
                const int cnl = cn;
                cn = wave_sum_dpp(cn);
                if (cn == TOPK) { Tsel = tp; exact = true; finished = true; break; }
                if (cn > TOPK) { lo = tp; clo = cn; cl_lane = cnl; } else { hi = tp; chi = cn; }
                Tsel = lo;
                const int cc = cn < 1 ? 1 : (cn > tq ? tq : cn);
                const float zm = qinv_upper((float)cc * rn);
                if (fabsf(zm) < 0.05f || (tp - mu) * zm <= 0.f) break;
                sg = fdiv(tp - mu, zm);
            }
        }
        for (; it < 200 && !finished; ++it) {
            if (clo <= LCAP) break;
            float mid = 0.5f * lo + 0.5f * hi;
            if (!(it & 1)) { const float frac = fdiv((float)(clo - TOPK) - 0.5f, (float)(clo - chi)); const float sm = lo + (hi - lo) * frac; if (sm > lo && sm < hi) mid = sm; }
            if (!(mid > lo && mid < hi)) { Tsel = lo; finished = true; break; }
            int cn = 0;
#pragma unroll
            for (int bk = 0; bk < 16; ++bk) if (bk < nblk) CNT4(cn, sc[4 * bk], sc[4 * bk + 1], sc[4 * bk + 2], sc[4 * bk + 3], mid);
            const int cnl = cn;
            cn = wave_sum_dpp(cn);
            if (cn == TOPK) { Tsel = mid; exact = true; finished = true; break; }
            if (cn > TOPK) { lo = mid; clo = cn; cl_lane = cnl; } else { hi = mid; chi = cn; }
            Tsel = lo;
        }
        bool tie_path = false;
        if (clo <= LCAP && !finished) {
            LAS unsigned char* lst = lds + 131072 + wave * 4096;
            {
                unsigned addr = (unsigned)(size_t)lst + 8u * (unsigned)wave_excl_scan(cl_lane), key = (unsigned)lane;
#pragma unroll
                for (int bk = 0; bk < 16; ++bk) if (bk < nblk) {
#pragma unroll
                    for (int j = 4 * bk; j < 4 * bk + 4; ++j) COMPACT1(addr, key, sc[j], lo);
                }
            }
            LDS_WAIT();
            float cv[8]; int ck[8];
#pragma unroll
            for (int j = 0; j < 8; ++j) { const u32x2 e = *(const LAS u32x2*)(lst + (64 * j + lane) * 8); cv[j] = __builtin_bit_cast(float, e.x); ck[j] = (int)e.y; }
#pragma unroll
            for (int j = 0; j < 8; ++j) { const bool in = 64 * j + lane < clo; cv[j] = in ? cv[j] : -INFINITY; }
            for (; it < 400; ++it) {
                float mid = 0.5f * lo + 0.5f * hi;
                if (!(it & 1)) { const float frac = fdiv((float)(clo - TOPK) - 0.5f, (float)(clo - chi)); const float sm = lo + (hi - lo) * frac; if (sm > lo && sm < hi) mid = sm; }
                if (!(mid > lo && mid < hi)) { Tsel = lo; break; }
                int cn = 0;
#pragma unroll
                for (int j = 0; j < 8; ++j) cn += __popcll(__ballot(cv[j] >= mid));
                if (cn == TOPK) { Tsel = mid; exact = true; break; }
                if (cn > TOPK) { lo = mid; clo = cn; } else { hi = mid; chi = cn; }
                Tsel = lo;
            }
            if (exact) {
                int outb = 0;
#pragma unroll
                for (int j = 0; j < 8; ++j) {
                    const bool take = cv[j] >= Tsel;
                    const unsigned long long bt = __ballot(take);
                    const int tr = __builtin_amdgcn_mbcnt_hi((unsigned)(bt >> 32), __builtin_amdgcn_mbcnt_lo((unsigned)bt, 0u));
                    if (take) so[outb + tr] = (unsigned short)ck[j];
                    outb += __popcll(bt);
                }
            } else tie_path = true;
            LDS_WAIT();
        } else if (exact) {
            int outb = 0;
#pragma unroll
            for (int q = 0; q < 4; ++q) if (q < nq) {
#pragma unroll
                for (int j = 16 * q; j < 16 * q + 16; ++j) {
                    const bool take = sc[j] >= Tsel;
                    const unsigned long long bt = __ballot(take);
                    const int tr = __builtin_amdgcn_mbcnt_hi((unsigned)(bt >> 32), __builtin_amdgcn_mbcnt_lo((unsigned)bt, 0u));
                    if (take) so[outb + tr] = (unsigned short)(j * 64 + lane);
                    outb += __popcll(bt);
                }
            }
        } else tie_path = true;
        if (tie_path) {
            int ngt = 0;
#pragma unroll
            for (int j = 0; j < 64; ++j) ngt += (sc[j] > Tsel) ? 1 : 0;
            ngt = wave_sum_dpp(ngt);
            const int quota = TOPK - ngt;
            int outb = 0, eqb = 0;
#pragma unroll
            for (int j = 0; j < 64; ++j) {
                const float v = sc[j];
                const bool gt = v > Tsel, eq = v == Tsel;
                const unsigned long long beq = __ballot(eq);
                const int eqr = __builtin_amdgcn_mbcnt_hi((unsigned)(beq >> 32), __builtin_amdgcn_mbcnt_lo((unsigned)beq, 0u));
                const bool take = gt || (eq && (eqb + eqr) < quota);
                const unsigned long long bt = __ballot(take);
                const int tr = __builtin_amdgcn_mbcnt_hi((unsigned)(bt >> 32), __builtin_amdgcn_mbcnt_lo((unsigned)bt, 0u));
                if (take) so[outb + tr] = (unsigned short)(j * 64 + lane);
                outb += __popcll(bt); eqb += __popcll(beq);
            }
        }
        if (lit < FQ_TOTAL) late_item_finish(p.w_out, p.w_mlp1, p.w_mlp2, ws, lit, ltv, lane);
    }
    for (;;) {
        const int lit = LATE_IDX(lk); ++lk;
        if (lit >= FQ_TOTAL) break;
        float ltv[32];
        late_item_load(p.w_out, p.w_mlp1, p.w_mlp2, ws, lit, ltv, lane);
        late_item_finish(p.w_out, p.w_mlp1, p.w_mlp2, ws, lit, ltv, lane);
    }
    __syncthreads();
}

typedef short s16x4v __attribute__((__vector_size__(4 * sizeof(short))));
__device__ __forceinline__ h16x4 lds_tr_read(const LAS unsigned char* p) {
    return __builtin_bit_cast(h16x4, __builtin_amdgcn_ds_read_tr16_b64_v4i16((LAS s16x4v*)p));
}
__device__ __forceinline__ void phase_attn(const Params& p, LAS unsigned char* lds, int bid, int nb) {
    const int tid = threadIdx.x, lane = tid & 63, wave = __builtin_amdgcn_readfirstlane(tid >> 6), g = lane >> 4, hd = lane & 15;
    unsigned char* ws = p.ws;
    const h16* qabs = (const h16*)(ws + WS_QABS); const h16* ckv = (const h16*)(ws + WS_CKV);
    const unsigned short* sel = (const unsigned short*)(ws + WS_SEL);
    h16* olat = (h16*)(ws + WS_OLAT);
    LAS unsigned char* kv = lds + wave * 16384;
    LAS int* sidx = (LAS int*)(lds + 131072 + wave * 1024);
    LAS float* biasT = (LAS float*)(lds + 131072 + 8192);
    LAS unsigned char* bktT = lds + 131072 + 8192 + 1024;
    __syncthreads();
    if (tid < 256) biasT[tid] = p.rel_bias[tid];
    if (tid < 128) bktT[tid] = (unsigned char)t5_bucket(tid);
    __syncthreads();
    int tstart, tstride, tcount;
    if (nb == 256) { const int b = (bid & 7) >> 1, wq = ((((bid >> 3) << 1) | (bid & 1)) << 3) + wave; tstart = b * SEQ + wq; tstride = 512; tcount = 8; }
    else { tstart = bid * NWAVES + wave; tstride = nb * NWAVES; tcount = (T - tstart + tstride - 1) / tstride; }
    const int rowA = hd;
    const int fswA = ((rowA & 3) << 1) | (((rowA >> 2) & 1) << 3);
    const int q4 = hd >> 2, p4 = hd & 3;
    const int rowT = 4 * g + q4;
    const int fswT = ((rowT & 3) << 1) | (((rowT >> 2) & 1) << 3);
    const LAS unsigned char* trbase = kv + rowT * 512 + 8 * (p4 & 1);
    for (int qi = 0; qi < tcount; ++qi) {
        int tg = tstart + qi * tstride;
        if (nb == 256) {
            const int idx = ((bid >> 3) << 1) | (bid & 1);
            const int it = qi < 4 ? 4 * idx + qi : 4 * (127 - idx) + (qi - 4);
            tg = ((bid & 7) >> 1) * SEQ + it * 8 + wave;
        }
        const int b = tg >> 12, tl = tg & (SEQ - 1);
        const int cnt = tl + 1 < TOPK ? tl + 1 : TOPK, nch = (cnt + 31) >> 5;
        {
            int i0, i1, i2, i3;
            if (tl + 1 > TOPK) { const u32x2 s4 = *(const u32x2*)(sel + (size_t)tg * TOPK + lane * 4); i0 = s4.x & 0xffff; i1 = s4.x >> 16; i2 = s4.y & 0xffff; i3 = s4.y >> 16; }
            else { const int j = lane * 4; i0 = j < cnt ? j : 0; i1 = j + 1 < cnt ? j + 1 : 0; i2 = j + 2 < cnt ? j + 2 : 0; i3 = j + 3 < cnt ? j + 3 : 0; }
            {
                const int pb = (lane >> 3) * 32 + 2 * (lane & 7);
                *(LAS i32x2*)(sidx + pb) = (i32x2){i0, i2}; *(LAS i32x2*)(sidx + pb + 16) = (i32x2){i1, i3};
            }
        }
        h16x8 Qf[8];
#pragma unroll
        for (int ks = 0; ks < 8; ++ks) {
            h16x8 z;
#pragma unroll
            for (int e = 0; e < 8; ++e) z[e] = (h16)0.f;
            Qf[ks] = (hd < 8) ? *(const h16x8*)(qabs + (size_t)tg * 2048 + hd * 256 + ks * 32 + g * 8) : z;
        }
        f32x4 O[16];
#pragma unroll
        for (int ct = 0; ct < 16; ++ct) O[ct] = (f32x4){0.f, 0.f, 0.f, 0.f};
        float m = -INFINITY, l = 0.f;
        const unsigned char* ckvb = (const unsigned char*)(ckv + (size_t)b * SEQ * 256);
        LDS_WAIT();
        for (int c = 0; c < nch; ++c) {
            asm volatile("" ::: "memory");
            int ridx[16];
            {
                const LAS i32x4* rp = (const LAS i32x4*)(sidx + 32 * c + 16 * (lane >> 5));
#pragma unroll
                for (int q4 = 0; q4 < 4; ++q4) { const i32x4 v4 = rp[q4]; ridx[4 * q4] = v4.x; ridx[4 * q4 + 1] = v4.y; ridx[4 * q4 + 2] = v4.z; ridx[4 * q4 + 3] = v4.w; }
            }
#pragma unroll
            for (int i = 0; i < 16; ++i) {
                const int row = 2 * i + (lane >> 5);
                const int fsw = ((row & 3) << 1) | (((row >> 2) & 1) << 3);
                const unsigned char* src = ckvb + (size_t)ridx[i] * 512 + ((((lane & 31) ^ fsw)) << 4);
                __builtin_amdgcn_global_load_lds((const unsigned*)src, (LAS unsigned*)(kv + i * 1024), 16, 0, 0);
            }
            const LAS int* sp = sidx + 32 * c + 2 * g;
            const i32x2 pa = *(const LAS i32x2*)(sp), pb2 = *(const LAS i32x2*)(sp + 16), pc = *(const LAS i32x2*)(sp + 8), pd = *(const LAS i32x2*)(sp + 24);
            const int h7 = hd & 7;
            const int kk8[8] = {pa.x, pb2.x, pa.y, pb2.y, pc.x, pd.x, pc.y, pd.y};
            int bkt8[8];
#pragma unroll
            for (int r = 0; r < 8; ++r) { int dist = tl - kk8[r]; dist = dist < 0 ? 0 : (dist > 127 ? 127 : dist); bkt8[r] = (int)bktT[dist]; }
            float bias8[8];
#pragma unroll
            for (int r = 0; r < 8; ++r) bias8[r] = biasT[bkt8[r] * 8 + h7];
#pragma unroll
            for (int r = 0; r < 8; ++r) {
                const int slot = 32 * c + (r < 4 ? 4 * g + r : 16 + 4 * g + (r - 4));
                bias8[r] = (slot < cnt) ? bias8[r] : -INFINITY;
            }
            asm volatile("s_waitcnt vmcnt(0)" ::: "memory");
            __builtin_amdgcn_sched_barrier(0);
            f32x4 S0 = {0.f, 0.f, 0.f, 0.f}, S1 = {0.f, 0.f, 0.f, 0.f};
            {
                h16x8 A0[8], A1[8];
#pragma unroll
                for (int ks = 0; ks < 8; ++ks) {
                    A0[ks] = *(const LAS h16x8*)(kv + rowA * 512 + (((4 * ks + g) ^ fswA) << 4));
                    A1[ks] = *(const LAS h16x8*)(kv + (rowA + 16) * 512 + (((4 * ks + g) ^ fswA) << 4));
                }
                __builtin_amdgcn_sched_barrier(0);
#pragma unroll
                for (int ks = 0; ks < 8; ++ks) {
                    S0 = __builtin_amdgcn_mfma_f32_16x16x32_f16(A0[ks], Qf[ks], S0, 0, 0, 0);
                    S1 = __builtin_amdgcn_mfma_f32_16x16x32_f16(A1[ks], Qf[ks], S1, 0, 0, 0);
                }
            }
            float sv[8]; float cmax = -INFINITY;
#pragma unroll
            for (int r = 0; r < 8; ++r) { sv[r] = ((r < 4) ? S0[r] : S1[r - 4]) + bias8[r]; cmax = fmaxf(cmax, sv[r]); }
            if (__any(cmax > m + 8.f)) {
                cmax = fmaxf(cmax, __shfl_xor(cmax, 16)); cmax = fmaxf(cmax, __shfl_xor(cmax, 32));
                const float mnew = fmaxf(m, cmax);
                const float alpha = __expf(m - mnew);
                l *= alpha; m = mnew;
#pragma unroll
                for (int ct = 0; ct < 16; ++ct) O[ct] *= alpha;
            }
            h16x8 Pf;
#pragma unroll
            for (int r = 0; r < 8; ++r) { const float pv = __expf(sv[r] - m); l += pv; Pf[r] = (h16)pv; }
#pragma unroll
            for (int ct = 0; ct < 16; ++ct) {
                const int choff = ((((2 * (ct & 7)) ^ fswT) + (p4 >> 1)) << 4) + (ct >> 3) * 256;
                const h16x4 a0 = lds_tr_read(trbase + choff);
                const h16x4 a1 = lds_tr_read(trbase + 16 * 512 + choff);
                h16x8 Av; Av[0] = a0[0]; Av[1] = a0[1]; Av[2] = a0[2]; Av[3] = a0[3]; Av[4] = a1[0]; Av[5] = a1[1]; Av[6] = a1[2]; Av[7] = a1[3];
                O[ct] = __builtin_amdgcn_mfma_f32_16x16x32_f16(Av, Pf, O[ct], 0, 0, 0);
            }
            asm volatile("" ::: "memory");
        }
        l += __shfl_xor(l, 16); l += __shfl_xor(l, 32);
        if (hd < 8) {
            const float inv = 1.f / l;
            h16* op = olat + (size_t)tg * 2048 + hd * 256 + 4 * g;
#pragma unroll
            for (int ct = 0; ct < 16; ++ct) *(u32x2*)(op + 16 * ct) = pack_h4(O[ct] * inv);
        }
    }
    __syncthreads();
}

__device__ __forceinline__ void phase_uv(const Params& p, LAS unsigned char* lds, int bid, int nb) {
    const int tid = threadIdx.x, lane = tid & 63, wave = tid >> 6, r31 = lane & 31, hh = lane >> 5;
    unsigned char* ws = p.ws;
    const h16* olat = (const h16*)(ws + WS_OLAT); const h16* wuvF = (const h16*)(ws + WS_WUVT);
    h16* ymix = (h16*)(ws + WS_R2);
    const int b = (bid & 7) >> 1, idx = ((bid >> 3) << 1) | (bid & 1), h = wave;
    LAS unsigned char* tl = lds + wave * 17408;
    const h16* wf = wuvF + (size_t)h * 32768 + lane * 8;
#pragma unroll 1
    for (int sl = 0; sl < 2; ++sl) {
        const int tok0 = b * SEQ + 32 * (sl == 0 ? idx : 127 - idx);
        {
            u32x4 st[16];
#pragma unroll
            for (int j = 0; j < 16; ++j) st[j] = *(const u32x4*)(olat + (size_t)(tok0 + 2 * j + hh) * 2048 + h * 256 + r31 * 8);
#pragma unroll
            for (int j = 0; j < 16; ++j) *(LAS u32x4*)(tl + (2 * j + hh) * 528 + r31 * 16) = st[j];
        }
        LDS_WAIT();
        f32x16 acc[4];
#pragma unroll
        for (int vt = 0; vt < 4; ++vt)
#pragma unroll
            for (int r = 0; r < 16; ++r) acc[vt][r] = 0.f;
#pragma unroll 4
        for (int ks = 0; ks < 16; ++ks) {
            const h16x8 Bf = *(const LAS h16x8*)(tl + r31 * 528 + ks * 32 + hh * 16);
#pragma unroll
            for (int vt = 0; vt < 4; ++vt) {
                const h16x8 Af = *(const h16x8*)(wf + (size_t)(vt * 16 + ks) * 512);
                acc[vt] = __builtin_amdgcn_mfma_f32_32x32x16_f16(Af, Bf, acc[vt], 0, 0, 0);
            }
        }
        float ss = 0.f;
#pragma unroll
        for (int vt = 0; vt < 4; ++vt)
#pragma unroll
            for (int r = 0; r < 16; ++r) ss += acc[vt][r] * acc[vt][r];
        ss += __shfl_xor(ss, 32);
        const float rstd = rsqrtf(ss * (1.f / 128.f) + EPS);
        h16* yp = ymix + (size_t)(tok0 + r31) * 2048 + h * 128 + 4 * hh;
        const float* gp = p.attn_out_norm_g + h * 128 + 4 * hh;
        f32x4 gg[4][4];
#pragma unroll
        for (int vt = 0; vt < 4; ++vt)
#pragma unroll
            for (int rq = 0; rq < 4; ++rq) gg[vt][rq] = *(const f32x4*)(gp + vt * 32 + 8 * rq);
        __builtin_amdgcn_s_waitcnt(0x0F70);
#pragma unroll
        for (int vt = 0; vt < 4; ++vt)
#pragma unroll
            for (int rq = 0; rq < 4; ++rq) {
                const f32x4 g4 = gg[vt][rq];
                const f32x4 y = {acc[vt][4 * rq + 0] * rstd * g4[0], acc[vt][4 * rq + 1] * rstd * g4[1], acc[vt][4 * rq + 2] * rstd * g4[2], acc[vt][4 * rq + 3] * rstd * g4[3]};
                *(u32x2*)(yp + vt * 32 + 8 * rq) = pack_h4(y);
            }
        LDS_WAIT();
    }
    __syncthreads();
    (void)nb;
}

#define XB_TMO      128
#define XB_XCNT(j)  (256  + 64 * (j))
#define XB_XSUB(j)  (1280 + 64 * (j))
#define XB_XGEN(j)  (2304 + 64 * (j))
#define XB_TOP      3328
#define XB_TOPGEN   3392
#define XCD_BAR_WORDS 3456
#define XB_SPIN_CAP (1u << 22)
__device__ __forceinline__ unsigned xb_ld(unsigned* p)              { return __hip_atomic_load(p, __ATOMIC_RELAXED, __HIP_MEMORY_SCOPE_AGENT); }
__device__ __forceinline__ unsigned xb_add(unsigned* p, unsigned v) { return __hip_atomic_fetch_add(p, v, __ATOMIC_RELAXED, __HIP_MEMORY_SCOPE_AGENT); }
__device__ __forceinline__ unsigned xb_xcc_id() { return (unsigned)__builtin_amdgcn_s_getreg((3 << 11) | 20) & 0xFu; }
#define XB_SPIN(cond, bar) do { unsigned _sp = 0; while (cond) { __builtin_amdgcn_s_sleep(1); \
    if ((++_sp & 255u) == 0u) { if (xb_ld(&(bar)[XB_TMO])) break; if (_sp > XB_SPIN_CAP) { atomicAdd(&(bar)[XB_TMO], 1u); break; } } } } while (0)
struct XcdBarrier { unsigned* bar; unsigned x; volatile LAS unsigned* st; };
__device__ __forceinline__ XcdBarrier xcd_barrier_post(unsigned* bar, volatile LAS unsigned* st) {
    XcdBarrier b; b.bar = bar; b.x = xb_xcc_id(); b.st = st;
    if (threadIdx.x == 0) (void)xb_add(&bar[XB_XCNT(b.x)], 1u);
    return b;
}
__device__ __forceinline__ void xcd_barrier_complete(unsigned* bar, unsigned x, unsigned& nloc, unsigned& nx) {
    const unsigned G = gridDim.x * gridDim.y * gridDim.z;
    unsigned sum, cnt, mine, sp = 0u;
    for (;;) {
        sum = 0u; cnt = 0u; mine = 0u;
#pragma unroll
        for (unsigned j = 0; j < 16; ++j) { const unsigned c = xb_ld(&bar[XB_XCNT(j)]); sum += c; cnt += (c > 0u) ? 1u : 0u; mine = (j == x) ? c : mine; }
        if (sum == G) break;
        __builtin_amdgcn_s_sleep(1);
        if ((++sp & 255u) == 0u) { if (xb_ld(&bar[XB_TMO])) break; if (sp > XB_SPIN_CAP) { atomicAdd(&bar[XB_TMO], 1u); break; } }
    }
    nloc = mine > 0u ? mine : 1u; nx = cnt > 0u ? cnt : 1u;
}
__device__ __forceinline__ void xcd_barrier(const XcdBarrier& b) {
    asm volatile("s_waitcnt vmcnt(0)" ::: "memory");
    __syncthreads();
    if (threadIdx.x == 0) {
        unsigned* bar = b.bar;
        __builtin_amdgcn_s_waitcnt(0);
        unsigned nloc = b.st[0], nx = b.st[1];
        if (nloc == 0u) { xcd_barrier_complete(bar, b.x, nloc, nx); b.st[0] = nloc; b.st[1] = nx; }
        const unsigned old = xb_add(&bar[XB_XSUB(b.x)], 1u);
        const unsigned gen = old / nloc;
        if (old + 1u == (gen + 1u) * nloc) {
            __builtin_amdgcn_fence(__ATOMIC_RELEASE, "agent");
            asm volatile("s_waitcnt vmcnt(0)" ::: "memory");
            const unsigned og = xb_add(&bar[XB_TOP], 1u);
            const unsigned tg = og / nx;
            if (og + 1u == (tg + 1u) * nx) xb_add(&bar[XB_TOPGEN], 1u);
            else XB_SPIN(xb_ld(&bar[XB_TOPGEN]) == tg, bar);
            __builtin_amdgcn_fence(__ATOMIC_ACQUIRE, "agent");
            xb_add(&bar[XB_XGEN(b.x)], 1u);
            asm volatile("s_waitcnt vmcnt(0)" ::: "memory");
        } else {
            XB_SPIN(xb_ld(&bar[XB_XGEN(b.x)]) == gen, bar);
            __builtin_amdgcn_fence(__ATOMIC_ACQUIRE, "workgroup");
            asm volatile("buffer_inv sc0\n\ts_waitcnt vmcnt(0)" ::: "memory");
        }
    }
    __syncthreads();
}

constexpr int LDS_BYTES = 160 * 1024;
constexpr int WGM_G1 = 4, WGM_G2 = 4, WGM_G6 = 2, WGM_G7 = 4, WGM_G8 = 2;
constexpr int NPHASES = 13;
__global__ void __launch_bounds__(NTHREADS, 2) fwd_kernel(Params p) {
    extern __shared__ __attribute__((aligned(16))) unsigned char lds_raw[];
    LAS unsigned char* lds = (LAS unsigned char*)lds_raw;
    const int bid = blockIdx.x, nb = gridDim.x;
    unsigned char* ws = p.ws;
    float* mod = (float*)(ws + WS_MOD);
    volatile LAS unsigned* bst = (volatile LAS unsigned*)(lds + LDS_BYTES - 64);
    if (threadIdx.x < 2) bst[threadIdx.x] = 0u;
    __syncthreads();
    XcdBarrier xbar = xcd_barrier_post((unsigned*)(ws + WS_CTL), bst);
#define IN(k) (p.ph_lo <= (k) && (k) < p.ph_hi)
#define SEAM(k) do { if (IN(k) && IN((k) + 1)) xcd_barrier(xbar); } while (0)
    if (IN(0)) { phase_prep(p, lds, bid, nb); }
    f32x4 nm1v[8];
    if (IN(1)) { const int t0_ = bid * NWAVES + (int)(threadIdx.x >> 6); const f32x4* xr_ = (const f32x4*)(p.x + (size_t)(t0_ < T ? t0_ : 0) * 2048) + (threadIdx.x & 63);
#pragma unroll
        for (int j = 0; j < 8; ++j) nm1v[j] = xr_[64 * j]; }
    SEAM(0);
    if (IN(1)) { phase_normmod(p.x, p.norm1_g, mod, 0, 2048, (h16*)(ws + WS_R2), bid, nb, nm1v); } SEAM(1);
    if (IN(2)) { EpiProj E{(h16*)(ws + WS_CQ), (float*)(ws + WS_PROJA), (h16*)(ws + WS_CKV), (h16*)(ws + WS_KIDX), (float*)(ws + WS_WIDX), (h16*)(ws + WS_PROJB), p.kv_norm_g, p.idx_k_norm_g, p.idx_k_norm_b};
                 run_gemm(lds, (const h16*)(ws + WS_R2), (const h16*)(ws + WS_BT_IN), T, N_IN, 2048, bid, nb, E, WGM_G1); } SEAM(2);
    if (IN(3)) { phase_rows3(p, bid, nb); }
    if (IN(4)) { EpiQ E{(h16*)(ws + WS_QABS), (h16*)(ws + WS_IQ), p.q_abs_norm_g, (const float*)(ws + WS_PROJA)}; run_gemm(lds, (const h16*)(ws + WS_CQ), (const h16*)(ws + WS_BT_Q), T, N_Q, 512, bid, nb, E, WGM_G2); } SEAM(4);
    if (IN(5)) { phase_index(p, lds, bid, nb); }
    if (IN(6)) { phase_attn(p, lds, bid, nb); }
    if (IN(7)) { phase_uv(p, lds, bid, nb); } SEAM(7);
    if (IN(8)) { EpiX1 E{(h16*)(ws + WS_Y6), p.x, mod}; run_gemm(lds, (const h16*)(ws + WS_R2), (const h16*)(ws + WS_BT_OUT), T, 2048, 2048, bid, nb, E, WGM_G6); } SEAM(8);
#define STAGE_B1() do { LAS h16* bl_ = (LAS h16*)(lds + 131072 + 8192); __syncthreads(); f32x4 b4_[4]; \
        _Pragma("unroll") for (int q = 0; q < 4; ++q) b4_[q] = *(const f32x4*)(p.b_mlp1 + 4 * (threadIdx.x + q * NTHREADS)); \
        _Pragma("unroll") for (int q = 0; q < 4; ++q) *(LAS u32x2*)(bl_ + 4 * (threadIdx.x + q * NTHREADS)) = pack_h4(b4_[q]); \
        __syncthreads(); } while (0)
    if (IN(9)) { phase_normmod2(p, bid, nb); if (IN(10)) STAGE_B1(); } SEAM(9);
    if (IN(10)) {
        LAS h16* bl = (LAS h16*)(lds + 131072 + 8192);
        if (!IN(9)) STAGE_B1();
        EpiMlp1 E{bl, (h16*)(ws + WS_R3)}; run_gemm(lds, (const h16*)(ws + WS_R2), (const h16*)(ws + WS_BT_1), T, D_FF, 2048, bid, nb, E, WGM_G7); } SEAM(10);
    if (IN(11)) { EpiFinal E{p.out, (const h16*)(ws + WS_Y6), p.b_mlp2, mod}; run_gemm(lds, (const h16*)(ws + WS_R3), (const h16*)(ws + WS_BT_2), T, 2048, D_FF, bid, nb, E, WGM_G8); }
#undef IN
#undef SEAM
}

#ifndef N_LAUNCH_MODE
#define N_LAUNCH_MODE 1
#endif
extern "C" void kernel_launch(void* const* d_in, const int* in_sizes, int n_in, void* d_out, int out_size, void* d_ws, size_t ws_size, hipStream_t stream) {
    static int grid = 0;
    if (grid == 0) {
        if (ws_size < WS_END) { fprintf(stderr, "kernel_launch: workspace too small (%zu < %zu)\n", ws_size, (size_t)WS_END); grid = -1; return; }
        int dev = 0, cus = 0, per_cu = 0;
        hipGetDevice(&dev);
        hipDeviceGetAttribute(&cus, hipDeviceAttributeMultiprocessorCount, dev);
        if (hipFuncSetAttribute((const void*)fwd_kernel, hipFuncAttributeMaxDynamicSharedMemorySize, LDS_BYTES) != hipSuccess) { fprintf(stderr, "kernel_launch: hipFuncSetAttribute failed\n"); grid = -1; return; }
        hipOccupancyMaxActiveBlocksPerMultiprocessor(&per_cu, (const void*)fwd_kernel, NTHREADS, LDS_BYTES);
        if (per_cu < 1) { fprintf(stderr, "kernel_launch: occupancy query says %d\n", per_cu); per_cu = 1; }
        grid = cus;
        if (grid > 256) grid = 256;
        if (grid != 256) { fprintf(stderr, "kernel_launch: this build needs 256 CUs (found %d): the P5..P7 workgroup-local token ownership is laid out for 256 workgroups\n", cus); grid = -1; return; }
    }
    if (grid < 0) return;
    Params p{};
    const float** f = (const float**)&p;
    for (int i = 0; i < 26; ++i) f[i] = (const float*)d_in[i];
    p.out = (float*)d_out; p.ws = (unsigned char*)d_ws;
#if N_LAUNCH_MODE == 1
    if (hipMemsetAsync((char*)d_ws + WS_CTL, 0, XCD_BAR_WORDS * 4, stream) != hipSuccess) { fprintf(stderr, "kernel_launch: memset failed\n"); return; }
    p.ph_lo = 0; p.ph_hi = NPHASES;
    void* args[] = {&p};
    hipError_t e = hipLaunchCooperativeKernel((const void*)fwd_kernel, dim3(grid), dim3(NTHREADS), args, LDS_BYTES, stream);
    if (e != hipSuccess) fprintf(stderr, "cooperative launch failed: %s (grid %d)\n", hipGetErrorString(e), grid);
#else
    for (int ph = 0; ph < 13; ++ph) {
        p.ph_lo = ph; p.ph_hi = ph + 1;
        hipLaunchKernelGGL(fwd_kernel, dim3(grid), dim3(NTHREADS), LDS_BYTES, stream, p);
    }
#endif
}
```
